# Optimizing an MI355X kernel written in HIP

```python
import math
import jax
import jax.numpy as jnp
from jax import lax
import numpy as np

D_MODEL = 1024
BATCH = 2
SEQ = 16384
DEPTH = 2

GRID_W = 64
CTX_LEN = 256
N_EVEN = (DEPTH + 1) // 2
N_ODD = DEPTH // 2
EPS = 1e-6
N_MOD = 6

GROUP_DIM = 64
HY_WIDTH = 3 * D_MODEL // 4
FN_WIDTH = D_MODEL - HY_WIDTH
FN_GROUPS = FN_WIDTH // GROUP_DIM
EVEN_IN = 3 * HY_WIDTH + FN_WIDTH
HY_EMB_DIM = 33
HY_FILTER_HIDDEN = 64
HY_DECAY_TARGET = 1e-2
HY_FAST_DECAY_PCT = 0.3
HY_SLOW_DECAY_PCT = 1.5
D_FF = ((8 * D_MODEL // 3 + 255) // 256) * 256

HEAD_DIM = 64
N_Q_HEADS = (D_MODEL // 2) // HEAD_DIM
N_KV_HEADS = 2
Q_PER_KV = N_Q_HEADS // N_KV_HEADS
ATT_WIDTH = N_Q_HEADS * HEAD_DIM
KV_WIDTH = N_KV_HEADS * HEAD_DIM
SC_WIDTH = D_MODEL - ATT_WIDTH
ODD_IN = ATT_WIDTH + 2 * KV_WIDTH + 3 * SC_WIDTH
WINDOW = 128
BLOCK = 128
ROPE_BASE = 10000.0
N_EXPERTS = 8
TOP_K = 2
D_FF_EXPERT = 7 * D_MODEL // 2
NEG_INF = -1e30

kernel_name = "hybrid_hyena_fnet_shortconv_swa_moe_dit"


def rms_norm(x, g):
    xf = x.astype(jnp.float32)
    y = xf * lax.rsqrt(jnp.mean(xf * xf, axis=-1, keepdims=True) + EPS)
    return (y * g.astype(jnp.float32)).astype(x.dtype)


def ada_params(cond, w, b):
    m = jax.nn.silu(cond) @ w + b
    return jnp.split(m[..., None, :], N_MOD, axis=-1)


def modulate(x, g, shift, scale):
    return rms_norm(x, g) * (1 + scale) + shift


def short_conv(u, w):
    L = u.shape[1]
    up = jnp.pad(u, ((0, 0), (1, 1), (0, 0)))
    return up[:, :L] * w[0] + up[:, 1:L + 1] * w[1] + up[:, 2:] * w[2]


def swiglu(h, wg, wu, wd):
    return (jax.nn.silu(h @ wg) * (h @ wu)) @ wd


def hyena_kernel(L, w1, b1, freq, w2, b2, w3):
    f32 = jnp.float32
    t = jnp.linspace(0.0, 1.0, L, dtype=f32)[:, None]
    bands = (HY_EMB_DIM - 1) // 2
    ang = (2.0 * math.pi / L) * jnp.arange(L, dtype=f32)[:, None] * jnp.linspace(1e-4, bands - 1, bands, dtype=f32)[None, :]
    z = jnp.concatenate([t, jnp.cos(ang), -jnp.sin(ang)], axis=-1)
    fr = freq.astype(f32)
    h = jnp.sin(fr * (z @ w1.astype(f32) + b1.astype(f32)))
    h = jnp.sin(fr * (h @ w2.astype(f32) + b2.astype(f32)))
    h = h @ w3.astype(f32)
    max_decay = math.log(HY_DECAY_TARGET) / HY_FAST_DECAY_PCT
    min_decay = math.log(HY_DECAY_TARGET) / HY_SLOW_DECAY_PCT
    deltas = jnp.abs(jnp.linspace(min_decay, max_decay, HY_WIDTH, dtype=f32))
    decay = jnp.exp(-t * deltas[None, :])
    h_fwd = h[:, :HY_WIDTH] * decay
    h_bwd = h[1:, HY_WIDTH:] * decay[1:]
    l1 = jnp.sum(jnp.abs(h_fwd), axis=0) + jnp.sum(jnp.abs(h_bwd), axis=0)
    kern = jnp.concatenate([h_fwd, jnp.zeros((1, HY_WIDTH), f32), h_bwd[::-1]], axis=0)
    return kern / l1


def fft_conv_bidir(u, kern):
    L = u.shape[1]
    n = 2 * L
    u_f = jnp.fft.rfft(u.astype(jnp.float32), n=n, axis=1)
    k_f = jnp.fft.rfft(kern, n=n, axis=0)
    return jnp.fft.irfft(u_f * k_f[None], n=n, axis=1)[:, :L]


def hyena_mix(p, short_w, w1, b1, freq, w2, b2, w3, skip):
    L = p.shape[1]
    p = short_conv(p, short_w)
    x0, x1, v = jnp.split(p, 3, axis=-1)
    u = v * x1
    kern = hyena_kernel(L, w1, b1, freq, w2, b2, w3)
    y = fft_conv_bidir(u, kern).astype(u.dtype) + u * skip
    return x0 * y


def fourier_mix(f):
    B, L, _ = f.shape
    fg = f.astype(jnp.float32).reshape(B, L, FN_GROUPS, GROUP_DIM)
    y = jnp.fft.fft2(fg, axes=(1, 3), norm="ortho").real
    return y.reshape(B, L, FN_WIDTH).astype(f.dtype)


def axial_rope(x, rows, cols):
    half = HEAD_DIM // 2
    quarter = half // 2
    inv_freq = ROPE_BASE ** (-jnp.arange(quarter, dtype=jnp.float32) / quarter)
    xf = x.astype(jnp.float32)

    def rotate(xa, pos):
        ang = pos.astype(jnp.float32)[:, None] * inv_freq[None, :]
        cos = jnp.cos(ang)[None, :, None, :]
        sin = jnp.sin(ang)[None, :, None, :]
        a1, a2 = xa[..., :quarter], xa[..., quarter:]
        return jnp.concatenate([a1 * cos - a2 * sin, a2 * cos + a1 * sin], axis=-1)

    out = jnp.concatenate([rotate(xf[..., :half], rows), rotate(xf[..., half:], cols)], axis=-1)
    return out.astype(x.dtype)


def window_attention(q, k, v, kc, vc, sink):
    B, L = q.shape[0], q.shape[1]
    n_blocks = L // BLOCK
    qg = q.reshape(B, L, N_KV_HEADS, Q_PER_KV, HEAD_DIM)
    kp = jnp.pad(k, ((0, 0), (BLOCK, BLOCK), (0, 0), (0, 0)))
    vp = jnp.pad(v, ((0, 0), (BLOCK, BLOCK), (0, 0), (0, 0)))
    scale = HEAD_DIM ** -0.5
    a_idx = jnp.arange(BLOCK)[:, None]
    b_idx = jnp.arange(3 * BLOCK)[None, :]
    band = jnp.abs(b_idx - BLOCK - a_idx) <= WINDOW
    sink_l = sink.astype(jnp.float32).reshape(1, N_KV_HEADS, Q_PER_KV, 1, 1)
    n_ctx = kc.shape[1]

    def attend_block(i):
        start = i * BLOCK
        qb = lax.dynamic_slice_in_dim(qg, start, BLOCK, axis=1)
        kb = lax.dynamic_slice_in_dim(kp, start, 3 * BLOCK, axis=1)
        vb = lax.dynamic_slice_in_dim(vp, start, 3 * BLOCK, axis=1)
        kpos = start - BLOCK + jnp.arange(3 * BLOCK)
        mask = band & ((kpos >= 0) & (kpos < L))[None, :]
        s_loc = jnp.einsum("bqhgd,bshd->bhgqs", qb, kb).astype(jnp.float32) * scale
        s_loc = jnp.where(mask, s_loc, NEG_INF)
        s_ctx = jnp.einsum("bqhgd,bchd->bhgqc", qb, kc).astype(jnp.float32) * scale
        s_sink = jnp.broadcast_to(sink_l, (B, N_KV_HEADS, Q_PER_KV, BLOCK, 1))
        p = jax.nn.softmax(jnp.concatenate([s_loc, s_ctx, s_sink], axis=-1), axis=-1)
        p_loc = p[..., :3 * BLOCK].astype(v.dtype)
        p_ctx = p[..., 3 * BLOCK:3 * BLOCK + n_ctx].astype(v.dtype)
        return jnp.einsum("bhgqs,bshd->bqhgd", p_loc, vb) + jnp.einsum("bhgqc,bchd->bqhgd", p_ctx, vc)

    out = lax.map(attend_block, jnp.arange(n_blocks))
    return jnp.moveaxis(out, 0, 1).reshape(B, L, ATT_WIDTH)


def context_attention(qc, kc, vc, sink):
    B, C = qc.shape[0], qc.shape[1]
    qg = qc.reshape(B, C, N_KV_HEADS, Q_PER_KV, HEAD_DIM)
    s = jnp.einsum("bqhgd,bshd->bhgqs", qg, kc).astype(jnp.float32) * HEAD_DIM ** -0.5
    s_sink = jnp.broadcast_to(sink.astype(jnp.float32).reshape(1, N_KV_HEADS, Q_PER_KV, 1, 1), (B, N_KV_HEADS, Q_PER_KV, C, 1))
    p = jax.nn.softmax(jnp.concatenate([s, s_sink], axis=-1), axis=-1)[..., :C].astype(vc.dtype)
    return jnp.einsum("bhgqs,bshd->bqhgd", p, vc).reshape(B, C, ATT_WIDTH)


def short_gated_conv_mix(s, conv_w):
    gate_b, gate_c, hx = jnp.split(s, 3, axis=-1)
    return gate_b * short_conv(gate_c * hx, conv_w)


def moe_swiglu(h, router_w, router_b, wg, wu, wd):
    logits = (h @ router_w + router_b).astype(jnp.float32)
    top_val, top_idx = lax.top_k(logits, TOP_K)
    gates = jax.nn.softmax(top_val, axis=-1)
    combine = jnp.einsum("blk,blke->ble", gates, jax.nn.one_hot(top_idx, N_EXPERTS, dtype=jnp.float32)).astype(h.dtype)
    out = jnp.zeros_like(h)
    for e in range(N_EXPERTS):
        out = out + combine[..., e:e + 1] * swiglu(h, wg[e], wu[e], wd[e])
    return out


def even_layer(x, ctx, mod_x, mod_c, norm1, norm2, w_in, hy_short, hy_w1, hy_b1, hy_freq, hy_w2, hy_b2, hy_w3, hy_skip, w_out, ffn_wg, ffn_wu, ffn_wd):
    def run(s, mod):
        sh1, sc1, g1, sh2, sc2, g2 = mod
        p = modulate(s, norm1, sh1, sc1) @ w_in
        y_h = hyena_mix(p[..., :3 * HY_WIDTH], hy_short, hy_w1, hy_b1, hy_freq, hy_w2, hy_b2, hy_w3, hy_skip)
        y_f = fourier_mix(p[..., 3 * HY_WIDTH:])
        s = s + g1 * (jnp.concatenate([y_h, y_f], axis=-1) @ w_out)
        return s + g2 * swiglu(modulate(s, norm2, sh2, sc2), ffn_wg, ffn_wu, ffn_wd)

    x_new = run(x, mod_x)
    ctx_new = run(ctx, mod_c) if mod_c is not None else None
    return x_new, ctx_new


def odd_layer(x, ctx, mod_x, mod_c, rows, cols, need_ctx, norm1, norm2, w_in, q_norm, k_norm, sink, sc_conv, w_out, router_w, router_b, moe_wg, moe_wu, moe_wd):
    B, L, _ = x.shape
    n_ctx = ctx.shape[1]
    csh1, csc1, cg1, csh2, csc2, cg2 = mod_c
    hc = modulate(ctx, norm1, csh1, csc1)
    if need_ctx:
        pc = hc @ w_in
        qc, kc, vc, sc_c = jnp.split(pc, [ATT_WIDTH, ATT_WIDTH + KV_WIDTH, ATT_WIDTH + 2 * KV_WIDTH], axis=-1)
    else:
        kvc = hc @ w_in[:, ATT_WIDTH:ATT_WIDTH + 2 * KV_WIDTH]
        kc, vc = jnp.split(kvc, 2, axis=-1)
    kc = rms_norm(kc.reshape(B, n_ctx, N_KV_HEADS, HEAD_DIM), k_norm)
    vc = vc.reshape(B, n_ctx, N_KV_HEADS, HEAD_DIM)

    sh1, sc1, g1, sh2, sc2, g2 = mod_x
    p = modulate(x, norm1, sh1, sc1) @ w_in
    q, k, v, s = jnp.split(p, [ATT_WIDTH, ATT_WIDTH + KV_WIDTH, ATT_WIDTH + 2 * KV_WIDTH], axis=-1)
    q = axial_rope(rms_norm(q.reshape(B, L, N_Q_HEADS, HEAD_DIM), q_norm), rows, cols)
    k = axial_rope(rms_norm(k.reshape(B, L, N_KV_HEADS, HEAD_DIM), k_norm), rows, cols)
    v = v.reshape(B, L, N_KV_HEADS, HEAD_DIM)
    y_att = window_attention(q, k, v, kc, vc, sink)
    y_sc = short_gated_conv_mix(s, sc_conv)
    x = x + g1 * (jnp.concatenate([y_att, y_sc], axis=-1) @ w_out)
    x = x + g2 * moe_swiglu(modulate(x, norm2, sh2, sc2), router_w, router_b, moe_wg, moe_wu, moe_wd)

    if need_ctx:
        qc = rms_norm(qc.reshape(B, n_ctx, N_Q_HEADS, HEAD_DIM), q_norm)
        yc = jnp.concatenate([context_attention(qc, kc, vc, sink), short_gated_conv_mix(sc_c, sc_conv)], axis=-1) @ w_out
        ctx = ctx + cg1 * yc
        ctx = ctx + cg2 * moe_swiglu(modulate(ctx, norm2, csh2, csc2), router_w, router_b, moe_wg, moe_wu, moe_wd)
    else:
        ctx = None
    return x, ctx


def setup_inputs(seed: int = 0) -> dict:
    key = jax.random.key(seed)
    ks = iter(jax.random.split(key, 48))
    f32 = jnp.float32
    D = D_MODEL
    NE, NO = N_EVEN, N_ODD

    def nrm(shape, scale):
        return jax.random.normal(next(ks), shape, f32) * scale

    def gain(shape):
        return 1.0 + nrm(shape, 0.02)

    return {
        "x": nrm((BATCH, SEQ, D), 1.0),
        "c": nrm((BATCH, D), 1.0),
        "ctx": nrm((BATCH, CTX_LEN, D), 1.0),
        "c_ctx": nrm((D,), 1.0),
        "e_ada_w": nrm((NE, D, N_MOD * D), D ** -0.5),
        "e_ada_b": nrm((NE, N_MOD * D), 0.02),
        "e_norm1": gain((NE, D)),
        "e_norm2": gain((NE, D)),
        "e_w_in": nrm((NE, D, EVEN_IN), D ** -0.5),
        "e_hy_short": nrm((NE, 3, 3 * HY_WIDTH), 3 ** -0.5),
        "e_hy_w1": nrm((NE, HY_EMB_DIM, HY_FILTER_HIDDEN), HY_EMB_DIM ** -0.5),
        "e_hy_b1": nrm((NE, HY_FILTER_HIDDEN), 0.02),
        "e_hy_freq": gain((NE, HY_FILTER_HIDDEN)),
        "e_hy_w2": nrm((NE, HY_FILTER_HIDDEN, HY_FILTER_HIDDEN), HY_FILTER_HIDDEN ** -0.5),
        "e_hy_b2": nrm((NE, HY_FILTER_HIDDEN), 0.02),
        "e_hy_w3": nrm((NE, HY_FILTER_HIDDEN, 2 * HY_WIDTH), HY_FILTER_HIDDEN ** -0.5),
        "e_hy_skip": nrm((NE, HY_WIDTH), 1.0),
        "e_w_out": nrm((NE, D, D), D ** -0.5),
        "e_ffn_wg": nrm((NE, D, D_FF), D ** -0.5),
        "e_ffn_wu": nrm((NE, D, D_FF), D ** -0.5),
        "e_ffn_wd": nrm((NE, D_FF, D), D_FF ** -0.5),
        "o_ada_w": nrm((NO, D, N_MOD * D), D ** -0.5),
        "o_ada_b": nrm((NO, N_MOD * D), 0.02),
        "o_norm1": gain((NO, D)),
        "o_norm2": gain((NO, D)),
        "o_w_in": nrm((NO, D, ODD_IN), D ** -0.5),
        "o_q_norm": gain((NO, HEAD_DIM)),
        "o_k_norm": gain((NO, HEAD_DIM)),
        "o_sink": nrm((NO, N_Q_HEADS), 0.5),
        "o_sc_conv": nrm((NO, 3, SC_WIDTH), 3 ** -0.5),
        "o_w_out": nrm((NO, D, D), D ** -0.5),
        "o_router_w": nrm((NO, D, N_EXPERTS), D ** -0.5),
        "o_router_b": nrm((NO, N_EXPERTS), 0.01),
        "o_moe_wg": nrm((NO, N_EXPERTS, D, D_FF_EXPERT), D ** -0.5),
        "o_moe_wu": nrm((NO, N_EXPERTS, D, D_FF_EXPERT), D ** -0.5),
        "o_moe_wd": nrm((NO, N_EXPERTS, D_FF_EXPERT, D), D_FF_EXPERT ** -0.5),
    }


def reference(x, c, ctx, c_ctx,
              e_ada_w, e_ada_b, e_norm1, e_norm2, e_w_in, e_hy_short, e_hy_w1, e_hy_b1, e_hy_freq,
              e_hy_w2, e_hy_b2, e_hy_w3, e_hy_skip, e_w_out, e_ffn_wg, e_ffn_wu, e_ffn_wd,
              o_ada_w, o_ada_b, o_norm1, o_norm2, o_w_in, o_q_norm, o_k_norm, o_sink, o_sc_conv,
              o_w_out, o_router_w, o_router_b, o_moe_wg, o_moe_wu, o_moe_wd):
    L = x.shape[1]
    n_rows = L // GRID_W
    rows = jnp.repeat(jnp.arange(n_rows, dtype=jnp.int32), GRID_W)
    cols = jnp.tile(jnp.arange(GRID_W, dtype=jnp.int32), n_rows)
    for layer in range(DEPTH):
        j = layer // 2
        need_ctx = layer < DEPTH - 1
        if layer % 2 == 0:
            mod_x = ada_params(c, e_ada_w[j], e_ada_b[j])
            mod_c = ada_params(c_ctx, e_ada_w[j], e_ada_b[j]) if need_ctx else None
            x, ctx = even_layer(x, ctx, mod_x, mod_c, e_norm1[j], e_norm2[j], e_w_in[j], e_hy_short[j],
                                e_hy_w1[j], e_hy_b1[j], e_hy_freq[j], e_hy_w2[j], e_hy_b2[j], e_hy_w3[j],
                                e_hy_skip[j], e_w_out[j], e_ffn_wg[j], e_ffn_wu[j], e_ffn_wd[j])
        else:
            mod_x = ada_params(c, o_ada_w[j], o_ada_b[j])
            mod_c = ada_params(c_ctx, o_ada_w[j], o_ada_b[j])
            x, ctx = odd_layer(x, ctx, mod_x, mod_c, rows, cols, need_ctx, o_norm1[j], o_norm2[j], o_w_in[j],
                               o_q_norm[j], o_k_norm[j], o_sink[j], o_sc_conv[j], o_w_out[j],
                               o_router_w[j], o_router_b[j], o_moe_wg[j], o_moe_wu[j], o_moe_wd[j])
    return x
```

```cpp
#include <hip/hip_runtime.h>
#include <cstdio>
#include <cstdint>
#ifndef N_LAUNCH_MODE
#define N_LAUNCH_MODE 1
#endif
#ifndef LAST_PHASE
#define LAST_PHASE 30
#endif
namespace pg8 {
#define PG8_LAS __attribute__((address_space(3)))
typedef unsigned short bf16_t;
typedef short bf16x8 __attribute__((ext_vector_type(8)));
typedef float f32x4 __attribute__((ext_vector_type(4)));
typedef unsigned u32x4 __attribute__((ext_vector_type(4)));
typedef int i32x4 __attribute__((ext_vector_type(4)));
typedef int i32x8 __attribute__((ext_vector_type(8)));
__device__ __forceinline__ i32x8 cat8(bf16x8 a, bf16x8 b) { const i32x4 x = __builtin_bit_cast(i32x4, a), y = __builtin_bit_cast(i32x4, b); return __builtin_shufflevector(x, y, 0, 1, 2, 3, 4, 5, 6, 7); }
constexpr int BM = 256, BK = 64, HALF = 128, HTB = HALF * BK * 2  , STAGE_BYTES = 8 * HTB, NXCD = 8, WGM = 8;

__host__ __device__ __forceinline__ int lds_byte(int r, int c) { const int st = (r >> 4) * 2 + (c >> 5), rr = r & 15, cc = c & 31, ob = rr * 64 + cc * 2; return st * 1024 + (ob ^ (((ob >> 9) & 1) << 5)); }
__host__ __device__ __forceinline__ void stage_rc(int b, int& R, int& C) { const int st = b / 1024, sb = b % 1024, swz = sb ^ (((sb >> 9) & 1) << 5); R = (st >> 1) * 16 + swz / 64; C = (st & 1) * 32 + (swz % 64) / 2; }
__host__ __device__ __forceinline__ int perm32(int rho) { const int n = rho >> 4, i = rho & 15; return 8 * (i >> 2) + 4 * n + (i & 3); }

struct Unit { int pm, pn, ko; };
struct Gemm { const bf16_t* A; const bf16_t* Bt; int M, N, K, ld; };
__device__ __forceinline__ unsigned cvt_pk_bf16(float lo, float hi) { unsigned r; asm volatile("v_cvt_pk_bf16_f32 %0, %1, %2" : "=v"(r) : "v"(lo), "v"(hi)); return r; }
template <class Epi, class Sched, bool ALIGN_EPI = false, bool SP2 = false, bool KSPLIT = false, bool FP8 = false>
__device__ __forceinline__ void gemm_phase(PG8_LAS unsigned char* lds, const Gemm g, const Sched& S, const Epi& E, int wid) {
    asm volatile("" : "+s"(wid));
    int lane; asm volatile("v_mbcnt_lo_u32_b32 %0, -1, 0\n\tv_mbcnt_hi_u32_b32 %0, -1, %0" : "=v"(lane)); lane &= 63;
    const int tid = (wid << 6) | lane, wr = wid >> 2, wc = wid & 3, fr = lane & 15, fq = lane >> 4;
    const int K = FP8 ? (g.K >> 1) : g.K, LD = KSPLIT ? (FP8 ? (g.ld >> 1) : g.ld) : K, nt = K / BK;
    unsigned voffA[2], voffB[2];
#pragma unroll
    for (int i = 0; i < 2; ++i) { int R, C; stage_rc(tid * 16 + i * 8192, R, C); const int Rb = Epi::PERM ? ((R & ~31) + perm32(R & 31)) : R;
        voffA[i] = (unsigned)(R * LD + C) * 2u; voffB[i] = (unsigned)(Rb * LD + C) * 2u; }
    const size_t kstep = (size_t)(BK * 2);
    const size_t hstep = (size_t)HALF * LD * 2;
    const size_t tstep = 2 * hstep;
    const unsigned ldsw = (unsigned)wid * 1024u;
    const int aoff = lds_byte(wr * 64 + fr, fq * 8), boff = lds_byte(wc * 32 + fr, fq * 8);
#define PG8_SA(b, h) (((b) * 2 + (h)) * HTB)
#define PG8_SB(b, h) ((4 + (b) * 2 + (h)) * HTB)
#define PG8_STAGE(bufoff, gbase, voff) do { const char* _g = (const char*)(gbase); asm volatile("" : "+s"(_g)); _Pragma("unroll") for (int _i = 0; _i < 2; ++_i) { unsigned _v = (voff)[_i]; asm volatile("" : "+v"(_v));   \
        __builtin_amdgcn_global_load_lds((const unsigned*)(_g + _v), (PG8_LAS unsigned*)(lds + (bufoff) + ldsw + _i * 8192), 16, 0, 0); } } while (0)
#define PG8_LDA(dst, b, h) do { _Pragma("unroll") for (int m = 0; m < 4; ++m) _Pragma("unroll") for (int k = 0; k < 2; ++k) dst[m][k] = *(const PG8_LAS bf16x8*)(lds + PG8_SA(b, h) + aoff + m * 2048 + k * 1024); } while (0)
#define PG8_LDB(dst, b, h) do { _Pragma("unroll") for (int n = 0; n < 2; ++n) _Pragma("unroll") for (int k = 0; k < 2; ++k) dst[n][k] = *(const PG8_LAS bf16x8*)(lds + PG8_SB(b, h) + boff + n * 2048 + k * 1024); } while (0)
#define PG8_MMA(ai, bj, At, Bt) do { __builtin_amdgcn_s_setprio(1); _Pragma("unroll") for (int m = 0; m < 4; ++m) _Pragma("unroll") for (int n = 0; n < 2; ++n) { \
        if constexpr (FP8) acc[ai][bj][m][n] = __builtin_amdgcn_mfma_scale_f32_16x16x128_f8f6f4(cat8(Bt[n][0], Bt[n][1]), cat8(At[m][0], At[m][1]), acc[ai][bj][m][n], 0, 0, 0, 0, 0, 0); \
        else { _Pragma("unroll") for (int k = 0; k < 2; ++k) acc[ai][bj][m][n] = __builtin_amdgcn_mfma_f32_16x16x32_bf16(Bt[n][k], At[m][k], acc[ai][bj][m][n], 0, 0, 0); } } __builtin_amdgcn_s_setprio(0); } while (0)
#define PG8_WAIT_V(n) asm volatile("s_waitcnt vmcnt(" #n ")" ::: "memory")
#define PG8_WAIT_L(n) asm volatile("s_waitcnt lgkmcnt(" #n ")" ::: "memory")
#define PG8_BAR __builtin_amdgcn_s_barrier()
#define PG8_SCHED __builtin_amdgcn_sched_barrier(0)
    Unit cur, nxt; int ui = 0;
    if (!S.next(0, cur)) return;
    f32x4 acc[2][2][4][2];
#pragma unroll
    for (int a = 0; a < 2; ++a)
#pragma unroll
        for (int b = 0; b < 2; ++b)
#pragma unroll
            for (int m = 0; m < 4; ++m)
#pragma unroll
                for (int n = 0; n < 2; ++n) acc[a][b][m][n] = (f32x4){0.f, 0.f, 0.f, 0.f};
    bf16x8 At[4][2], B0[2][2], B1[2][2];
    const char* cA = (const char*)g.A + (size_t)cur.pm * tstep + (KSPLIT ? cur.ko : 0); const char* cB = (const char*)g.Bt + (size_t)cur.pn * tstep + (KSPLIT ? cur.ko : 0);
    S.a_ready(cur);
    if constexpr (SP2) {
        PG8_STAGE(PG8_SB(0, 0), cB, voffB); PG8_STAGE(PG8_SB(0, 1), cB + hstep, voffB); PG8_STAGE(PG8_SA(0, 0), cA, voffA); PG8_STAGE(PG8_SA(0, 1), cA + hstep, voffA);
        if (wr == 1) PG8_BAR;
        PG8_WAIT_V(2); PG8_BAR;
        PG8_STAGE(PG8_SB(1, 0), cB + kstep, voffB); PG8_STAGE(PG8_SA(1, 0), cA + kstep, voffA); PG8_STAGE(PG8_SB(1, 1), cB + hstep + kstep, voffB);
        PG8_WAIT_V(6); PG8_BAR;
    } else {
        PG8_STAGE(PG8_SB(0, 0), cB, voffB); PG8_STAGE(PG8_SA(0, 0), cA, voffA); PG8_STAGE(PG8_SB(0, 1), cB + hstep, voffB); PG8_STAGE(PG8_SA(0, 1), cA + hstep, voffA);
        if (wr == 1) PG8_BAR;
        PG8_WAIT_V(4); PG8_BAR;
        PG8_STAGE(PG8_SB(1, 0), cB + kstep, voffB); PG8_STAGE(PG8_SA(1, 0), cA + kstep, voffA); PG8_STAGE(PG8_SB(1, 1), cB + hstep + kstep, voffB);
        PG8_WAIT_V(6); PG8_BAR;
    }
    for (;;) {
        const bool has_next = S.next(ui + 1, nxt);
        const char* nA = has_next ? (const char*)g.A + (size_t)nxt.pm * tstep + (KSPLIT ? nxt.ko : 0) : cA; const char* nB = has_next ? (const char*)g.Bt + (size_t)nxt.pn * tstep + (KSPLIT ? nxt.ko : 0) : cB;
        for (int t = 0; t < nt; t += 2) {
            const bool last = (t == nt - 2);
            const char* a1 = cA + (size_t)(t + 1) * kstep;
            const char* a2 = last ? nA : cA + (size_t)(t + 2) * kstep; const char* b2 = last ? nB : cB + (size_t)(t + 2) * kstep;
            const char* a3 = a2 + kstep; const char* b3 = b2 + kstep;
            if (last && has_next) S.a_ready(nxt);
            if constexpr (SP2) {
            PG8_LDB(B0, 0, 0); PG8_LDB(B1, 0, 1); PG8_SCHED; PG8_LDA(At, 0, 0); PG8_STAGE(PG8_SA(1, 1), a1 + hstep, voffA);
            PG8_WAIT_V(8); PG8_WAIT_L(0); PG8_BAR; PG8_MMA(0, 0, At, B0); PG8_MMA(0, 1, At, B1); PG8_BAR; PG8_SCHED;
            PG8_LDA(At, 0, 1); PG8_STAGE(PG8_SB(0, 0), b2, voffB); PG8_STAGE(PG8_SB(0, 1), b2 + hstep, voffB); PG8_STAGE(PG8_SA(0, 0), a2, voffA);
            PG8_WAIT_V(8); PG8_WAIT_L(0); PG8_BAR; PG8_MMA(1, 0, At, B0); PG8_MMA(1, 1, At, B1); PG8_BAR; PG8_SCHED;
            PG8_LDB(B0, 1, 0); PG8_LDB(B1, 1, 1); PG8_SCHED; PG8_LDA(At, 1, 0); PG8_STAGE(PG8_SA(0, 1), a2 + hstep, voffA);
            PG8_WAIT_V(8); PG8_WAIT_L(0); PG8_BAR; PG8_MMA(0, 0, At, B0); PG8_MMA(0, 1, At, B1); PG8_BAR; PG8_SCHED;
            PG8_LDA(At, 1, 1); PG8_STAGE(PG8_SB(1, 0), b3, voffB); PG8_STAGE(PG8_SB(1, 1), b3 + hstep, voffB); PG8_STAGE(PG8_SA(1, 0), a3, voffA);
            PG8_WAIT_V(8); PG8_WAIT_L(0); PG8_BAR; PG8_MMA(1, 0, At, B0); PG8_MMA(1, 1, At, B1); PG8_BAR; PG8_SCHED;
            } else {
            PG8_LDB(B0, 0, 0); PG8_SCHED; PG8_LDA(At, 0, 0); PG8_STAGE(PG8_SA(1, 1), a1 + hstep, voffA);
            PG8_WAIT_L(8); PG8_BAR; PG8_WAIT_L(0); PG8_MMA(0, 0, At, B0); PG8_BAR; PG8_SCHED;
            PG8_LDB(B1, 0, 1); PG8_STAGE(PG8_SB(0, 0), b2, voffB);
            PG8_BAR; PG8_WAIT_L(0); PG8_MMA(0, 1, At, B1); PG8_BAR;
            PG8_LDA(At, 0, 1); PG8_STAGE(PG8_SA(0, 0), a2, voffA);
            PG8_BAR; PG8_WAIT_L(0); PG8_MMA(1, 0, At, B0); PG8_BAR; PG8_SCHED;
            PG8_STAGE(PG8_SB(0, 1), b2 + hstep, voffB);
            PG8_WAIT_V(6); PG8_BAR; PG8_MMA(1, 1, At, B1); PG8_BAR;
            PG8_LDB(B0, 1, 0); PG8_SCHED; PG8_LDA(At, 1, 0); PG8_STAGE(PG8_SA(0, 1), a2 + hstep, voffA);
            PG8_WAIT_L(8); PG8_BAR; PG8_WAIT_L(0); PG8_MMA(0, 0, At, B0); PG8_BAR; PG8_SCHED;
            PG8_LDB(B1, 1, 1); PG8_STAGE(PG8_SB(1, 0), b3, voffB);
            PG8_BAR; PG8_WAIT_L(0); PG8_MMA(0, 1, At, B1); PG8_BAR;
            PG8_LDA(At, 1, 1); PG8_STAGE(PG8_SA(1, 0), a3, voffA);
            PG8_BAR; PG8_WAIT_L(0); PG8_MMA(1, 0, At, B0); PG8_BAR; PG8_SCHED;
            PG8_STAGE(PG8_SB(1, 1), b3 + hstep, voffB);
            PG8_WAIT_V(6); PG8_BAR; PG8_MMA(1, 1, At, B1); PG8_BAR;
            }
        }
        if constexpr (ALIGN_EPI) { if (wr == 0) PG8_BAR; }
        if constexpr (!Epi::AFTER_DRAIN) { E(acc, cur, wr, wc, fr, fq); S.done(cur); }
        if (!has_next) break;
#pragma unroll
        for (int a = 0; a < 2; ++a)
#pragma unroll
            for (int b = 0; b < 2; ++b)
#pragma unroll
                for (int m = 0; m < 4; ++m)
#pragma unroll
                    for (int n = 0; n < 2; ++n) acc[a][b][m][n] = (f32x4){0.f, 0.f, 0.f, 0.f};
        cur = nxt; cA = nA; cB = nB; ++ui;
        if constexpr (ALIGN_EPI) { if (wr == 1) PG8_BAR; }
    }
    PG8_WAIT_V(0);
    if constexpr (!ALIGN_EPI) { if (wr == 0) PG8_BAR; }
    PG8_BAR;
    if constexpr (Epi::AFTER_DRAIN) { E.fused(acc, cur, wr, wc, fr, fq, lds, wid, lane); S.done(cur); }
#undef PG8_SA
#undef PG8_SB
#undef PG8_STAGE
#undef PG8_LDA
#undef PG8_LDB
#undef PG8_MMA
#undef PG8_WAIT_V
#undef PG8_WAIT_L
#undef PG8_BAR
#undef PG8_SCHED
}
}

constexpr int DM = 1024, SEQL = 16384, CTXL = 256, T_LAT = 32768, T_CTX = 512, T_ALL = 33280;
constexpr int N1 = 2816;
constexpr int DFF = 2816, N2 = 2304, DFE = 3584, NEXP = 8;
constexpr int HYW = 768;
constexpr int UTP = SEQL + 64;
constexpr int F1P = SEQL + 32;
constexpr int NWAVES = 8, NTHR = 512;
constexpr int MAXPANELS = 272;
constexpr int CHUNKP = 128;
constexpr int NCHUNK = 6;
constexpr int PE_NSTEP = 403, PE_SD = 2600, PE_SG = 2632, PE_SX = 2664, PE_SND = 2696;
constexpr int XPANELS = 16;
constexpr int PE_CNP = 416, PE_LIST = 512, PE_RES = 1536;

constexpr size_t MiB = 1u << 20;
constexpr size_t WS_CTL = 0, CTL_ZERO_BYTES = 1 * MiB;
constexpr size_t WS_ADA = 1 * MiB;
constexpr size_t WS_XC = 2 * MiB;
constexpr size_t WS_TOKE = 4 * MiB;
constexpr size_t WS_TOKG = 4 * MiB + 256 * 1024;
constexpr size_t WS_BLKCNT = 4 * MiB + 512 * 1024;
constexpr size_t WS_PANELE = 4 * MiB + 528 * 1024;
constexpr size_t WS_SLOTTOK = 5 * MiB;
constexpr size_t WS_SLOTW = 5 * MiB + 512 * 1024;
constexpr size_t WS_KC = 6 * MiB;
constexpr size_t WS_VCT = 6 * MiB + 256 * 1024;
constexpr size_t WS_H2C = 7 * MiB;
constexpr size_t WS_KTC = 8 * MiB;
constexpr size_t WS_H2 = 11 * MiB;
constexpr size_t WS_W_EIN = 16 * MiB, WS_W_EOUT = 22 * MiB, WS_W_FGU = 24 * MiB, WS_W_FD = 35 * MiB, WS_W_OIN = 41 * MiB, WS_W_OOUT = 46 * MiB;
constexpr size_t WS_H = 48 * MiB;
constexpr size_t WS_A2 = 113 * MiB;
constexpr size_t ACTM_HALF = (size_t)CHUNKP * 256 * DFE;
constexpr size_t WS_ACTM2 = 246 * MiB;
constexpr size_t WS_ACTM = 48 * MiB;
constexpr size_t WS_ACTX = 16 * MiB;
constexpr size_t WS_BIG = 178 * MiB;
constexpr size_t WS_X0C = 48 * MiB;
constexpr size_t WS_YT = 178 * MiB;
constexpr size_t WS_YF = 178 * MiB + 64 * MiB;
constexpr size_t WS_T = 358 * MiB;
constexpr size_t WS_UT = WS_T;
constexpr size_t WS_PART = WS_T + 49 * MiB;
constexpr size_t WS_F1T = WS_T + 81 * MiB;
constexpr size_t WS_KT = WS_T + 114 * MiB;
constexpr size_t WS_PARTC = WS_T;
constexpr size_t WS_QR = WS_T;
constexpr size_t WS_KR = WS_T + 32 * MiB;
constexpr size_t WS_VT = WS_T + 40 * MiB;
constexpr size_t WS_WMGU = WS_T + 56 * MiB;
constexpr size_t WS_WMD = WS_T + 112 * MiB;
constexpr size_t WS_END = 526 * MiB;
static_assert(WS_KT + (size_t)1536 * UTP * 2 <= WS_END && WS_UT + (size_t)1536 * UTP * 2 <= WS_PART && WS_F1T + (size_t)512 * F1P * 4 <= WS_KT && WS_VT + (size_t)256 * UTP * 2 <= WS_T + 49 * MiB && WS_WMD + (size_t)8 * 1024 * 3584 * 2 <= WS_END, "ws map");
static_assert(WS_BIG + (size_t)T_ALL * N1 * 2 <= WS_T && WS_A2 + (size_t)T_ALL * DM * 2 <= WS_BIG && WS_ACTM + ACTM_HALF <= WS_BIG && WS_BIG + (size_t)69632 * 1024 <= WS_ACTM2 && WS_ACTM2 + ACTM_HALF <= WS_T, "ws map");
constexpr int CW_BAR = 4096;

constexpr int LDS_BYTES = 147456;
constexpr int LDS_WORK = 139264;
constexpr int LDS_RED = 139264;
constexpr int LDS_MISC = 146432;
constexpr int WAVE_SCR = 17408;

#define LAS __attribute__((address_space(3)))
typedef unsigned short bf16;
typedef unsigned v4u __attribute__((ext_vector_type(4)));
typedef unsigned v2u __attribute__((ext_vector_type(2)));
typedef float f32x4 __attribute__((ext_vector_type(4)));
typedef float f32x2 __attribute__((ext_vector_type(2)));
typedef float f32x16 __attribute__((ext_vector_type(16)));
typedef short bf16x8 __attribute__((ext_vector_type(8)));
typedef short s16x4 __attribute__((ext_vector_type(4)));

struct Args { const float* in[36]; float* out; unsigned char* ws; int ph_lo, ph_hi; };
struct Ctx { const float* const (&in)[36]; float* const& out; unsigned char* const& ws; const int wv; };
__device__ __forceinline__ int lane_id() { int l; asm volatile("v_mbcnt_lo_u32_b32 %0, -1, 0\n\tv_mbcnt_hi_u32_b32 %0, -1, %0" : "=v"(l)); return l & 63; }
__device__ __forceinline__ int wave_of(int wv) { asm volatile("" : "+s"(wv)); return wv; }
__device__ __forceinline__ int tid_of(int wv) { return (wave_of(wv) << 6) | lane_id(); }

__device__ __forceinline__ unsigned f2bf(float f) { unsigned u = __float_as_uint(f); return (u + 0x7fffu + ((u >> 16) & 1u)) >> 16; }
__device__ __forceinline__ unsigned pk2(float lo, float hi) { return f2bf(lo) | (f2bf(hi) << 16); }
__device__ __forceinline__ float bf2f(unsigned h) { return __uint_as_float(h << 16); }
__device__ __forceinline__ float bflo(unsigned w) { return __uint_as_float(w << 16); }
__device__ __forceinline__ float bfhi(unsigned w) { return __uint_as_float(w & 0xffff0000u); }
__device__ __forceinline__ float wave_sum(float v) {
#pragma unroll
    for (int o = 1; o < 64; o <<= 1) v += __shfl_xor(v, o);
    return v;
}
__device__ __forceinline__ float siluf(float x) { return x / (1.0f + __expf(-x)); }

#define XB_TMO      128
#define XB_XCNT(j)  (256  + 64 * (j))
#define XB_XSUB(j)  (1280 + 64 * (j))
#define XB_XGEN(j)  (2304 + 64 * (j))
#define XB_TOP      3328
#define XB_TOPGEN   3392
#define XCD_BAR_WORDS 3456
#define XB_SPIN_CAP (1u << 20)

__device__ __forceinline__ unsigned xb_ld(unsigned* p)              { return __hip_atomic_load(p, __ATOMIC_RELAXED, __HIP_MEMORY_SCOPE_AGENT); }
__device__ __forceinline__ unsigned xb_add(unsigned* p, unsigned v) { return __hip_atomic_fetch_add(p, v, __ATOMIC_RELAXED, __HIP_MEMORY_SCOPE_AGENT); }
__device__ __forceinline__ unsigned xb_xcc_id() { return (unsigned)__builtin_amdgcn_s_getreg((3 << 11) | 20) & 0xFu; }
#define XB_SPIN(cond, bar) do { unsigned _sp = 0; while (cond) { __builtin_amdgcn_s_sleep(1); \
    if ((++_sp & 255u) == 0u) { if (xb_ld(&(bar)[XB_TMO])) break; if (_sp > XB_SPIN_CAP) { atomicAdd(&(bar)[XB_TMO], 1u); break; } } } } while (0)

struct XcdBarrier {
    unsigned* bar; unsigned x; int wv;
    volatile LAS unsigned* st;
};
__device__ __forceinline__ XcdBarrier xcd_barrier_post(unsigned* bar, volatile LAS unsigned* st, int wv) {
    XcdBarrier b; b.bar = bar; b.x = xb_xcc_id(); b.st = st; b.wv = wv;
    if (tid_of(wv) == 0) (void)xb_add(&bar[XB_XCNT(b.x)], 1u);
    return b;
}
__device__ __forceinline__ void xcd_barrier_complete(unsigned* bar, unsigned x, unsigned& nloc, unsigned& nx) {
    const unsigned G = gridDim.x * gridDim.y * gridDim.z;
    unsigned sum, cnt, mine, sp = 0u;
    for (;;) {
        sum = 0u; cnt = 0u; mine = 0u;
#pragma unroll
        for (unsigned j = 0; j < 16; ++j) { const unsigned c = xb_ld(&bar[XB_XCNT(j)]); sum += c; cnt += (c > 0u) ? 1u : 0u; mine = (j == x) ? c : mine; }
        if (sum == G) break;
        __builtin_amdgcn_s_sleep(1);
        if ((++sp & 255u) == 0u) { if (xb_ld(&bar[XB_TMO])) break; if (sp > XB_SPIN_CAP) { atomicAdd(&bar[XB_TMO], 1u); break; } }
    }
    nloc = mine > 0u ? mine : 1u; nx = cnt > 0u ? cnt : 1u;
}
__device__ __forceinline__ void xcd_barrier(const XcdBarrier& b) {
    asm volatile("s_waitcnt vmcnt(0)" ::: "memory");
    __syncthreads();
    if (tid_of(b.wv) == 0) {
        unsigned* bar = b.bar;
        __builtin_amdgcn_s_waitcnt(0);
        unsigned nloc = b.st[0], nx = b.st[1];
        if (nloc == 0u) { xcd_barrier_complete(bar, b.x, nloc, nx); b.st[0] = nloc; b.st[1] = nx; }
        const unsigned old = xb_add(&bar[XB_XSUB(b.x)], 1u);
        const unsigned gen = old / nloc;
        if (old + 1u == (gen + 1u) * nloc) {
            __builtin_amdgcn_fence(__ATOMIC_RELEASE, "agent");
            asm volatile("s_waitcnt vmcnt(0)" ::: "memory");
            const unsigned og = xb_add(&bar[XB_TOP], 1u);
            const unsigned tg = og / nx;
            if (og + 1u == (tg + 1u) * nx) xb_add(&bar[XB_TOPGEN], 1u);
            else XB_SPIN(xb_ld(&bar[XB_TOPGEN]) == tg, bar);
            __builtin_amdgcn_fence(__ATOMIC_ACQUIRE, "agent");
            xb_add(&bar[XB_XGEN(b.x)], 1u);
            asm volatile("s_waitcnt vmcnt(0)" ::: "memory");
        } else {
            XB_SPIN(xb_ld(&bar[XB_XGEN(b.x)]) == gen, bar);
            __builtin_amdgcn_fence(__ATOMIC_ACQUIRE, "agent");
            asm volatile("s_waitcnt vmcnt(0)" ::: "memory");
        }
    }
    __syncthreads();
}

namespace pg8 {
struct StaticOrder {
    int nM, nN, nwg, G, c;
    __device__ __forceinline__ void init(int M, int N, int G_, int c_) { nM = M / BM; nN = N / BM; nwg = nM * nN; G = G_; c = c_; }
    __device__ __forceinline__ bool next(int i, Unit& u) const {
        const long L = (long)i * G + c; if (L >= nwg) return false;
        int wgid = (int)L; { const int q = nwg / NXCD, r = nwg % NXCD, xcd = wgid % NXCD, off = wgid / NXCD; wgid = (xcd < r ? xcd * (q + 1) : r * (q + 1) + (xcd - r) * q) + off; }
        const int nig = WGM * nN, gid = wgid / nig, fm = gid * WGM, gsz = (nM - fm) < WGM ? (nM - fm) : WGM;
        u.pm = fm + ((wgid % nig) % gsz); u.pn = (wgid % nig) / gsz; u.ko = 0; return true;
    }
    __device__ __forceinline__ void a_ready(const Unit&) const {}
    __device__ __forceinline__ void done(const Unit&) const {}
};
struct OrderL1In {
    StaticOrder S; int G, c;
    __device__ __forceinline__ void init(int G_, int c_) { S.init(32768, 2304, G_, c_); G = G_; c = c_; }
    __device__ __forceinline__ bool next(int i, Unit& u) const {
        const long L = (long)i * G + c;
        if (L < S.nwg) return S.next(i, u);
        const int r = (int)(L - S.nwg); if (r >= 2) return false;
        u.pm = 128 + r; u.pn = 2; u.ko = 0; return true;
    }
    __device__ __forceinline__ void a_ready(const Unit&) const {}
    __device__ __forceinline__ void done(const Unit&) const {}
};
struct OrderMoe {
    const int* panel_e; const int* list; int np, ncol, G, c, down, nd;
    __device__ __forceinline__ bool next(int i, Unit& u) const {
        int pl, j;
        if (np == 128 && G == 256) {
            int ii = i, cc = c;
            if (nd > 0) {
                const int sk = (5 * nd <= 256) ? 4 : 3;
                if (c < nd) { ii = i + sk; if (ii >= ncol / 2) return false; }
                else if (i >= ncol / 2) { const int e = c - nd; if (i > ncol / 2 || e >= sk * nd) return false; ii = e / nd; cc = e % nd; }
            } else if ((long)i * G + c >= (long)np * ncol) return false;
            const int x = cc & 7, k = cc >> 3, ntg = ncol >> 2, hf = ii / ntg, tg = ii - hf * ntg; pl = 16 * x + 8 * hf + (k & 7); j = 4 * tg + (k >> 3);
        } else { const long L = (long)i * G + c; if (L >= (long)np * ncol) return false; pl = (int)(L % np); j = (int)(L / np); }
        const int pabs = __builtin_amdgcn_readfirstlane(list[pl]);
        u.pm = down ? (pabs & 127) : pabs; u.pn = __builtin_amdgcn_readfirstlane(panel_e[pabs]) * ncol + j; u.ko = 0; return true;
    }
    __device__ __forceinline__ void a_ready(const Unit&) const {}
    __device__ __forceinline__ void done(const Unit&) const {}
};

template <int KOB = 512>
struct OrderCtxSplitT {
    int ntile, nks, G, c;
    __device__ __forceinline__ bool next(int i, Unit& u) const {
        const int e = i * G + c; if (e >= 2 * ntile * nks) return false;
        u.pm = 128 + (e & 1); u.pn = (e >> 1) % ntile; u.ko = ((e >> 1) / ntile) * KOB; return true;
    }
    __device__ __forceinline__ void a_ready(const Unit&) const {}
    __device__ __forceinline__ void done(const Unit&) const {}
};
typedef OrderCtxSplitT<512> OrderCtxSplit;

struct EpiStoreBf16 {
    static constexpr bool PERM = true, AFTER_DRAIN = false;
    bf16_t* O; int ldc;
    __device__ __forceinline__ void operator()(const f32x4 (&acc)[2][2][4][2], const Unit& u, int wr, int wc, int fr, int fq) const {
        const int row0 = u.pm * BM + wr * 64 + fr, col0 = u.pn * BM + wc * 32 + 8 * fq;
#pragma unroll
        for (int ai = 0; ai < 2; ++ai)
#pragma unroll
            for (int m = 0; m < 4; ++m) { bf16_t* rowp = O + (size_t)(row0 + ai * HALF + m * 16) * ldc + col0;
#pragma unroll
                for (int bj = 0; bj < 2; ++bj) { const f32x4 v0 = acc[ai][bj][m][0], v1 = acc[ai][bj][m][1];
                    u32x4 w; w.x = cvt_pk_bf16(v0[0], v0[1]); w.y = cvt_pk_bf16(v0[2], v0[3]); w.z = cvt_pk_bf16(v1[0], v1[1]); w.w = cvt_pk_bf16(v1[2], v1[3]);
                    *(u32x4*)(rowp + bj * HALF) = w; } }
    }
};
__device__ __forceinline__ float silu_fast(float x) { return x * __builtin_amdgcn_rcpf(1.0f + __expf(-x)); }
typedef float f32x2 __attribute__((ext_vector_type(2)));
__device__ __forceinline__ f32x2 swiglu2(f32x2 g, f32x2 u, float gs, float us) {
    const f32x2 t = g * (-1.4426950408889634f * gs);
    f32x2 d; d.x = __builtin_amdgcn_exp2f(t.x); d.y = __builtin_amdgcn_exp2f(t.y);
    d = d + 1.0f;
    f32x2 rc; rc.x = __builtin_amdgcn_rcpf(d.x); rc.y = __builtin_amdgcn_rcpf(d.y);
    return (g * rc) * (u * (gs * us));
}
struct EpiSwiglu {
    static constexpr bool PERM = true, AFTER_DRAIN = false;
    bf16_t* O; int ldc; int pm_mask; int ncol;
    __device__ __forceinline__ void operator()(const f32x4 (&acc)[2][2][4][2], const Unit& u, int wr, int wc, int fr, int fq) const {
        const int row0 = (u.pm & pm_mask) * BM + wr * 64 + fr, col0 = (u.pn % ncol) * HALF + wc * 32 + 8 * fq;
#pragma unroll
        for (int ai = 0; ai < 2; ++ai)
#pragma unroll
            for (int m = 0; m < 4; ++m) { bf16_t* rowp = O + (size_t)(row0 + ai * HALF + m * 16) * ldc + col0;
                const f32x4 g0 = acc[ai][0][m][0], g1 = acc[ai][0][m][1], u0 = acc[ai][1][m][0], u1 = acc[ai][1][m][1];
                float r[8];
#pragma unroll
                for (int j = 0; j < 2; ++j) { const f32x2 a0 = swiglu2((f32x2){g0[2 * j], g0[2 * j + 1]}, (f32x2){u0[2 * j], u0[2 * j + 1]}, 1.0f, 1.0f), a1 = swiglu2((f32x2){g1[2 * j], g1[2 * j + 1]}, (f32x2){u1[2 * j], u1[2 * j + 1]}, 1.0f, 1.0f);
                    r[2 * j] = a0.x; r[2 * j + 1] = a0.y; r[4 + 2 * j] = a1.x; r[5 + 2 * j] = a1.y; }
                u32x4 w; w.x = cvt_pk_bf16(r[0], r[1]); w.y = cvt_pk_bf16(r[2], r[3]); w.z = cvt_pk_bf16(r[4], r[5]); w.w = cvt_pk_bf16(r[6], r[7]);
                *(u32x4*)rowp = w; }
    }
};
constexpr float F8_SX = 16.f, F8_SW = 256.f, F8_SA = 8.f;
__device__ __forceinline__ unsigned pk4_fp8(float a, float b, float c, float d) {
    a = __builtin_amdgcn_fmed3f(a, -448.f, 448.f); b = __builtin_amdgcn_fmed3f(b, -448.f, 448.f); c = __builtin_amdgcn_fmed3f(c, -448.f, 448.f); d = __builtin_amdgcn_fmed3f(d, -448.f, 448.f);
    int w = __builtin_amdgcn_cvt_pk_fp8_f32(a, b, 0, false); w = __builtin_amdgcn_cvt_pk_fp8_f32(c, d, w, true); return (unsigned)w; }
template <int INSC = 4096>
struct EpiSwigluF8T {
    static constexpr bool PERM = true, AFTER_DRAIN = false;
    unsigned char* O; int ldc; int pm_mask; int ncol;
    __device__ __forceinline__ void operator()(const f32x4 (&acc)[2][2][4][2], const Unit& u, int wr, int wc, int fr, int fq) const {
        const int row0 = (u.pm & pm_mask) * BM + wr * 64 + fr, col0 = (u.pn % ncol) * HALF + wc * 32 + 8 * fq;
        constexpr float gi = 1.0f / (float)INSC, ui = F8_SA / (float)INSC;
#pragma unroll
        for (int ai = 0; ai < 2; ++ai)
#pragma unroll
            for (int m = 0; m < 4; ++m) { unsigned char* rowp = O + (size_t)(row0 + ai * HALF + m * 16) * ldc + col0;
                const f32x4 g0 = acc[ai][0][m][0], g1 = acc[ai][0][m][1], u0 = acc[ai][1][m][0], u1 = acc[ai][1][m][1];
                float r[8];
#pragma unroll
                for (int j = 0; j < 2; ++j) { const f32x2 a0 = swiglu2((f32x2){g0[2 * j], g0[2 * j + 1]}, (f32x2){u0[2 * j], u0[2 * j + 1]}, gi, ui), a1 = swiglu2((f32x2){g1[2 * j], g1[2 * j + 1]}, (f32x2){u1[2 * j], u1[2 * j + 1]}, gi, ui);
                    r[2 * j] = a0.x; r[2 * j + 1] = a0.y; r[4 + 2 * j] = a1.x; r[5 + 2 * j] = a1.y; }
                typedef unsigned u32x2 __attribute__((ext_vector_type(2)));
                u32x2 w; w.x = pk4_fp8(r[0], r[1], r[2], r[3]); w.y = pk4_fp8(r[4], r[5], r[6], r[7]);
                *(u32x2*)rowp = w; }
    }
};
typedef EpiSwigluF8T<4096> EpiSwigluF8;
template <int SDIV = 1>
struct EpiResidT {
    static constexpr bool PERM = false, AFTER_DRAIN = false;
    const float* src_lat; const float* src_ctx; float* dst_lat; float* dst_ctx; const float* gate;
    __device__ __forceinline__ void operator()(const f32x4 (&acc)[2][2][4][2], const Unit& u, int wr, int wc, int fr, int fq) const {
        const bool isctx = u.pm >= 128; const int cond = isctx ? 2 : (u.pm >> 6);
        const int row0 = (isctx ? u.pm - 128 : u.pm) * BM + wr * 64 + fr, col0 = u.pn * BM + wc * 32 + 4 * fq;
        const float* sp = isctx ? src_ctx : src_lat; float* dp = isctx ? dst_ctx : dst_lat;
        f32x4 gv[2][2];
#pragma unroll
        for (int bj = 0; bj < 2; ++bj)
#pragma unroll
            for (int n = 0; n < 2; ++n) gv[bj][n] = *(const f32x4*)(gate + cond * 6144 + col0 + bj * HALF + n * 16) * (1.0f / (float)SDIV);
#pragma unroll
        for (int ai = 0; ai < 2; ++ai)
#pragma unroll
            for (int m = 0; m < 4; ++m) { const size_t off = (size_t)(row0 + ai * HALF + m * 16) * 1024 + col0;
#pragma unroll
                for (int bj = 0; bj < 2; ++bj)
#pragma unroll
                    for (int n = 0; n < 2; ++n) { const f32x4 s = *(const f32x4*)(sp + off + bj * HALF + n * 16); *(f32x4*)(dp + off + bj * HALF + n * 16) = s + gv[bj][n] * acc[ai][bj][m][n]; } }
    }
};
typedef EpiResidT<1> EpiResid;
template <int KOSH = 9, int SDIV = 1>
struct EpiPartialT {
    static constexpr bool PERM = false, AFTER_DRAIN = false;
    float* P;
    __device__ __forceinline__ void operator()(const f32x4 (&acc)[2][2][4][2], const Unit& u, int wr, int wc, int fr, int fq) const {
        const int row0 = (u.pm - 128) * BM + wr * 64 + fr, col0 = u.pn * BM + wc * 32 + 4 * fq;
        float* base = P + (size_t)(u.ko >> KOSH) * 512 * 1024;
#pragma unroll
        for (int ai = 0; ai < 2; ++ai)
#pragma unroll
            for (int m = 0; m < 4; ++m) { float* rp = base + (size_t)(row0 + ai * HALF + m * 16) * 1024 + col0;
#pragma unroll
                for (int bj = 0; bj < 2; ++bj)
#pragma unroll
                    for (int n = 0; n < 2; ++n) *(f32x4*)(rp + bj * HALF + n * 16) = acc[ai][bj][m][n] * (1.0f / (float)SDIV); }
    }
};
typedef EpiPartialT<9, 1> EpiPartial;
struct EpiMoeDown {
    static constexpr bool PERM = false, AFTER_DRAIN = false;
    float* out; const float* gate; const int* slot_tok; const float* slot_w; const int* res2abs;
    __device__ __forceinline__ void operator()(const f32x4 (&acc)[2][2][4][2], const Unit& u, int wr, int wc, int fr, int fq) const {
        const int slot0 = __builtin_amdgcn_readfirstlane(res2abs[u.pm]) * BM + wr * 64 + fr, col0 = (u.pn & 3) * BM + wc * 32 + 4 * fq;
#pragma unroll
        for (int ai = 0; ai < 2; ++ai)
#pragma unroll
            for (int m = 0; m < 4; ++m) { const int s = slot0 + ai * HALF + m * 16; const int tok = slot_tok[s];
                if (tok >= 0) { const float w = slot_w[s] * (1.0f / (F8_SA * F8_SW)); const float* gp = gate + (tok >> 14) * 6144 + col0; float* op = out + (size_t)tok * 1024 + col0;
#pragma unroll
                    for (int bj = 0; bj < 2; ++bj)
#pragma unroll
                        for (int n = 0; n < 2; ++n) { const f32x4 g = *(const f32x4*)(gp + bj * HALF + n * 16); const f32x4 o = *(const f32x4*)(op + bj * HALF + n * 16);
                            *(f32x4*)(op + bj * HALF + n * 16) = o + (g * w) * acc[ai][bj][m][n]; } } }
    }
};
}

#define DI __device__ __forceinline__
#define GW_DECL const int lane = lane_id(), wave = wave_of(a.wv), tid = (wave << 6) | lane, G = gridDim.x, gw = blockIdx.x * NWAVES + wave, NGW = G * NWAVES; (void)gw; (void)NGW; (void)lane; (void)wave; (void)G

DI void ada_item(const Ctx& a, int item, LAS float* red) {
    GW_DECL;
    const int lyr = item / 128, cc = item % 128;
    const float* W = a.in[lyr ? 21 : 4]; const float* B = a.in[lyr ? 22 : 5];
    float* ADA = (float*)(a.ws + WS_ADA);
    LAS float* sil = red + 2048;
    for (int i = tid; i < 3072; i += NTHR) { const int j = i >> 10, k = i & 1023; const float cv = (j == 0) ? a.in[1][k] : (j == 1) ? a.in[1][1024 + k] : a.in[3][k]; sil[i] = siluf(cv); }
    __syncthreads();
    const int col = cc * 48 + (lane < 48 ? lane : 47);
    float acc0 = 0.f, acc1 = 0.f, acc2 = 0.f;
    const int k0 = wave * 128;
#pragma unroll 16
    for (int k = k0; k < k0 + 128; ++k) {
        const float wv = W[(size_t)k * 6144 + col];
        acc0 += sil[k] * wv; acc1 += sil[1024 + k] * wv; acc2 += sil[2048 + k] * wv;
    }
    red[(wave * 3 + 0) * 64 + lane] = acc0; red[(wave * 3 + 1) * 64 + lane] = acc1; red[(wave * 3 + 2) * 64 + lane] = acc2;
    __syncthreads();
    if (tid < 192) { const int j = tid >> 6, l = tid & 63;
        if (l < 48) { float s = B[cc * 48 + l];
#pragma unroll
            for (int w = 0; w < 8; ++w) s += red[(w * 3 + j) * 64 + l];
            ADA[(lyr * 3 + j) * 6144 + cc * 48 + l] = s; } }
    __syncthreads();
}

DI void filt_hidden_item(const Ctx& a, int item, LAS float* sm) {
    GW_DECL;
    LAS float* w1s = sm;
    LAS float* b1s = sm + 2112;
    LAS float* frs = sm + 2176;
    LAS float* w2s = sm + 2240;
    LAS float* b2s = sm + 6336;
    LAS float* xch = sm + 6400;
    const float* w1 = a.in[10]; const float* b1 = a.in[11]; const float* fr = a.in[12]; const float* w2 = a.in[13]; const float* b2 = a.in[14];
    for (int i = tid; i < 2112; i += NTHR) w1s[i] = w1[i];
    for (int i = tid; i < 4096; i += NTHR) w2s[i] = w2[i];
    if (tid < 64) { b1s[tid] = b1[tid]; frs[tid] = fr[tid]; b2s[tid] = b2[tid]; }
    __syncthreads();
    const bool isctx = item >= 64;
    const int Ln = isctx ? CTXL : SEQL;
    const int pos = tid & 255, hh = __builtin_amdgcn_readfirstlane(tid >> 8);
    const int n = isctx ? pos : item * 256 + pos;
    float* H = isctx ? (float*)(a.ws + WS_H2C) : (float*)(a.ws + WS_H2);
    float z[33];
    z[0] = (float)n / (float)(Ln - 1);
#pragma unroll
    for (int q = 0; q < 16; ++q) { const float fq = 1e-4f + (float)q * ((15.0f - 1e-4f) / 15.0f); const float x = (float)n * fq / (float)Ln;
        z[1 + q] = __builtin_amdgcn_cosf(x); z[17 + q] = -__builtin_amdgcn_sinf(x); }
    f32x4 acc2[16];
#pragma unroll
    for (int o4 = 0; o4 < 16; ++o4) acc2[o4] = hh ? (f32x4){0.f, 0.f, 0.f, 0.f} : *(LAS f32x4*)(b2s + o4 * 4);
#pragma unroll 1
    for (int ii = 0; ii < 32; ++ii) { const int i = hh * 32 + ii;
        float acc = b1s[i];
#pragma unroll
        for (int q = 0; q < 33; ++q) acc += z[q] * w1s[q * 64 + i];
        const float h1 = __builtin_amdgcn_sinf(frs[i] * acc * 0.15915494309189535f);
#pragma unroll
        for (int o4 = 0; o4 < 16; ++o4) acc2[o4] += h1 * *(LAS f32x4*)(w2s + i * 64 + o4 * 4);
    }
    f32x4 mine[8];
    if (hh) {
#pragma unroll
        for (int o4 = 0; o4 < 8; ++o4) { mine[o4] = acc2[8 + o4];
#pragma unroll
            for (int j = 0; j < 4; ++j) xch[tid * 33 + o4 * 4 + j] = acc2[o4][j]; }
    } else {
#pragma unroll
        for (int o4 = 0; o4 < 8; ++o4) { mine[o4] = acc2[o4];
#pragma unroll
            for (int j = 0; j < 4; ++j) xch[tid * 33 + o4 * 4 + j] = acc2[8 + o4][j]; }
    }
    __syncthreads();
    const int ptid = tid ^ 256;
#pragma unroll
    for (int o4 = 0; o4 < 8; ++o4) { const f32x4 f = *(LAS f32x4*)(frs + hh * 32 + o4 * 4); f32x4 v;
#pragma unroll
        for (int j = 0; j < 4; ++j) v[j] = __builtin_amdgcn_sinf(f[j] * (mine[o4][j] + xch[ptid * 33 + o4 * 4 + j]) * 0.15915494309189535f);
        *(f32x4*)(H + (size_t)n * 64 + hh * 32 + o4 * 4) = v; }
    __syncthreads();
}

DI void transpose_item(const float* W, int K, int N, bf16* WT, int dst_row0, LAS float* scr, int kb, int n0, int lane) {
    const int k0 = 64 * kb;
    float wv[32];
#pragma unroll
    for (int i = 0; i < 32; ++i) { const int kk = 2 * i + (lane >> 5); wv[i] = W[(size_t)(k0 + kk) * N + n0 + (lane & 31)]; }
#pragma unroll
    for (int i = 0; i < 32; ++i) { const int kk = 2 * i + (lane >> 5); scr[kk * 33 + (lane & 31)] = wv[i]; }
    asm volatile("s_waitcnt lgkmcnt(0)" ::: "memory");
    const int c = lane & 7;
#pragma unroll
    for (int j = 0; j < 4; ++j) { const int n = (lane >> 3) + 8 * j; const LAS float* s = scr + (8 * c) * 33 + n;
        v4u o; o.x = pk2(s[0 * 33], s[1 * 33]); o.y = pk2(s[2 * 33], s[3 * 33]); o.z = pk2(s[4 * 33], s[5 * 33]); o.w = pk2(s[6 * 33], s[7 * 33]);
        *(v4u*)(WT + (size_t)(dst_row0 + n) * K + k0 + 8 * c) = o; }
    asm volatile("s_waitcnt lgkmcnt(0)" ::: "memory");
}
DI void transpose_item_f8(const float* W, int K, int N, unsigned char* WT, int dst_row0, LAS float* scr, int kb, int n0, int lane) {
    const int k0 = 64 * kb;
    float wv[32];
#pragma unroll
    for (int i = 0; i < 32; ++i) { const int kk = 2 * i + (lane >> 5); wv[i] = W[(size_t)(k0 + kk) * N + n0 + (lane & 31)]; }
#pragma unroll
    for (int i = 0; i < 32; ++i) { const int kk = 2 * i + (lane >> 5); scr[kk * 33 + (lane & 31)] = wv[i] * pg8::F8_SW; }
    asm volatile("s_waitcnt lgkmcnt(0)" ::: "memory");
    const int c = lane & 7;
#pragma unroll
    for (int j = 0; j < 4; ++j) { const int n = (lane >> 3) + 8 * j; const LAS float* s = scr + (8 * c) * 33 + n;
        v2u o; o.x = pg8::pk4_fp8(s[0 * 33], s[1 * 33], s[2 * 33], s[3 * 33]); o.y = pg8::pk4_fp8(s[4 * 33], s[5 * 33], s[6 * 33], s[7 * 33]);
        *(v2u*)(WT + (size_t)(dst_row0 + n) * K + k0 + 8 * c) = o; }
    asm volatile("s_waitcnt lgkmcnt(0)" ::: "memory");
}
template <bool F8 = false>
DI void conv_matrix(const float* W, int K, int N, bf16* WT, int mode, int rowbase, LAS float* scr, int& goff, int gw, int NGW, int lane) {
    const int nblk = N / 32, items = (K / 64) * nblk;
    int first = (gw - (goff % NGW)); if (first < 0) first += NGW;
    for (int it = first; it < items; it += NGW) {
        const int kb = it / nblk, n0 = (it % nblk) * 32;
        const int drow = rowbase + (mode == 0 ? n0 : ((n0 >> 7) * 256 + (mode == 2 ? 128 : 0) + (n0 & 127)));
        if constexpr (F8) transpose_item_f8(W, K, N, (unsigned char*)WT, drow, scr, kb, n0, lane); else transpose_item(W, K, N, WT, drow, scr, kb, n0, lane);
    }
    goff += items;
}
DI void fold_item(const float* W  , bf16* WT  , LAS float* scr  , const LAS float* cosT, int kb, int g, int qtr, int lane) {
    const int k0 = kb * 64;
    float wv[64];
#pragma unroll
    for (int i = 0; i < 64; ++i) wv[i] = W[(size_t)(k0 + i) * 2560 + 2304 + g * 64 + lane];
#pragma unroll
    for (int i = 0; i < 64; ++i) scr[i * 65 + lane] = wv[i];
    asm volatile("s_waitcnt lgkmcnt(0)" ::: "memory");
    float row[64];
#pragma unroll
    for (int c = 0; c < 64; ++c) row[c] = scr[lane * 65 + c];
    for (int jp = qtr * 32; jp < qtr * 32 + 32; ++jp) {
        const int jj = jp & 63, off = (jp >= 64) ? 16 : 0;
        float acc = 0.f;
#pragma unroll
        for (int c = 0; c < 64; ++c) acc += row[c] * cosT[(jj * c + off) & 63];
        WT[(size_t)(2304 + g * 128 + jp) * 1024 + k0 + lane] = (bf16)f2bf(acc);
    }
    asm volatile("s_waitcnt lgkmcnt(0)" ::: "memory");
}

DI void phase0(const Ctx& a, LAS unsigned char* lds) {
    for (int it = blockIdx.x; it < 256; it += (int)gridDim.x) ada_item(a, it, (LAS float*)lds);
    GW_DECL;
    LAS float* cosT = (LAS float*)(lds + LDS_RED);
    if (tid < 64) { float s, c; sincospif((float)tid / 32.0f, &s, &c); cosT[tid] = c; }
    __syncthreads();
    LAS float* scr = (LAS float*)(lds + wave * WAVE_SCR);
    unsigned char* ws = a.ws;
    int goff = 0;
    for (int it = gw; it < 256; it += NGW) fold_item(a.in[8], (bf16*)(ws + WS_W_EIN), scr, cosT, it >> 4, (it >> 2) & 3, it & 3, lane);
    goff += 256;
    {   const int nblk = 2304 / 32, items = 16 * nblk; int first = gw - (goff % NGW); if (first < 0) first += NGW;
        for (int it = first; it < items; it += NGW) { const int kb = it / nblk, n0 = (it % nblk) * 32; transpose_item(a.in[8], 1024, 2560, (bf16*)(ws + WS_W_EIN), n0, scr, kb, n0, lane); }
        goff += items; }
    conv_matrix(a.in[17], 1024, 1024, (bf16*)(ws + WS_W_EOUT), 0, 0, scr, goff, gw, NGW, lane);
    conv_matrix<true>(a.in[18], 1024, DFF, (bf16*)(ws + WS_W_FGU), 1, 0, scr, goff, gw, NGW, lane);
    conv_matrix<true>(a.in[19], 1024, DFF, (bf16*)(ws + WS_W_FGU), 2, 0, scr, goff, gw, NGW, lane);
    conv_matrix<true>(a.in[20], DFF, 1024, (bf16*)(ws + WS_W_FD), 0, 0, scr, goff, gw, NGW, lane);
    conv_matrix(a.in[25], 1024, N2, (bf16*)(ws + WS_W_OIN), 0, 0, scr, goff, gw, NGW, lane);
    conv_matrix(a.in[30], 1024, 1024, (bf16*)(ws + WS_W_OOUT), 0, 0, scr, goff, gw, NGW, lane);
}
DI void conv_moe_weights(const Ctx& a, LAS unsigned char* lds) {
    GW_DECL;
    LAS float* scr = (LAS float*)(lds + wave * WAVE_SCR);
    unsigned char* ws = a.ws; int goff = 0;
    for (int e = 0; e < 4; ++e) {
        conv_matrix<true>(a.in[33] + (size_t)e * 1024 * DFE, 1024, DFE, (bf16*)(ws + WS_WMGU), 1, e * 2 * DFE, scr, goff, gw, NGW, lane);
        conv_matrix<true>(a.in[34] + (size_t)e * 1024 * DFE, 1024, DFE, (bf16*)(ws + WS_WMGU), 2, e * 2 * DFE, scr, goff, gw, NGW, lane);
    }
}

DI void conv_moe_S(const Ctx& a, LAS unsigned char* lds, int it_begin, int it_end, int rank, int nranks) {
    const int lane = lane_id(), wave = wave_of(a.wv);
    LAS float* scr = (LAS float*)(lds + wave * WAVE_SCR);
#pragma unroll 1
    for (int it = it_begin + rank * NWAVES + wave; it < it_end; it += nranks * NWAVES) {
        const int m = it / 1792, r = it % 1792;
        if (m < 8) { const int e = 4 + (m >> 1), t = m & 1, kb = r / 112, n0 = (r % 112) * 32;
            transpose_item_f8(a.in[33 + t] + (size_t)e * 1024 * DFE, 1024, DFE, a.ws + WS_WMGU, e * 2 * DFE + (n0 >> 7) * 256 + (t ? 128 : 0) + (n0 & 127), scr, kb, n0, lane); }
        else { const int e = m - 8, kb = r >> 5, n0 = (r & 31) * 32;
            transpose_item_f8(a.in[35] + (size_t)e * DFE * 1024, DFE, 1024, a.ws + WS_WMD, e * 1024 + n0, scr, kb, n0, lane); }
    }
}

DI void taps_mfma_item(const Ctx& a, int item, LAS unsigned char* lds) {
    GW_DECL;
    const bool isctx = item >= 256;
    const int q = isctx ? item - 256 : item >> 6, posblk = isctx ? 0 : item & 63, cbase = q * 384;
    const int Ln = isctx ? CTXL : SEQL;
    const float* w3 = a.in[15]; const float* H = isctx ? (const float*)(a.ws + WS_H2C) : (const float*)(a.ws + WS_H2);
    bf16* KT = (bf16*)(a.ws + WS_KT); float* KTCp = (float*)(a.ws + WS_KTC);
    for (int e = tid; e < 12 * 4 * 64; e += NTHR) { const int l = e & 63, sidx = (e >> 6) & 3, cgp = e >> 8; const int r = l & 31, h = l >> 5;
        const float* src = w3 + (size_t)(16 * sidx + 8 * h) * 1536 + cbase + 32 * cgp + r;
        v4u o; o.x = pk2(src[0], src[1536]); o.y = pk2(src[2 * 1536], src[3 * 1536]); o.z = pk2(src[4 * 1536], src[5 * 1536]); o.w = pk2(src[6 * 1536], src[7 * 1536]);
        *(LAS v4u*)(lds + (size_t)e * 16) = o; }
    const int r = lane & 31, h = lane >> 5, n = posblk * 256 + wave * 32 + r;
    bf16x8 bfr[4];
#pragma unroll
    for (int sidx = 0; sidx < 4; ++sidx) { const f32x4 v0 = *(const f32x4*)(H + (size_t)n * 64 + 16 * sidx + 8 * h), v1 = *(const f32x4*)(H + (size_t)n * 64 + 16 * sidx + 8 * h + 4);
        v4u o; o.x = pk2(v0[0], v0[1]); o.y = pk2(v0[2], v0[3]); o.z = pk2(v1[0], v1[1]); o.w = pk2(v1[2], v1[3]); bfr[sidx] = __builtin_bit_cast(bf16x8, o); }
    __syncthreads();
    const float tn = (float)n / (float)(Ln - 1);
    const float min_decay = -3.0701134573253945f, max_decay = -15.350567286626973f;
    const bool bwd = cbase >= HYW;
    const int idx = (!bwd || n == 0) ? n : SEQL - n;
#pragma unroll 1
    for (int cgp = 0; cgp < 12; ++cgp) {
        f32x16 acc;
#pragma unroll
        for (int i = 0; i < 16; ++i) acc[i] = 0.f;
#pragma unroll
        for (int sidx = 0; sidx < 4; ++sidx) { const bf16x8 af = *(LAS bf16x8*)(lds + ((cgp * 4 + sidx) * 64 + lane) * 16); acc = __builtin_amdgcn_mfma_f32_32x32x16_bf16(af, bfr[sidx], acc, 0, 0, 0); }
#pragma unroll
        for (int i = 0; i < 16; ++i) { const int c = cbase + 32 * cgp + (i & 3) + 8 * (i >> 2) + 4 * h, cc = c % HYW;
            const float delta = fabsf(min_decay + (float)cc * ((max_decay - min_decay) / 767.0f));
            const float val = acc[i] * __builtin_amdgcn_exp2f(-tn * delta * 1.4426950408889634f);
            if (isctx) KTCp[(size_t)c * CTXL + n] = val;
            else KT[(size_t)c * UTP + idx] = (bf16)((bwd && n == 0) ? 0u : f2bf(val)); }
    }
    __syncthreads();
}

template <bool F8 = false>
DI void norm_rows(const float* xlat, const float* xctx, const float* gain, const float* ADA  , int sh_off, int sc_off, bf16* H, int nrows, int gw, int NGW, int lane) {
    f32x4 nv[2][4];
#pragma unroll
    for (int q = 0; q < 2; ++q) { const int r = gw + q * NGW;
        if (r < nrows) { const float* xr = (r < T_LAT) ? xlat + (size_t)r * DM : xctx + (size_t)(r - T_LAT) * DM;
#pragma unroll
            for (int j = 0; j < 4; ++j) nv[q][j] = *(const f32x4*)(xr + 4 * lane + 256 * j); } }
    for (int r0 = gw; r0 < nrows; r0 += 2 * NGW) {
        f32x4 v[2][4];
#pragma unroll
        for (int q = 0; q < 2; ++q)
#pragma unroll
            for (int j = 0; j < 4; ++j) v[q][j] = nv[q][j];
#pragma unroll
        for (int q = 0; q < 2; ++q) { const int rn = r0 + (2 + q) * NGW;
            if (rn < nrows) { const float* xr = (rn < T_LAT) ? xlat + (size_t)rn * DM : xctx + (size_t)(rn - T_LAT) * DM;
#pragma unroll
                for (int j = 0; j < 4; ++j) nv[q][j] = *(const f32x4*)(xr + 4 * lane + 256 * j); } }
#pragma unroll
        for (int q = 0; q < 2; ++q) { const int r = r0 + q * NGW;
            if (r < nrows) {
                const int cond = r >> 14;
                float ss = 0.f;
#pragma unroll
                for (int j = 0; j < 4; ++j) ss += (v[q][j].x * v[q][j].x + v[q][j].y * v[q][j].y) + (v[q][j].z * v[q][j].z + v[q][j].w * v[q][j].w);
                const float rstd = 1.0f / sqrtf(wave_sum(ss) * (1.0f / DM) + 1e-6f);
#pragma unroll
                for (int j = 0; j < 4; ++j) {
                    const int c = 4 * lane + 256 * j;
                    const f32x4 g = *(const f32x4*)(gain + c), sc = *(const f32x4*)(ADA + cond * 6144 + sc_off + c), sh = *(const f32x4*)(ADA + cond * 6144 + sh_off + c);
                    const f32x4 y = (v[q][j] * rstd) * g * (sc + 1.0f) + sh;
                    if constexpr (F8) *(unsigned*)((unsigned char*)H + (size_t)r * DM + c) = pg8::pk4_fp8(y.x * pg8::F8_SX, y.y * pg8::F8_SX, y.z * pg8::F8_SX, y.w * pg8::F8_SX);
                    else { v2u o; o.x = pk2(y.x, y.y); o.y = pk2(y.z, y.w);
                    *(v2u*)(H + (size_t)r * DM + c) = o; }
                } } }
    }
}

template <int NKS, bool F8 = false>
DI void norm_ctx_partial(const float* xsrc, const float* gain, const float* ADA, int sh_off, int sc_off, bf16* Hout, const float* part, const float* pgate, float* wb, int gw, int NGW, int lane) {
    for (int rc = gw; rc < T_CTX; rc += NGW) {
        f32x4 v[4]; float ss = 0.f;
#pragma unroll
        for (int j = 0; j < 4; ++j) { const int c = 4 * lane + 256 * j;
            f32x4 pl[NKS];
#pragma unroll
            for (int sl = 0; sl < NKS; ++sl) pl[sl] = *(const f32x4*)(part + ((size_t)sl * 512 + rc) * 1024 + c);
            const f32x4 x0 = *(const f32x4*)(xsrc + (size_t)rc * DM + c), pg = *(const f32x4*)(pgate + c);
            f32x4 sum = pl[0];
#pragma unroll
            for (int sl = 1; sl < NKS; ++sl) sum += pl[sl];
            const f32x4 x = x0 + pg * sum;
            if (wb) *(f32x4*)(wb + (size_t)rc * DM + c) = x;
            v[j] = x;
            ss += (x.x * x.x + x.y * x.y) + (x.z * x.z + x.w * x.w); }
        const float rstd = 1.0f / sqrtf(wave_sum(ss) * (1.0f / DM) + 1e-6f);
#pragma unroll
        for (int j = 0; j < 4; ++j) { const int c = 4 * lane + 256 * j;
            const f32x4 g = *(const f32x4*)(gain + c), sc = *(const f32x4*)(ADA + 2 * 6144 + sc_off + c), sh = *(const f32x4*)(ADA + 2 * 6144 + sh_off + c);
            const f32x4 y = (v[j] * rstd) * g * (sc + 1.0f) + sh;
            if constexpr (F8) *(unsigned*)((unsigned char*)Hout + (size_t)(T_LAT + rc) * DM + c) = pg8::pk4_fp8(y.x * pg8::F8_SX, y.y * pg8::F8_SX, y.z * pg8::F8_SX, y.w * pg8::F8_SX);
            else { v2u o; o.x = pk2(y.x, y.y); o.y = pk2(y.z, y.w);
            *(v2u*)(Hout + (size_t)(T_LAT + rc) * DM + c) = o; } }
    }
}

DI void norm_router_phase(const Ctx& a, LAS unsigned char* lds) {
    GW_DECL;
    LAS float* rw = (LAS float*)lds;
    LAS int* cnt = (LAS int*)(lds + LDS_RED);
    const float* RW = a.in[31]; const float* RB = a.in[32];
    for (int i = tid; i < 8192; i += NTHR) rw[i] = RW[i];
    if (tid < 16) cnt[tid] = 0;
    __syncthreads();
    const float* ADA = (const float*)(a.ws + WS_ADA) + 3 * 6144;
    const float* gain = a.in[24];
    bf16* H = (bf16*)(a.ws + WS_H);
    int* toke = (int*)(a.ws + WS_TOKE); float* tokg = (float*)(a.ws + WS_TOKG);
    const int RPB = T_LAT / G;
    f32x4 nv[4];
    {   const float* xr = a.out + (size_t)(blockIdx.x * RPB + wave) * DM;
#pragma unroll
        for (int j = 0; j < 4; ++j) nv[j] = *(const f32x4*)(xr + 4 * lane + 256 * j); }
    for (int rr = wave; rr < RPB; rr += NWAVES) {
        const int r = blockIdx.x * RPB + rr, cond = r >> 14;
        f32x4 v[4]; float ss = 0.f;
#pragma unroll
        for (int j = 0; j < 4; ++j) { v[j] = nv[j]; ss += (v[j].x * v[j].x + v[j].y * v[j].y) + (v[j].z * v[j].z + v[j].w * v[j].w); }
        if (rr + NWAVES < RPB) { const float* xr = a.out + (size_t)(r + NWAVES) * DM;
#pragma unroll
            for (int j = 0; j < 4; ++j) nv[j] = *(const f32x4*)(xr + 4 * lane + 256 * j); }
        const float rstd = 1.0f / sqrtf(wave_sum(ss) * (1.0f / DM) + 1e-6f);
        float lg[8];
#pragma unroll
        for (int e = 0; e < 8; ++e) lg[e] = 0.f;
#pragma unroll
        for (int j = 0; j < 4; ++j) {
            const int c = 4 * lane + 256 * j;
            const f32x4 g = *(const f32x4*)(gain + c), sc = *(const f32x4*)(ADA + cond * 6144 + 4096 + c), sh = *(const f32x4*)(ADA + cond * 6144 + 3072 + c);
            const f32x4 y = (v[j] * rstd) * g * (sc + 1.0f) + sh;
            *(unsigned*)((unsigned char*)H + (size_t)r * DM + c) = pg8::pk4_fp8(y.x * pg8::F8_SX, y.y * pg8::F8_SX, y.z * pg8::F8_SX, y.w * pg8::F8_SX);
#pragma unroll
            for (int q = 0; q < 4; ++q) { const f32x4 w0 = *(LAS f32x4*)(rw + (c + q) * 8), w1 = *(LAS f32x4*)(rw + (c + q) * 8 + 4);
                lg[0] += y[q] * w0[0]; lg[1] += y[q] * w0[1]; lg[2] += y[q] * w0[2]; lg[3] += y[q] * w0[3];
                lg[4] += y[q] * w1[0]; lg[5] += y[q] * w1[1]; lg[6] += y[q] * w1[2]; lg[7] += y[q] * w1[3]; }
        }
#pragma unroll
        for (int e = 0; e < 8; ++e) lg[e] = wave_sum(lg[e]) + RB[e];
        int e1 = 0; float v1 = lg[0];
#pragma unroll
        for (int e = 1; e < 8; ++e) if (lg[e] > v1) { v1 = lg[e]; e1 = e; }
        int e2 = -1; float v2 = -3.0e38f;
#pragma unroll
        for (int e = 0; e < 8; ++e) if (e != e1 && lg[e] > v2) { v2 = lg[e]; e2 = e; }
        const float g1 = 1.0f / (1.0f + expf(v2 - v1)), g2 = 1.0f - g1;
        if (lane == 0) { toke[2 * r] = e1; toke[2 * r + 1] = e2; tokg[2 * r] = g1; tokg[2 * r + 1] = g2; __hip_atomic_fetch_add(&cnt[e1], 1, __ATOMIC_RELAXED, __HIP_MEMORY_SCOPE_WORKGROUP); __hip_atomic_fetch_add(&cnt[8 + e2], 1, __ATOMIC_RELAXED, __HIP_MEMORY_SCOPE_WORKGROUP); }
    }
    __syncthreads();
    if (tid < 16) ((int*)(a.ws + WS_BLKCNT))[blockIdx.x * 16 + tid] = cnt[tid];
    __syncthreads();
}

DI void slot_phase(const Ctx& a, LAS unsigned char* lds) {
    GW_DECL;
    LAS int* tot = (LAS int*)lds;
    LAS int* pre = tot + 16;
    LAS int* segstart = tot + 32;
    LAS int* cntL = tot + 64;
    LAS int* tokL = cntL + 4096;
    const int* blkcnt = (const int*)(a.ws + WS_BLKCNT);
    const int* toke = (const int*)(a.ws + WS_TOKE); const float* tokg = (const float*)(a.ws + WS_TOKG);
    const int RPB = T_LAT / G;
    for (int i = tid; i < G * 16; i += NTHR) cntL[i] = blkcnt[i];
    for (int i = tid; i < RPB * 2; i += NTHR) tokL[i] = toke[(size_t)blockIdx.x * RPB * 2 + i];
    __syncthreads();
    if (tid < 16) { int t = 0, p = 0; for (int b = 0; b < G; ++b) { const int c = cntL[b * 16 + tid]; if (b < (int)blockIdx.x) p += c; t += c; } tot[tid] = t; pre[tid] = p; }
    __syncthreads();
    if (tid == 0) { int s = 0; for (int g = 0; g < 16; ++g) { segstart[g] = s; s += ((tot[g] + 255) >> 8) << 8; } segstart[16] = s; }
    __syncthreads();
    int* slot_tok = (int*)(a.ws + WS_SLOTTOK); float* slot_w = (float*)(a.ws + WS_SLOTW);
    LAS int* posL = tokL + 2 * RPB;
    {
        LAS int* wcnt = posL + 2 * RPB;
        const bool act = tid < 2 * RPB;
        const int myseg = act ? (tid & 1) * 8 + tokL[tid] : -1;
        int rank = 0;
#pragma unroll
        for (int sg = 0; sg < 16; ++sg) { const unsigned long long m = __ballot(myseg == sg); if (myseg == sg) rank = __popcll(m & ((1ull << lane) - 1ull)); if (lane == 0 && wave < 4) wcnt[wave * 16 + sg] = __popcll(m); }
        __syncthreads();
        if (act) { int off = 0; for (int w = 0; w < wave; ++w) off += wcnt[w * 16 + myseg];
            const int pos = segstart[myseg] + pre[myseg] + off + rank, r = blockIdx.x * RPB + (tid >> 1);
            slot_tok[pos] = r; slot_w[pos] = tokg[2 * r + (tid & 1)]; posL[tid] = pos; }
    }
    __syncthreads();
    {
        const unsigned char* Hn = a.ws + WS_H; unsigned char* HP = a.ws + WS_BIG;
        for (int q0 = wave * 8; q0 < 2 * RPB; q0 += NWAVES * 8) {
            v4u v0[8]; int ps[8];
#pragma unroll
            for (int q = 0; q < 8; ++q) { const int r = blockIdx.x * RPB + ((q0 + q) >> 1); ps[q] = posL[q0 + q];
                v0[q] = *(const v4u*)(Hn + (size_t)r * DM + 16 * lane); }
#pragma unroll
            for (int q = 0; q < 8; ++q) *(v4u*)(HP + (size_t)ps[q] * DM + 16 * lane) = v0[q];
        }
        const v4u z = {0u, 0u, 0u, 0u};
        for (int g = 0; g < 16; ++g) { const int s0 = segstart[g] + tot[g], s1 = segstart[g + 1];
            for (int sl = s0 + gw; sl < s1; sl += NGW) { if (lane == 0) { slot_tok[sl] = -1; slot_w[sl] = 0.f; }
                *(v4u*)(HP + (size_t)sl * DM + 16 * lane) = z; } }
    }
    if (blockIdx.x == 0) {
        int* panel_e = (int*)(a.ws + WS_PANELE);
        for (int g = 0; g < 16; ++g) {
            for (int p = (segstart[g] >> 8) + tid; p < (segstart[g + 1] >> 8); p += NTHR) panel_e[p] = g & 7; }
    }
    if (blockIdx.x == (unsigned)(G - 1)) {
        int* panel_e = (int*)(a.ws + WS_PANELE);
        {
            const int P0 = segstart[8] >> 8, P = segstart[16] >> 8, P1 = P - P0, n0 = P0 >> 7, n1 = P1 >> 7;
            int* cnp = panel_e + PE_CNP; int* clist = panel_e + PE_LIST; int* cres = panel_e + PE_RES;
            for (int e = tid; e < (n0 + n1) * 128; e += NTHR) { const int i = e >> 7, q = e & 127, pa = (i < n0) ? 128 * i + q : P0 + 128 * (i - n0) + q;
                clist[i * 128 + q] = pa; cres[i * 128 + (pa & 127)] = pa; if (q == 0) cnp[i] = 128; }
        }
        if (tid == 0) {
            const int P0 = segstart[8] >> 8, P = segstart[16] >> 8, P1 = P - P0;
            const int n0 = P0 >> 7, r0 = P0 & 127, n1 = P1 >> 7, r1 = P1 & 127;
            int nc = n0 + n1, lastnp = 128;
            int* cnp = panel_e + PE_CNP; int* clist = panel_e + PE_LIST; int* cres = panel_e + PE_RES;
            int eA = -1, eB = -1; bool single = (r0 + r1 <= 128);
            for (int q = 0; q < r0 && single; ++q) { const int pa = 128 * n0 + q; int g = 0; while ((segstart[g + 1] >> 8) <= pa) ++g; const int e = g & 7; if (eA < 0) eA = e; else if (eA != e) single = false; }
            for (int q = 0; q < r1 && single; ++q) { const int pa = P0 + 128 * n1 + q; int g = 8; while ((segstart[g + 1] >> 8) <= pa) ++g; const int e = g & 7; if (eB < 0) eB = e; else if (eB != e) single = false; }
            if (single && r0 > 0 && r1 > 0 && eA != eB) single = false;
            if (single) { int k = 0;
                for (int q = 0; q < r0; ++q) { const int pa = 128 * n0 + q; clist[nc * 128 + k++] = pa; cres[nc * 128 + (pa & 127)] = pa; }
                for (int q = 0; q < r1; ++q) { const int pa = P0 + 128 * n1 + q; clist[nc * 128 + k++] = pa; cres[nc * 128 + (pa & 127)] = pa; }
                if (k > 0) { cnp[nc] = k; lastnp = k; ++nc; }
            } else {
                if (r0 > 0) { for (int q = 0; q < r0; ++q) { const int pa = 128 * n0 + q; clist[nc * 128 + q] = pa; cres[nc * 128 + (pa & 127)] = pa; } cnp[nc] = r0; lastnp = r0; ++nc; }
                if (r1 > 0) { for (int q = 0; q < r1; ++q) { const int pa = P0 + 128 * n1 + q; clist[nc * 128 + q] = pa; cres[nc * 128 + (pa & 127)] = pa; } cnp[nc] = r1; lastnp = r1; ++nc; }
            }
            panel_e[400] = P; panel_e[401] = P0; panel_e[402] = nc;
            int* sd = panel_e + PE_SD; int* sg = panel_e + PE_SG; int* sx = panel_e + PE_SX; int* snd = panel_e + PE_SND; int ns = 0;
            const int last = nc - 1;
            bool xok = (nc >= 2) && lastnp <= XPANELS;
            if (xok) for (int q = 0; q < lastnp; ++q) if ((clist[last * 128 + q] & 127) >= XPANELS) xok = false;
            if (xok && (n0 + n1) > 0 && G == 256) {
                sd[ns] = -1; sg[ns] = last; sx[ns] = 2; snd[ns] = 0; ++ns;
                sd[ns] = last; sg[ns] = 0; sx[ns] = 1; snd[ns] = lastnp * 4; ++ns;
                for (int chh = 1; chh < last; ++chh) { sd[ns] = chh - 1; sg[ns] = chh; sx[ns] = (((chh - 1) & 1) ? 4 : 0) | ((chh & 1) ? 8 : 0); snd[ns] = 0; ++ns; }
                sd[ns] = last - 1; sg[ns] = -1; sx[ns] = ((last - 1) & 1) ? 4 : 0; snd[ns] = 0; ++ns;
            } else {
                sd[ns] = -1; sg[ns] = 0; sx[ns] = 0; snd[ns] = 0; ++ns;
                for (int chh = 1; chh < nc; ++chh) { sd[ns] = chh - 1; sg[ns] = chh; sx[ns] = (((chh - 1) & 1) ? 4 : 0) | ((chh & 1) ? 8 : 0); snd[ns] = 0; ++ns; }
                sd[ns] = nc - 1; sg[ns] = -1; sx[ns] = ((nc - 1) & 1) ? 4 : 0; snd[ns] = 0; ++ns;
            }
            panel_e[PE_NSTEP] = ns;
        }
    }
    __syncthreads();
}

DI void gather_phase(const Ctx& a) {
    GW_DECL;
    const int P = ((const int*)(a.ws + WS_PANELE))[400];
    const int* slot_tok = (const int*)(a.ws + WS_SLOTTOK);
    const bf16* H = (const bf16*)(a.ws + WS_H); bf16* HP = (bf16*)(a.ws + WS_BIG);
    const int nslots = P * 256;
    for (int s0 = gw * 4; s0 < nslots; s0 += NGW * 4) {
        int tok[4]; v4u v0[4], v1[4];
#pragma unroll
        for (int q = 0; q < 4; ++q) tok[q] = slot_tok[s0 + q];
#pragma unroll
        for (int q = 0; q < 4; ++q) { v0[q] = (v4u){0u, 0u, 0u, 0u}; v1[q] = (v4u){0u, 0u, 0u, 0u};
            if (tok[q] >= 0) { v0[q] = *(const v4u*)(H + (size_t)tok[q] * DM + 8 * lane); v1[q] = *(const v4u*)(H + (size_t)tok[q] * DM + 512 + 8 * lane); } }
#pragma unroll
        for (int q = 0; q < 4; ++q) { *(v4u*)(HP + (size_t)(s0 + q) * DM + 8 * lane) = v0[q]; *(v4u*)(HP + (size_t)(s0 + q) * DM + 512 + 8 * lane) = v1[q]; }
    }
}

DI void prep0_phase(const Ctx& a, LAS unsigned char* lds) {
    GW_DECL;
    const bf16* P = (const bf16*)(a.ws + WS_BIG);
    bf16* A2 = (bf16*)(a.ws + WS_X0C); bf16* UT = (bf16*)(a.ws + WS_UT); unsigned* F1T = (unsigned*)(a.ws + WS_F1T);
    const float* SW = a.in[9];
    LAS bf16* raw = (LAS bf16*)lds;
    const int NH = 2 * 256 * 3, NF = 2 * 256;
    for (int it = blockIdx.x; it < NH + NF; it += G) {
        if (it < NH) {
            const int cq = it % 3, tch = (it / 3) % 256, b = it / 768, t0 = tch * 64, c0 = cq * 256;
            const size_t rowb = (size_t)b * SEQL;
            {   v4u sv[13];
#pragma unroll
                for (int i = 0; i < 13; ++i) { const int p = tid + NTHR * i; const int pc = p & 31, r = (p >> 5) % 66, sidx = p / (66 * 32); const int t = t0 - 1 + r;
                    sv[i] = (v4u){0u, 0u, 0u, 0u}; if (p < 3 * 66 * 32 && t >= 0 && t < SEQL) sv[i] = *(const v4u*)(P + (rowb + t) * N1 + sidx * HYW + c0 + pc * 8); }
#pragma unroll
                for (int i = 0; i < 13; ++i) { const int p = tid + NTHR * i; const int pc = p & 31, r = (p >> 5) % 66, sidx = p / (66 * 32);
                    if (p < 3 * 66 * 32) *(LAS v4u*)(raw + (sidx * 66 + r) * 256 + pc * 8) = sv[i]; } }
            __syncthreads();
            const int c = tid & 255, tg = tid >> 8;
            float w[3][3];
#pragma unroll
            for (int k = 0; k < 3; ++k)
#pragma unroll
                for (int sidx = 0; sidx < 3; ++sidx) w[k][sidx] = SW[k * 2304 + sidx * HYW + c0 + c];
            float pv[3], cu[3];
#pragma unroll
            for (int sidx = 0; sidx < 3; ++sidx) { pv[sidx] = bf2f(raw[(sidx * 66 + tg * 32) * 256 + c]); cu[sidx] = bf2f(raw[(sidx * 66 + tg * 32 + 1) * 256 + c]); }
            unsigned up[16];
#pragma unroll
            for (int tt = 0; tt < 32; ++tt) {
                float cv[3];
#pragma unroll
                for (int sidx = 0; sidx < 3; ++sidx) { const float nx = bf2f(raw[(sidx * 66 + tg * 32 + tt + 2) * 256 + c]);
                    cv[sidx] = w[0][sidx] * pv[sidx] + w[1][sidx] * cu[sidx] + w[2][sidx] * nx; pv[sidx] = cu[sidx]; cu[sidx] = nx; }
                A2[(rowb + t0 + tg * 32 + tt) * DM + c0 + c] = (bf16)f2bf(cv[0]);
                const unsigned ub = f2bf(cv[2] * cv[1]);
                if (tt & 1) up[tt >> 1] |= ub << 16; else up[tt >> 1] = ub;
            }
            v4u* dst = (v4u*)(UT + ((size_t)(c0 + c) * 2 + b) * UTP + t0 + tg * 32);
#pragma unroll
            for (int q = 0; q < 4; ++q) dst[q] = (v4u){up[4 * q], up[4 * q + 1], up[4 * q + 2], up[4 * q + 3]};
            __syncthreads();
        } else {
            const int f = it - NH, tch = f % 256, b = f / 256, t0 = tch * 64; const size_t rowb = (size_t)b * SEQL;
            {   v4u sv[8];
#pragma unroll
                for (int i = 0; i < 8; ++i) { const int p = tid + NTHR * i, pc = p & 63, r = p >> 6; sv[i] = *(const v4u*)(P + (rowb + t0 + r) * N1 + 2304 + pc * 8); }
#pragma unroll
                for (int i = 0; i < 8; ++i) { const int p = tid + NTHR * i, pc = p & 63, r = p >> 6; *(LAS v4u*)(raw + r * 512 + pc * 8) = sv[i]; } }
            __syncthreads();
            const int jb = tid & 255, g = jb >> 6, j = jb & 63, tg = tid >> 8;
            unsigned o[32];
#pragma unroll
            for (int tt = 0; tt < 32; ++tt) { const unsigned re = raw[(tg * 32 + tt) * 512 + g * 128 + j], im = raw[(tg * 32 + tt) * 512 + g * 128 + 64 + j]; o[tt] = re | (im << 16); }
            v4u* dst = (v4u*)(F1T + ((size_t)((b * 4 + g) * 64 + j)) * F1P + t0 + tg * 32);
#pragma unroll
            for (int q = 0; q < 8; ++q) dst[q] = (v4u){o[4 * q], o[4 * q + 1], o[4 * q + 2], o[4 * q + 3]};
            __syncthreads();
        }
    }
}

DI void untr0_phase(const Ctx& a, LAS unsigned char* lds) {
    GW_DECL;
    bf16* A2 = (bf16*)(a.ws + WS_A2); const bf16* X0C = (const bf16*)(a.ws + WS_X0C); const bf16* YT = (const bf16*)(a.ws + WS_YT); const bf16* YF = (const bf16*)(a.ws + WS_YF);
    LAS unsigned* tile32 = (LAS unsigned*)lds;
    LAS bf16* tile = (LAS bf16*)lds;
    const int NH = 2 * 256 * 3, NF = 2 * 256;
    for (int it = blockIdx.x; it < NH + NF; it += G) {
        const bool hy = it < NH;
        const int f = it - NH;
        const int cq = hy ? it % 3 : 0, tch = hy ? (it / 3) % 256 : f % 256, b = hy ? it / 768 : f / 256, t0 = tch * 64, c0 = cq * 256;
        const size_t rowb = (size_t)b * SEQL;
        {   v4u sv[4];
#pragma unroll
            for (int i = 0; i < 4; ++i) { const int p = tid + NTHR * i, pc = p & 7, c = p >> 3;
                const bf16* src = hy ? YT + ((size_t)(c0 + c) * 2 + b) * UTP + t0 + pc * 8 : YF + ((size_t)(b * 256 + c)) * UTP + t0 + pc * 8; sv[i] = *(const v4u*)src; }
#pragma unroll
            for (int i = 0; i < 4; ++i) { const int p = tid + NTHR * i, pc = p & 7, c = p >> 3; LAS unsigned* d = tile32 + c * 33 + pc * 4; d[0] = sv[i].x; d[1] = sv[i].y; d[2] = sv[i].z; d[3] = sv[i].w; } }
        __syncthreads();
        const int c8 = tid & 31, tr = tid >> 5;
        v4u xq[4];
#pragma unroll
        for (int q = 0; q < 4; ++q) { xq[q] = (v4u){0u, 0u, 0u, 0u}; if (hy) xq[q] = *(const v4u*)(X0C + (rowb + t0 + tr + 16 * q) * DM + c0 + c8 * 8); }
#pragma unroll
        for (int q = 0; q < 4; ++q) { const int t = tr + 16 * q;
            float y[8];
#pragma unroll
            for (int j = 0; j < 8; ++j) y[j] = bf2f(tile[(c8 * 8 + j) * 66 + t]);
            bf16* ap = A2 + (rowb + t0 + t) * DM + (hy ? c0 : HYW) + c8 * 8;
            v4u o;
            if (hy) { const v4u x = xq[q];
                o.x = pk2(bflo(x.x) * y[0], bfhi(x.x) * y[1]); o.y = pk2(bflo(x.y) * y[2], bfhi(x.y) * y[3]); o.z = pk2(bflo(x.z) * y[4], bfhi(x.z) * y[5]); o.w = pk2(bflo(x.w) * y[6], bfhi(x.w) * y[7]); }
            else { o.x = pk2(y[0], y[1]); o.y = pk2(y[2], y[3]); o.z = pk2(y[4], y[5]); o.w = pk2(y[6], y[7]); }
            *(v4u*)ap = o; }
        __syncthreads();
    }
}

DI void prep1_phase(const Ctx& a, LAS unsigned char* lds) {
    GW_DECL;
    const bf16* P = (const bf16*)(a.ws + WS_BIG);
    bf16* A2 = (bf16*)(a.ws + WS_A2); bf16* QR = (bf16*)(a.ws + WS_QR); bf16* KR = (bf16*)(a.ws + WS_KR); bf16* VT = (bf16*)(a.ws + WS_VT);
    bf16* KC = (bf16*)(a.ws + WS_KC); bf16* VCT = (bf16*)(a.ws + WS_VCT);
    const float* qn = a.in[26]; const float* kn = a.in[27]; const float* CW = a.in[29];
    LAS bf16* raw = (LAS bf16*)lds;
    const int NC = 1024, NQ = 1024, NQC = 16;
    const float QSCALE = 0.125f * 1.4426950408889634f;
    for (int it = blockIdx.x; it < NC + NQ + NQC; it += G) {
        if (it < NC) {
            const int b = it / 512, t0 = (it % 512) * 32; const size_t rowb = (size_t)b * SEQL;
            {   v4u sv[13];
#pragma unroll
                for (int i = 0; i < 13; ++i) { const int p = tid + NTHR * i, pc = p % 192, r = p / 192, t = t0 - 1 + r; sv[i] = (v4u){0u, 0u, 0u, 0u};
                    if (p < 34 * 192 && t >= 0 && t < SEQL) sv[i] = *(const v4u*)(P + (rowb + t) * N2 + 768 + pc * 8); }
#pragma unroll
                for (int i = 0; i < 13; ++i) { const int p = tid + NTHR * i, pc = p % 192, r = p / 192; if (p < 34 * 192) *(LAS v4u*)(raw + r * 1536 + pc * 8) = sv[i]; } }
            __syncthreads();
            const int c8 = tid & 63, tr = tid >> 6, c = 8 * c8;
            float w[3][8];
#pragma unroll
            for (int k = 0; k < 3; ++k) { const f32x4 w0 = *(const f32x4*)(CW + k * 512 + c), w1 = *(const f32x4*)(CW + k * 512 + c + 4);
                w[k][0] = w0[0]; w[k][1] = w0[1]; w[k][2] = w0[2]; w[k][3] = w0[3]; w[k][4] = w1[0]; w[k][5] = w1[1]; w[k][6] = w1[2]; w[k][7] = w1[3]; }
            float pr[6][8];
#pragma unroll
            for (int q = 0; q < 6; ++q) { const v4u gc = *(LAS v4u*)(raw + (tr * 4 + q) * 1536 + 512 + c), hx = *(LAS v4u*)(raw + (tr * 4 + q) * 1536 + 1024 + c);
                pr[q][0] = bflo(gc.x) * bflo(hx.x); pr[q][1] = bfhi(gc.x) * bfhi(hx.x); pr[q][2] = bflo(gc.y) * bflo(hx.y); pr[q][3] = bfhi(gc.y) * bfhi(hx.y);
                pr[q][4] = bflo(gc.z) * bflo(hx.z); pr[q][5] = bfhi(gc.z) * bfhi(hx.z); pr[q][6] = bflo(gc.w) * bflo(hx.w); pr[q][7] = bfhi(gc.w) * bfhi(hx.w); }
#pragma unroll
            for (int k = 0; k < 4; ++k) { const int rr = tr * 4 + k;
                const v4u gb = *(LAS v4u*)(raw + (rr + 1) * 1536 + c);
                const float gbf[8] = {bflo(gb.x), bfhi(gb.x), bflo(gb.y), bfhi(gb.y), bflo(gb.z), bfhi(gb.z), bflo(gb.w), bfhi(gb.w)};
                float y[8];
#pragma unroll
                for (int j = 0; j < 8; ++j) y[j] = gbf[j] * (w[0][j] * pr[k][j] + w[1][j] * pr[k + 1][j] + w[2][j] * pr[k + 2][j]);
                v4u o; o.x = pk2(y[0], y[1]); o.y = pk2(y[2], y[3]); o.z = pk2(y[4], y[5]); o.w = pk2(y[6], y[7]);
                *(v4u*)(A2 + (rowb + t0 + rr) * DM + 512 + c) = o; }
            __syncthreads();
        } else {
            const int i2 = it - NC; const bool isctx = i2 >= NQ;
            const int row0 = isctx ? T_LAT + (i2 - NQ) * 32 : i2 * 32;
            if (!isctx) { v4u sv[6];
#pragma unroll
                for (int i = 0; i < 6; ++i) { const int p = tid + NTHR * i, pc = p % 96, r = p / 96; sv[i] = *(const v4u*)(P + (size_t)(row0 + r) * N2 + pc * 8); }
#pragma unroll
                for (int i = 0; i < 6; ++i) { const int p = tid + NTHR * i, pc = p % 96, r = p / 96; *(LAS v4u*)(raw + r * 768 + pc * 8) = sv[i]; } }
            else { for (int p = tid; p < 32 * 32; p += NTHR) { const int pc = p & 31, r = p >> 5; *(LAS v4u*)(raw + r * 768 + 512 + pc * 8) = *(const v4u*)(P + (size_t)(row0 + r) * N2 + 512 + pc * 8); } }
            __syncthreads();
            const int d = lane, fi = d & 15;
            const float inv_freq = exp2f(-(float)fi * (13.287712379549449f / 16.0f)) * 0.15915494309189535f;
            const float gq = qn[d], gk = kn[d];
#pragma unroll 1
            for (int k = 0; k < 4; ++k) { const int rr = wave * 4 + k, row = row0 + rr;
                if (!isctx) {
                    const int t = row & (SEQL - 1);
                    const float pos = (float)((d < 32) ? (t >> 6) : (t & 63));
                    const float sn = __builtin_amdgcn_sinf(pos * inv_freq), cs = __builtin_amdgcn_cosf(pos * inv_freq);
#pragma unroll
                    for (int hh = 0; hh < 10; ++hh) {
                        const float x = bf2f(raw[rr * 768 + hh * 64 + d]);
                        const float ss = wave_sum(x * x);
                        const float xn = x * (1.0f / sqrtf(ss * (1.0f / 64.0f) + 1e-6f)) * (hh < 8 ? gq : gk);
                        const float pr = __shfl_xor(xn, 16);
                        const float o = (d & 16) ? (xn * cs + pr * sn) : (xn * cs - pr * sn);
                        if (hh < 8) QR[(size_t)row * 512 + hh * 64 + d] = (bf16)f2bf(o * QSCALE);
                        else KR[(size_t)row * 128 + (hh - 8) * 64 + d] = (bf16)f2bf(o);
                    }
                } else {
                    const int cr = row - T_LAT, bb = cr >> 8, j = cr & 255;
#pragma unroll
                    for (int kh = 0; kh < 2; ++kh) {
                        const float x = bf2f(raw[rr * 768 + 512 + kh * 64 + d]);
                        const float ss = wave_sum(x * x);
                        KC[((size_t)(bb * 256 + j) * 2 + kh) * 64 + d] = (bf16)f2bf(x * (1.0f / sqrtf(ss * (1.0f / 64.0f) + 1e-6f)) * gk);
                    }
                }
            }
            {
                const int dd = tid & 127, tg = tid >> 7;
                unsigned o[4];
#pragma unroll
                for (int q = 0; q < 4; ++q) o[q] = (unsigned)raw[(tg * 8 + 2 * q) * 768 + 640 + dd] | ((unsigned)raw[(tg * 8 + 2 * q + 1) * 768 + 640 + dd] << 16);
                if (!isctx) { const int bb = row0 >> 14, t0 = row0 & (SEQL - 1);
                    *(v4u*)(VT + ((size_t)(bb * 128 + dd)) * UTP + t0 + tg * 8) = (v4u){o[0], o[1], o[2], o[3]}; }
                else { const int cr = row0 - T_LAT, bb = cr >> 8, j0 = cr & 255;
                    *(v4u*)(VCT + ((size_t)(bb * 128 + dd)) * CTXL + j0 + tg * 8) = (v4u){o[0], o[1], o[2], o[3]}; }
            }
            __syncthreads();
        }
    }
}

DI int pidx(int i) { return i + (i >> 4); }
DI void sincos_rev(float x, float& s, float& c) { s = __builtin_amdgcn_sinf(x); c = __builtin_amdgcn_cosf(x); }
DI f32x2 cmul(f32x2 a, f32x2 b) { return (f32x2){a.x * b.x - a.y * b.y, a.x * b.y + a.y * b.x}; }
DI float c32(int i) { const float t[16] = {1.0000000000000000f, 0.9807852804032304f, 0.9238795325112867f, 0.8314696123025452f, 0.7071067811865476f, 0.5555702330196023f, 0.3826834323650898f, 0.1950903220161283f, 0.0000000000000001f, -0.1950903220161282f, -0.3826834323650897f, -0.5555702330196020f, -0.7071067811865475f, -0.8314696123025453f, -0.9238795325112867f, -0.9807852804032304f}; return t[i]; }
DI float s32(int i) { const float t[16] = {0.0000000000000000f, 0.1950903220161282f, 0.3826834323650898f, 0.5555702330196022f, 0.7071067811865475f, 0.8314696123025452f, 0.9238795325112867f, 0.9807852804032304f, 1.0000000000000000f, 0.9807852804032304f, 0.9238795325112867f, 0.8314696123025455f, 0.7071067811865476f, 0.5555702330196022f, 0.3826834323650899f, 0.1950903220161286f}; return t[i]; }

DI f32x2 cmulr(f32x2 a, f32x2 t, f32x2 tr) { return a.xx * t + a.yy * tr; }
DI f32x2 rot90(f32x2 t) { return (f32x2){-t.y, t.x}; }
template <int HPL2, int RL2, bool INV, bool FUSE = false>
DI void fft_pass(LAS f32x2* X, int tid, const f32x2* kr = nullptr) {
    constexpr int R = 1 << RL2, hp = 1 << HPL2, NB = 16384 >> RL2;
    int b0 = tid; asm volatile("" : "+v"(b0));
#pragma unroll 1
    for (int b = b0; b < NB; b += NTHR) {
        const int lo = b & (hp - 1), hi = b >> HPL2;
        const int base = hi * (hp * R) + lo, pbase = base + (base >> 4);
        f32x2 r[R];
#pragma unroll
        for (int j = 0; j < R; ++j) r[j] = X[pbase + j * hp + ((j * hp) >> 4)];
        f32x2 wp[RL2], wr[RL2];
        if (HPL2 > 0) { float s, c; sincos_rev((INV ? 1.0f : -1.0f) * (float)lo / (float)(R * hp), s, c); wp[0] = (f32x2){c, s}; wr[0] = (f32x2){-s, c};
#pragma unroll
            for (int q = 1; q < RL2; ++q) { wp[q] = cmulr(wp[q - 1], wp[q - 1], wr[q - 1]); wr[q] = rot90(wp[q]); } }
        if (!INV) {
#pragma unroll
            for (int ms = RL2 - 1; ms >= 0; --ms) {
                const int m = 1 << ms;
#pragma unroll
                for (int j = 0; j < R; ++j) if ((j & m) == 0) {
                    const f32x2 x0 = r[j], x1 = r[j + m];
                    r[j] = x0 + x1;
                    f32x2 d = x0 - x1;
                    const int idx = (j & (m - 1)) * 16 / m;
                    if (idx == 8) d = (f32x2){d.y, -d.x};
                    else if (idx != 0) d = cmulr(d, (f32x2){c32(idx), -s32(idx)}, (f32x2){s32(idx), c32(idx)});
                    if (HPL2 > 0) d = cmulr(d, wp[RL2 - 1 - ms], wr[RL2 - 1 - ms]);
                    r[j + m] = d;
                }
            }
        }
        if constexpr (FUSE) {
#pragma unroll
            for (int j = 0; j < R; ++j) r[j] = cmul(r[j], kr[j]);
        }
        if (INV || FUSE) {
#pragma unroll
            for (int ms = 0; ms < RL2; ++ms) {
                const int m = 1 << ms;
#pragma unroll
                for (int j = 0; j < R; ++j) if ((j & m) == 0) {
                    f32x2 x1 = r[j + m];
                    const int idx = (j & (m - 1)) * 16 / m;
                    if (idx == 8) x1 = (f32x2){-x1.y, x1.x};
                    else if (idx != 0) x1 = cmulr(x1, (f32x2){c32(idx), s32(idx)}, (f32x2){-s32(idx), c32(idx)});
                    if (HPL2 > 0) x1 = cmulr(x1, wp[RL2 - 1 - ms], wr[RL2 - 1 - ms]);
                    const f32x2 x0 = r[j];
                    r[j] = x0 + x1; r[j + m] = x0 - x1;
                }
            }
        }
#pragma unroll
        for (int j = 0; j < R; ++j) X[pbase + j * hp + ((j * hp) >> 4)] = r[j];
    }
}
DI void fft_fwd(LAS f32x2* X, int tid) {
    fft_pass<10, 4, false>(X, tid); __syncthreads(); fft_pass<5, 5, false>(X, tid); __syncthreads(); fft_pass<0, 5, false>(X, tid); __syncthreads();
}
DI void fft_conv_a(LAS f32x2* X, int tid, const f32x2* kr) {
    fft_pass<10, 4, false>(X, tid); __syncthreads(); fft_pass<5, 5, false>(X, tid); __syncthreads(); fft_pass<0, 5, false, true>(X, tid, kr); __syncthreads();
}
DI void fft_conv_b(LAS f32x2* X, int tid) {
    fft_pass<5, 5, true>(X, tid); __syncthreads(); fft_pass<10, 4, true>(X, tid); __syncthreads();
}
DI void fft_inv(LAS f32x2* X, int tid) {
    fft_pass<0, 5, true>(X, tid); __syncthreads(); fft_pass<5, 5, true>(X, tid); __syncthreads(); fft_pass<10, 4, true>(X, tid); __syncthreads();
}

DI void hyena_job(const Ctx& a, int c, LAS unsigned char* lds) {
    int tid_ = tid_of(a.wv);
    const int tid = tid_, lane = tid & 63, wave = tid >> 6, pb = tid + (tid >> 4);
    LAS f32x2* X = (LAS f32x2*)lds; LAS float* red = (LAS float*)(lds + LDS_RED);
    const bf16* kf = (const bf16*)(a.ws + WS_KT) + (size_t)c * UTP; const bf16* kb = (const bf16*)(a.ws + WS_KT) + (size_t)(HYW + c) * UTP;
    const bf16* U0 = (const bf16*)(a.ws + WS_UT) + (size_t)(c * 2) * UTP; const bf16* U1 = U0 + UTP;
    bf16* Y0 = (bf16*)(a.ws + WS_YT) + (size_t)(c * 2) * UTP; bf16* Y1 = Y0 + UTP;
    const float skip = a.in[16][c];
    f32x2 kreg[32];
    unsigned* PART = (unsigned*)(a.ws + WS_PART) + (size_t)blockIdx.x * SEQL;
    const float sc = 0.5f / (float)SEQL;
    float l1 = 0.f;
    v4u fv[4], bv[4], u0v[4], u1v[4];
#pragma unroll
    for (int i = 0; i < 4; ++i) { const int n0 = 8 * tid + 4096 * i; fv[i] = *(const v4u*)(kf + n0); bv[i] = *(const v4u*)(kb + n0); }
    {
#pragma unroll
        for (int i = 0; i < 4; ++i) { const int n0 = 8 * tid + 4096 * i; const unsigned fw[4] = {fv[i].x, fv[i].y, fv[i].z, fv[i].w}, bw[4] = {bv[i].x, bv[i].y, bv[i].z, bv[i].w};
#pragma unroll
            for (int j = 0; j < 4; ++j) { const float f0 = bflo(fw[j]), f1 = bfhi(fw[j]), b0 = bflo(bw[j]), b1 = bfhi(bw[j]);
                l1 += (fabsf(f0) + fabsf(b0)) + (fabsf(f1) + fabsf(b1));
                X[pidx(n0 + 2 * j)] = (f32x2){f0 + b0, 0.f}; X[pidx(n0 + 2 * j + 1)] = (f32x2){f1 + b1, 0.f}; } }
    }
    l1 = wave_sum(l1); if (lane == 0) red[wave] = l1;
    __syncthreads();
    float tot = 0.f;
#pragma unroll
    for (int w = 0; w < 8; ++w) tot += red[w];
    const float inv = 1.0f / tot;
#pragma unroll
    for (int i = 0; i < 4; ++i) { const int n0 = 8 * tid + 4096 * i; u0v[i] = *(const v4u*)(U0 + n0); u1v[i] = *(const v4u*)(U1 + n0); }
    fft_fwd(X, tid);
#pragma unroll
    for (int i = 0; i < 32; ++i) { const f32x2 v = X[34 * tid + i + (i >> 4)]; kreg[i] = (f32x2){v.x * inv + skip, v.y * inv}; }
    __syncthreads();
    {
#pragma unroll
        for (int i = 0; i < 4; ++i) { const int n0 = 8 * tid + 4096 * i; const unsigned aw[4] = {u0v[i].x, u0v[i].y, u0v[i].z, u0v[i].w}, bw[4] = {u1v[i].x, u1v[i].y, u1v[i].z, u1v[i].w};
#pragma unroll
            for (int j = 0; j < 4; ++j) { X[pidx(n0 + 2 * j)] = (f32x2){bflo(aw[j]), bflo(bw[j])}; X[pidx(n0 + 2 * j + 1)] = (f32x2){bfhi(aw[j]), bfhi(bw[j])}; } }
    }
    __syncthreads();
    fft_conv_a(X, tid, kreg);
#pragma unroll
    for (int i = 0; i < 4; ++i) { const int n0 = 8 * tid + 4096 * i; fv[i] = *(const v4u*)(kf + n0); bv[i] = *(const v4u*)(kb + n0); }
    fft_conv_b(X, tid);
#pragma unroll
    for (int i = 0; i < 4; ++i) { const int n0 = 8 * tid + 4096 * i; unsigned pw[8];
#pragma unroll
        for (int j = 0; j < 8; ++j) { const f32x2 v0 = X[pidx(n0 + j)] * sc; pw[j] = pk2(v0.x, v0.y); }
        *(v4u*)(PART + n0) = (v4u){pw[0], pw[1], pw[2], pw[3]}; *(v4u*)(PART + n0 + 4) = (v4u){pw[4], pw[5], pw[6], pw[7]}; }
    __syncthreads();
    {
#pragma unroll
        for (int i = 0; i < 4; ++i) { const int n0 = 8 * tid + 4096 * i; const unsigned fw[4] = {fv[i].x, fv[i].y, fv[i].z, fv[i].w}, bw[4] = {bv[i].x, bv[i].y, bv[i].z, bv[i].w};
#pragma unroll
            for (int j = 0; j < 8; ++j) { const float d = (j & 1) ? (bfhi(fw[j >> 1]) - bfhi(bw[j >> 1])) : (bflo(fw[j >> 1]) - bflo(bw[j >> 1]));
                float s, cs; sincos_rev(-(float)(n0 + j) / (float)(2 * SEQL), s, cs); X[pidx(n0 + j)] = (f32x2){d * cs, d * s}; } }
    }
    __syncthreads();
    { int t2 = tid; asm volatile("" : "+v"(t2));
#pragma unroll
    for (int i = 0; i < 4; ++i) { const int n0 = 8 * t2 + 4096 * i; u0v[i] = *(const v4u*)(U0 + n0); u1v[i] = *(const v4u*)(U1 + n0); } }
    fft_fwd(X, tid);
#pragma unroll
    for (int i = 0; i < 32; ++i) { const f32x2 v = X[34 * tid + i + (i >> 4)]; kreg[i] = (f32x2){v.x * inv + skip, v.y * inv}; }
    __syncthreads();
    {
#pragma unroll
        for (int i = 0; i < 4; ++i) { const int n0 = 8 * tid + 4096 * i; const unsigned aw[4] = {u0v[i].x, u0v[i].y, u0v[i].z, u0v[i].w}, bw[4] = {u1v[i].x, u1v[i].y, u1v[i].z, u1v[i].w};
#pragma unroll
            for (int j = 0; j < 8; ++j) { const f32x2 z = (j & 1) ? (f32x2){bfhi(aw[j >> 1]), bfhi(bw[j >> 1])} : (f32x2){bflo(aw[j >> 1]), bflo(bw[j >> 1])};
                float s, cs; sincos_rev(-(float)(n0 + j) / (float)(2 * SEQL), s, cs); X[pidx(n0 + j)] = cmul(z, (f32x2){cs, s}); } }
    }
    __syncthreads();
    fft_conv_a(X, tid, kreg); fft_conv_b(X, tid);
#pragma unroll 1
    for (int ih = 0; ih < 2; ++ih) {
        v4u pv[2][2];
#pragma unroll
        for (int i = 0; i < 2; ++i)
#pragma unroll
            for (int j = 0; j < 2; ++j) pv[i][j] = *(const v4u*)(PART + 8 * tid + 4096 * (2 * ih + i) + 4 * j);
#pragma unroll
        for (int i = 0; i < 2; ++i) { const int n0 = 8 * tid + 4096 * (2 * ih + i); unsigned o0[4], o1[4];
#pragma unroll
            for (int j = 0; j < 4; ++j) { float s, cs; f32x2 y[2];
#pragma unroll
                for (int q = 0; q < 2; ++q) { const int n = n0 + 2 * j + q; sincos_rev((float)n / (float)(2 * SEQL), s, cs);
                    const unsigned pwd = pv[i][j >> 1][2 * (j & 1) + q]; const f32x2 pe = {bflo(pwd), bfhi(pwd)};
                    y[q] = pe + cmul(X[pidx(n)], (f32x2){cs, s}) * sc; }
                o0[j] = pk2(y[0].x, y[1].x); o1[j] = pk2(y[0].y, y[1].y); }
            *(v4u*)(Y0 + n0) = (v4u){o0[0], o0[1], o0[2], o0[3]}; *(v4u*)(Y1 + n0) = (v4u){o1[0], o1[1], o1[2], o1[3]}; }
    }
    __syncthreads();
}

DI void fnet_job(const Ctx& a, int job, LAS unsigned char* lds) {
    int tid_ = tid_of(a.wv);
    const int tid = tid_;
    LAS f32x2* X = (LAS f32x2*)lds;
    const unsigned* F = (const unsigned*)(a.ws + WS_F1T) + (size_t)job * F1P;
    {   v4u fv[8];
#pragma unroll
        for (int i = 0; i < 8; ++i) fv[i] = *(const v4u*)(F + 4 * tid + 2048 * i);
#pragma unroll
        for (int i = 0; i < 8; ++i) { const int n0 = 4 * tid + 2048 * i; const unsigned w[4] = {fv[i].x, fv[i].y, fv[i].z, fv[i].w};
#pragma unroll
            for (int j = 0; j < 4; ++j) X[pidx(n0 + j)] = (f32x2){bflo(w[j]), bfhi(w[j])}; }
    }
    __syncthreads();
    fft_fwd(X, tid);
    bf16* Y = (bf16*)(a.ws + WS_YF) + (size_t)job * UTP;
    const int pb = tid + (tid >> 4);
    float re[32];
#pragma unroll
    for (int i = 0; i < 32; ++i) re[i] = X[pb + 544 * i].x * (1.0f / 1024.0f);
    __syncthreads();
    LAS float* Yl = (LAS float*)lds;
#pragma unroll
    for (int i = 0; i < 32; ++i) { const int k = (int)(__brev((unsigned)(tid + 512 * i)) >> 18); Yl[k + (k >> 9)] = re[i]; }
    __syncthreads();
#pragma unroll
    for (int i = 0; i < 16; ++i) { const int k = 2 * tid + 1024 * i; const int ad = k + (k >> 9);
        *(unsigned*)(Y + k) = pk2(Yl[ad], Yl[ad + 1]); }
    __syncthreads();
}

DI void ctx_hyena_job(const Ctx& a, int b, int cg, LAS unsigned char* lds) {
    int tid_ = tid_of(a.wv);
    const int tid = tid_, c = tid & 15, tq = tid >> 4, ch = cg * 16 + c;
    LAS float* U = (LAS float*)lds; LAS float* TF = U + 256 * 16; LAS float* TB = TF + 256 * 16;
    const bf16* P = (const bf16*)(a.ws + WS_BIG) + (size_t)(T_LAT + b * CTXL) * N1;
    const float* SW = a.in[9];
    const float* kfw = (const float*)(a.ws + WS_KTC) + (size_t)ch * CTXL; const float* kbw = (const float*)(a.ws + WS_KTC) + (size_t)(HYW + ch) * CTXL;
    float w[3][3];
#pragma unroll
    for (int k = 0; k < 3; ++k)
#pragma unroll
        for (int s = 0; s < 3; ++s) w[k][s] = SW[k * 2304 + s * HYW + ch];
    float x0r[8], l1p = 0.f;
#pragma unroll
    for (int i = 0; i < 8; ++i) { const int t = tq + 32 * i; float cv[3];
#pragma unroll
        for (int s = 0; s < 3; ++s) { const float pm = (t > 0) ? bf2f(P[(size_t)(t - 1) * N1 + s * HYW + ch]) : 0.f, p0 = bf2f(P[(size_t)t * N1 + s * HYW + ch]),
            pp = (t < CTXL - 1) ? bf2f(P[(size_t)(t + 1) * N1 + s * HYW + ch]) : 0.f; cv[s] = w[0][s] * pm + w[1][s] * p0 + w[2][s] * pp; }
        U[t * 16 + c] = cv[2] * cv[1]; x0r[i] = cv[0];
        const float kf = kfw[t], kb = (t >= 1) ? kbw[t] : 0.f; TF[t * 16 + c] = kf; TB[t * 16 + c] = kb; l1p += fabsf(kf) + fabsf(kb); }
    LAS float* red = (LAS float*)(lds + LDS_RED);
    red[tid] = l1p;
    __syncthreads();
    float l1 = 0.f;
#pragma unroll 8
    for (int q = 0; q < 32; ++q) l1 += red[q * 16 + c];
    float acc[8];
#pragma unroll
    for (int i = 0; i < 8; ++i) acc[i] = 0.f;
    for (int d = 0; d < CTXL; ++d) { const float kd = TF[d * 16 + c], km = TB[d * 16 + c];
#pragma unroll
        for (int i = 0; i < 8; ++i) { const int t = tq + 32 * i; const int s0 = t - d, s1 = t + d;
            if (s0 >= 0) acc[i] += kd * U[s0 * 16 + c];
            if (s1 < CTXL) acc[i] += km * U[s1 * 16 + c]; } }
    const float inv = 1.0f / l1, skip = a.in[16][ch];
    bf16* A2 = (bf16*)(a.ws + WS_A2);
#pragma unroll
    for (int i = 0; i < 8; ++i) { const int t = tq + 32 * i; const float y = acc[i] * inv + skip * U[t * 16 + c];
        A2[(size_t)(T_LAT + b * CTXL + t) * DM + ch] = (bf16)f2bf(x0r[i] * y); }
    __syncthreads();
}
DI void ctx_fnet_job(const Ctx& a, int b, int g, LAS unsigned char* lds) {
    int tid_ = tid_of(a.wv);
    const int tid = tid_, j = tid & 63, kq = tid >> 6;
    LAS float* RE = (LAS float*)lds; LAS float* IM = RE + 256 * 64; LAS float* cosT = (LAS float*)(lds + LDS_RED);
    const bf16* P = (const bf16*)(a.ws + WS_BIG) + (size_t)(T_LAT + b * CTXL) * N1 + 2304 + g * 128;
    for (int i = 0; i < 32; ++i) { const int t = kq + 8 * i; RE[t * 64 + j] = bf2f(P[(size_t)t * N1 + j]); IM[t * 64 + j] = bf2f(P[(size_t)t * N1 + 64 + j]); }
    if (tid < 256) cosT[tid] = cospif((float)tid / 128.0f);
    __syncthreads();
    float acc[32];
#pragma unroll
    for (int i = 0; i < 32; ++i) acc[i] = 0.f;
    for (int t = 0; t < CTXL; ++t) { const float re = RE[t * 64 + j], im = IM[t * 64 + j];
#pragma unroll
        for (int i = 0; i < 32; ++i) { const int m = ((kq + 8 * i) * t) & 255; acc[i] += re * cosT[m] + im * cosT[(m - 64) & 255]; } }
    bf16* A2 = (bf16*)(a.ws + WS_A2);
#pragma unroll
    for (int i = 0; i < 32; ++i) A2[(size_t)(T_LAT + b * CTXL + kq + 8 * i) * DM + HYW + g * 64 + j] = (bf16)f2bf(acc[i] * (1.0f / 128.0f));
    __syncthreads();
}
DI void fft_phase(const Ctx& a, LAS unsigned char* lds, int mask = 7) {
    const int G = gridDim.x;
#pragma unroll 1
    for (int sl = 0; sl < 6; ++sl) {
        const int bx = blockIdx.x; int job = bx + G * sl;
        if (G == 256 && ((bx >> 3) & 1)) job = (sl == 0) ? 768 + bx : (sl <= 3) ? bx + 256 * (sl - 1) : (sl == 4) ? 1024 + bx : 1280 + bx;
        if (job >= 768 + 512 + 96 + 8) continue;
        if (job < 768) { if (mask & 1) hyena_job(a, job, lds); }
        else if (job < 1280) { if (mask & 2) fnet_job(a, job - 768, lds); }
        else if (!(mask & 4)) continue;
        else if (job < 1376) ctx_hyena_job(a, (job - 1280) / 48, (job - 1280) % 48, lds);
        else ctx_fnet_job(a, (job - 1376) / 4, (job - 1376) % 4, lds);
    }
}

#ifdef SELFCHECK
DI void hyena_selfcheck(const Ctx& a, LAS unsigned char* lds) {
    if (blockIdx.x != 0) return;
    const int lane = lane_id(), wave = wave_of(a.wv), tid = (wave << 6) | lane;
    LAS float* red = (LAS float*)lds;
    const int cs[4] = {0, 5, 300, 767}; const int ts[5] = {0, 1, 777, 8191, 16383};
    float sdiff = 0.f, sconv = 0.f;
    for (int ci = 0; ci < 4; ++ci) {
        const int c = cs[ci];
        const bf16* kf = (const bf16*)(a.ws + WS_KT) + (size_t)c * UTP; const bf16* kb = (const bf16*)(a.ws + WS_KT) + (size_t)(HYW + c) * UTP;
        float l1 = 0.f;
        for (int n = tid; n < SEQL; n += NTHR) l1 += fabsf(bf2f(kf[n])) + fabsf(bf2f(kb[n]));
        l1 = wave_sum(l1); __syncthreads(); if (lane == 0) red[wave] = l1; __syncthreads();
        float tot = 0.f; for (int w = 0; w < 8; ++w) tot += red[w];
        const float skip = a.in[16][c];
        for (int b = 0; b < 2; ++b) {
            const bf16* U = (const bf16*)(a.ws + WS_UT) + (size_t)(c * 2 + b) * UTP; const bf16* Y = (const bf16*)(a.ws + WS_YT) + (size_t)(c * 2 + b) * UTP;
            for (int ti = 0; ti < 5; ++ti) { const int t = ts[ti];
                float p = 0.f;
                for (int sidx = tid; sidx < SEQL; sidx += NTHR) { const int lag = t - sidx; const float kv = (lag >= 0) ? bf2f(kf[lag]) : bf2f(kb[SEQL + lag]); p += kv * bf2f(U[sidx]); }
                p = wave_sum(p); __syncthreads(); if (lane == 0) red[wave] = p; __syncthreads();
                float conv = 0.f; for (int w = 0; w < 8; ++w) conv += red[w];
                conv /= tot;
                const float yref = conv + skip * bf2f(U[t]); const float d = bf2f(Y[t]) - yref;
                sdiff += d * d; sconv += conv * conv; } } }
    if (tid == 0 && !(sdiff < 0.3f * sconv)) ((unsigned*)(a.ws + WS_CTL))[8] = 1u;
    if (tid < 64) {
        const int tcs[8] = {0, 5, 300, 767, 768, 1000, 1301, 1535}; const int tns[8] = {0, 1, 2, 33, 777, 8191, 12345, 16383};
        const int c = tcs[tid >> 3], n = tns[tid & 7];
        const float* w3 = a.in[15]; const float* H = (const float*)(a.ws + WS_H2);
        float acc = 0.f; for (int i = 0; i < 64; ++i) acc += H[(size_t)n * 64 + i] * w3[(size_t)i * 1536 + c];
        const int cc = c % HYW; const float delta = fabsf(-3.0701134573253945f + (float)cc * ((-15.350567286626973f + 3.0701134573253945f) / 767.0f));
        float ref = acc * expf(-((float)n / (float)(SEQL - 1)) * delta);
        const bool bwd = c >= HYW; if (bwd && n == 0) ref = 0.f;
        const int idx = (!bwd || n == 0) ? n : SEQL - n;
        const float got = bf2f(((const bf16*)(a.ws + WS_KT))[(size_t)c * UTP + idx]);
        if (!(fabsf(got - ref) <= 0.02f * fabsf(ref) + 2e-3f)) ((unsigned*)(a.ws + WS_CTL))[8] = 1u;
    }
}
#endif

#define MFMA32(a_, b_, c_) __builtin_amdgcn_mfma_f32_32x32x16_bf16((a_), (b_), (c_), 0, 0, 0)
template <int S>
DI bf16x8 pack_step(const f32x16& x) {
    v4u p;
    asm volatile("v_cvt_pk_bf16_f32 %0, %4, %5\n\tv_cvt_pk_bf16_f32 %1, %6, %7\n\tv_cvt_pk_bf16_f32 %2, %8, %9\n\tv_cvt_pk_bf16_f32 %3, %10, %11\n\ts_nop 1"
                 : "=&v"(p[0]), "=&v"(p[1]), "=&v"(p[2]), "=&v"(p[3])
                 : "v"(x[8 * S]), "v"(x[8 * S + 1]), "v"(x[8 * S + 2]), "v"(x[8 * S + 3]), "v"(x[8 * S + 4]), "v"(x[8 * S + 5]), "v"(x[8 * S + 6]), "v"(x[8 * S + 7]));
    return __builtin_bit_cast(bf16x8, p);
}
constexpr int AT_KPITCH = 144, AT_VOFF = 46080, AT_VPL = 648, AT_VPC = 520;
template <bool LOCAL>
DI void attn_chunk(LAS unsigned char* Ks, LAS unsigned char* Vs, int ch, const bf16x8 (&qf)[4], float& m, float& l, f32x16& o0, f32x16& o1, int r, int h, int tq, int kp_base) {
    constexpr int vpitch = LOCAL ? AT_VPL : AT_VPC;
    const int cr0 = ch * 32;
    f32x16 s;
#pragma unroll
    for (int i = 0; i < 16; ++i) s[i] = 0.f;
#pragma unroll
    for (int ks = 0; ks < 4; ++ks) { const bf16x8 kf = *(LAS bf16x8*)(Ks + (cr0 + r) * AT_KPITCH + (16 * ks + 8 * h) * 2); s = MFMA32(kf, qf[ks], s); }
    float cmax = -1e30f;
#pragma unroll
    for (int i = 0; i < 16; ++i) {
        if (LOCAL) { const int kp = kp_base + cr0 + (i & 3) + 8 * (i >> 2) + 4 * h; const int dl = kp - tq;
            const bool ok = (dl <= 128) && (dl >= -128) && (kp >= 0) && (kp < SEQL); s[i] = ok ? s[i] : -1e30f; }
        cmax = fmaxf(cmax, s[i]);
    }
    cmax = fmaxf(cmax, __shfl_xor(cmax, 32));
    const float mn = fmaxf(m, cmax), alpha = __builtin_amdgcn_exp2f(m - mn);
    m = mn;
    float ps = 0.f;
#pragma unroll
    for (int i = 0; i < 16; ++i) { s[i] = __builtin_amdgcn_exp2f(s[i] - mn); ps += s[i]; }
    l = l * alpha + ps;
#pragma unroll
    for (int i = 0; i < 16; ++i) { o0[i] *= alpha; o1[i] *= alpha; }
    const bf16x8 p0 = pack_step<0>(s), p1 = pack_step<1>(s);
#pragma unroll
    for (int mt = 0; mt < 2; ++mt) {
#pragma unroll
        for (int sp = 0; sp < 2; ++sp) {
            LAS unsigned char* vp = Vs + (32 * mt + r) * vpitch + (cr0 + 16 * sp + 4 * h) * 2;
            const s16x4 vlo = *(LAS s16x4*)vp, vhi = *(LAS s16x4*)(vp + 16);
            const bf16x8 vf = __builtin_shufflevector(vlo, vhi, 0, 1, 2, 3, 4, 5, 6, 7);
            if (mt == 0) o0 = MFMA32(vf, sp == 0 ? p0 : p1, o0); else o1 = MFMA32(vf, sp == 0 ? p0 : p1, o1);
        }
    }
}
DI void attn_load_local(const bf16* KR, const bf16* VT, int b, int kvh, int t0, int tid, v4u (&kv)[10]) {
#pragma unroll
    for (int i = 0; i < 5; ++i) { const int p = tid + NTHR * i, row = p >> 3, pc = p & 7, kp = t0 - 128 + row; kv[i] = (v4u){0u, 0u, 0u, 0u};
        if (kp >= 0 && kp < SEQL) kv[i] = *(const v4u*)(KR + ((size_t)(b * SEQL + kp)) * 128 + kvh * 64 + pc * 8); }
#pragma unroll
    for (int i = 0; i < 5; ++i) { const int p = tid + NTHR * i, d = p / 40, pc = p % 40, kp0 = t0 - 128 + pc * 8; kv[5 + i] = (v4u){0u, 0u, 0u, 0u};
        if (kp0 >= 0 && kp0 < SEQL) kv[5 + i] = *(const v4u*)(VT + ((size_t)((b * 2 + kvh) * 64 + d)) * UTP + kp0); }
}
DI void attn_store_local(LAS unsigned char* Ks, LAS unsigned char* Vs, int tid, const v4u (&kv)[10]) {
#pragma unroll
    for (int i = 0; i < 5; ++i) { const int p = tid + NTHR * i, row = p >> 3, pc = p & 7; *(LAS v4u*)(Ks + row * AT_KPITCH + pc * 16) = kv[i]; }
#pragma unroll
    for (int i = 0; i < 5; ++i) { const int p = tid + NTHR * i, d = p / 40, pc = p % 40; LAS v2u* dst = (LAS v2u*)(Vs + d * AT_VPL + pc * 16);
        dst[0] = (v2u){kv[5 + i].x, kv[5 + i].y}; dst[1] = (v2u){kv[5 + i].z, kv[5 + i].w}; }
}
DI void attn_load_ctx(const bf16* KC, const bf16* VCT, int b, int kvh, int tid, v4u (&cv)[8]) {
#pragma unroll
    for (int i = 0; i < 4; ++i) { const int p = tid + NTHR * i, row = p >> 3, pc = p & 7; cv[i] = *(const v4u*)(KC + ((size_t)(b * CTXL + row) * 2 + kvh) * 64 + pc * 8); }
#pragma unroll
    for (int i = 0; i < 4; ++i) { const int p = tid + NTHR * i, d = p >> 5, pc = p & 31; cv[4 + i] = *(const v4u*)(VCT + ((size_t)((b * 2 + kvh) * 64 + d)) * CTXL + pc * 8); }
}
DI void attn_store_ctx(LAS unsigned char* Ks, LAS unsigned char* Vs, int tid, const v4u (&cv)[8]) {
#pragma unroll
    for (int i = 0; i < 4; ++i) { const int p = tid + NTHR * i, row = p >> 3, pc = p & 7; *(LAS v4u*)(Ks + row * AT_KPITCH + pc * 16) = cv[i]; }
#pragma unroll
    for (int i = 0; i < 4; ++i) { const int p = tid + NTHR * i, d = p >> 5, pc = p & 31; LAS v2u* dst = (LAS v2u*)(Vs + d * AT_VPC + pc * 16);
        dst[0] = (v2u){cv[4 + i].x, cv[4 + i].y}; dst[1] = (v2u){cv[4 + i].z, cv[4 + i].w}; }
}
DI void attn_phase(const Ctx& a, LAS unsigned char* lds) {
    const int lane = lane_id(), wave = wave_of(a.wv), tid = (wave << 6) | lane, G = gridDim.x;
    const int r = lane & 31, h = lane >> 5;
    const bf16* QR = (const bf16*)(a.ws + WS_QR); const bf16* KR = (const bf16*)(a.ws + WS_KR); const bf16* VT = (const bf16*)(a.ws + WS_VT);
    const bf16* KC = (const bf16*)(a.ws + WS_KC); const bf16* VCT = (const bf16*)(a.ws + WS_VCT);
    bf16* A2 = (bf16*)(a.ws + WS_A2); const float* sink = a.in[28];
    LAS unsigned char* Ks = lds; LAS unsigned char* Vs = lds + AT_VOFF;
    v4u kv[10], cv[8];
    if ((int)blockIdx.x < 1024) { const int u = blockIdx.x; attn_load_local(KR, VT, u >> 9, (u >> 8) & 1, (u & 255) * 64, tid, kv); }
    for (int u = blockIdx.x; u < 1024; u += G) {
        const int qb = u & 255, kvh = (u >> 8) & 1, b = u >> 9;
        const int t0 = qb * 64, g = wave >> 1, qs = wave & 1, h8 = kvh * 4 + g, tq = t0 + qs * 32 + r;
        bf16x8 qf[4];
#pragma unroll
        for (int s = 0; s < 4; ++s) qf[s] = *(const bf16x8*)(QR + ((size_t)(b * SEQL + tq)) * 512 + h8 * 64 + 16 * s + 8 * h);
        float m = sink[h8] * 1.4426950408889634f, l = (h == 0) ? 1.0f : 0.0f;
        f32x16 o0, o1;
#pragma unroll
        for (int i = 0; i < 16; ++i) { o0[i] = 0.f; o1[i] = 0.f; }
        __syncthreads();
        attn_store_local(Ks, Vs, tid, kv);
        attn_load_ctx(KC, VCT, b, kvh, tid, cv);
        __syncthreads();
#pragma unroll 1
        for (int ch = 0; ch < 10; ++ch) attn_chunk<true>(Ks, Vs, ch, qf, m, l, o0, o1, r, h, tq, t0 - 128);
        __syncthreads();
        attn_store_ctx(Ks, Vs, tid, cv);
        { const int un = u + G; if (un < 1024) attn_load_local(KR, VT, un >> 9, (un >> 8) & 1, (un & 255) * 64, tid, kv); }
        __syncthreads();
#pragma unroll 1
        for (int ch = 0; ch < 8; ++ch) attn_chunk<false>(Ks, Vs, ch, qf, m, l, o0, o1, r, h, tq, 0);
        const float inv = 1.0f / (l + __shfl_xor(l, 32));
        bf16* op = A2 + ((size_t)(b * SEQL + tq)) * DM + h8 * 64 + 4 * h;
#pragma unroll
        for (int g4 = 0; g4 < 4; ++g4) {
            v2u w0; w0.x = pk2(o0[4 * g4] * inv, o0[4 * g4 + 1] * inv); w0.y = pk2(o0[4 * g4 + 2] * inv, o0[4 * g4 + 3] * inv);
            v2u w1; w1.x = pk2(o1[4 * g4] * inv, o1[4 * g4 + 1] * inv); w1.y = pk2(o1[4 * g4 + 2] * inv, o1[4 * g4 + 3] * inv);
            *(v2u*)(op + 8 * g4) = w0; *(v2u*)(op + 32 + 8 * g4) = w1;
        }
    }
    __syncthreads();
}

#ifndef SPLIT_G2
#define SPLIT_G2 1
#endif
#ifndef SPLIT_G4
#define SPLIT_G4 1
#endif
__global__ void __launch_bounds__(NTHR, 2) fwd_kernel(Args ka) {
    extern __shared__ __attribute__((aligned(16))) unsigned char lds_raw[];
    LAS unsigned char* lds = (LAS unsigned char*)lds_raw;
    const int wave = __builtin_amdgcn_readfirstlane((int)threadIdx.x >> 6), G = gridDim.x, gw = blockIdx.x * NWAVES + wave, NGW = G * NWAVES;
    const Ctx a{ka.in, ka.out, ka.ws, wave};
    { const int tid = tid_of(wave); if (tid < 4) ((LAS unsigned*)(lds + LDS_MISC))[tid] = 0u; }
    __syncthreads();
#if N_LAUNCH_MODE == 1
    XcdBarrier bar = xcd_barrier_post((unsigned*)(a.ws + WS_CTL) + CW_BAR, (volatile LAS unsigned*)(lds + LDS_MISC), wave);
#define GRID_BAR() xcd_barrier(bar)
#else
#define GRID_BAR() do { } while (0)
#endif
    const int lo = ka.ph_lo, hi = ka.ph_hi;
#ifdef ONLY_PHASE
#define IN(k) (((k) == ONLY_PHASE || (ONLY_PHASE >= 18 && (k) >= 18 && (((k) - ONLY_PHASE) % 2 == 0))) && lo <= (k) && (k) < hi)
#else
#define IN(k) (lo <= (k) && (k) < hi)
#endif
#define SEAM(k) do { if (IN(k) && IN((k) + 1)) GRID_BAR(); } while (0)
#ifndef DUP_MASK
#define DUP_MASK 0
#endif
#ifndef DUP_G345
#define DUP_G345 0
#endif
#define REPS(k) ((((DUP_MASK) >> (k)) & 1) + 1)
#define PH_BEGIN(k) if (IN(k)) { _Pragma("unroll 1") for (int rep_ = 0; rep_ < REPS(k); ++rep_) { if (rep_) GRID_BAR();
#define PH_END(k) } } SEAM(k);
    const int bid = (int)blockIdx.x;

    PH_BEGIN(0) phase0(a, lds); PH_END(0)
    PH_BEGIN(1) {
        norm_rows(a.in[0], a.in[2], a.in[6], ((const float*)(a.ws + WS_ADA)), 0, 1024, ((bf16*)(a.ws + WS_H)), T_ALL, gw, NGW, lane_id());
    } PH_END(1)
    if (IN(2)) {
        pg8::Gemm g{((bf16*)(a.ws + WS_H)), (const bf16*)(a.ws + WS_W_EIN), T_ALL, N1, DM}; pg8::StaticOrder S; S.init(T_ALL, N1, G, bid);
        pg8::EpiStoreBf16 E{((bf16*)(a.ws + WS_BIG)), N1};
        pg8::gemm_phase<pg8::EpiStoreBf16, pg8::StaticOrder, true, true>(lds, g, S, E, wave);
        if (bid >= 150) for (int it = bid - 150; it < 65; it += 106) filt_hidden_item(a, it, (LAS float*)lds);
    }
    SEAM(2);
#pragma unroll 1
    for (int grep_ = 0; grep_ < 1 + DUP_G345; ++grep_) {
    if (grep_) GRID_BAR();
    PH_BEGIN(3) {
        for (int it = bid; it < 256; it += G) taps_mfma_item(a, it, lds);
        for (int it = 256 + (G - 1 - bid); it < 260; it += G) taps_mfma_item(a, it, lds);
        prep0_phase(a, lds); } PH_END(3)
#ifdef SELFCHECK
    if (IN(4)) { fft_phase(a, lds); GRID_BAR(); hyena_selfcheck(a, lds); } SEAM(4);
#else
#ifdef PROBE_FFT_MASK
    if (IN(4)) { fft_phase(a, lds); GRID_BAR(); fft_phase(a, lds, PROBE_FFT_MASK); } SEAM(4);
#else
    PH_BEGIN(4) fft_phase(a, lds); PH_END(4)
#endif
#endif
    PH_BEGIN(5) untr0_phase(a, lds); } }
    if (grep_ + 1 < 1 + DUP_G345) continue;
    SEAM(5);
    }
    if (IN(6)) {
        pg8::Gemm g{((bf16*)(a.ws + WS_A2)), (const bf16*)(a.ws + WS_W_EOUT), T_ALL, DM, DM}; pg8::StaticOrder S; S.init(T_LAT, DM, G, bid);
        pg8::EpiResid E{a.in[0], a.in[2], a.out, ((float*)(a.ws + WS_XC)), ((const float*)(a.ws + WS_ADA)) + 2048};
        pg8::gemm_phase<pg8::EpiResid, pg8::StaticOrder, true, true>(lds, g, S, E, wave);
        int bid2 = bid, ksl = 256; asm volatile("" : "+s"(bid2), "+s"(ksl) :: "memory");
        pg8::Gemm gc{((bf16*)(a.ws + WS_A2)), (const bf16*)(a.ws + WS_W_EOUT), T_ALL, DM, ksl, DM}; pg8::OrderCtxSplit Sc{4, 4, G, bid2};
        pg8::EpiPartial Ec{(float*)(a.ws + WS_PARTC)};
        if (SPLIT_G2) pg8::gemm_phase<pg8::EpiPartial, pg8::OrderCtxSplit, true, true, true>(lds, gc, Sc, Ec, wave);
        if (bid >= 32) conv_moe_S(a, lds, 0, 4608, bid - 32, 224);
    }
    SEAM(6);
    PH_BEGIN(7) {
        norm_ctx_partial<4, true>(a.in[2], a.in[7], (const float*)(a.ws + WS_ADA), 3072, 4096, (bf16*)(a.ws + WS_H), (const float*)(a.ws + WS_PARTC), (const float*)(a.ws + WS_ADA) + 2 * 6144 + 2048, (float*)(a.ws + WS_XC), NGW - 1 - gw, NGW, lane_id());
        norm_rows<true>(a.out, a.in[2], a.in[7], ((const float*)(a.ws + WS_ADA)), 3072, 4096, ((bf16*)(a.ws + WS_H)), T_LAT, gw, NGW, lane_id());
    } PH_END(7)
    if (IN(8)) {
        pg8::Gemm g{((bf16*)(a.ws + WS_H)), (const bf16*)(a.ws + WS_W_FGU), T_ALL, 2 * DFF, DM}; pg8::StaticOrder S; S.init(T_ALL, 2 * DFF, G, bid);
        pg8::EpiSwigluF8 E{a.ws + WS_BIG, DFF, 0x7fffffff, 22};
        pg8::gemm_phase<pg8::EpiSwigluF8, pg8::StaticOrder, true, true, false, true>(lds, g, S, E, wave);
        if (bid >= 44) conv_moe_S(a, lds, 4608, 17408, bid - 44, 212);
    }
    SEAM(8);
    if (IN(9)) {
        pg8::Gemm g{((bf16*)(a.ws + WS_BIG)), (const bf16*)(a.ws + WS_W_FD), T_ALL, DM, DFF}; pg8::StaticOrder S; S.init(T_LAT, DM, G, bid);
        pg8::EpiResidT<2048> E{a.out, ((float*)(a.ws + WS_XC)), a.out, ((float*)(a.ws + WS_XC)), ((const float*)(a.ws + WS_ADA)) + 5120};
        pg8::gemm_phase<pg8::EpiResidT<2048>, pg8::StaticOrder, true, true, false, true>(lds, g, S, E, wave);
        int bid2 = bid, ksl = 256; asm volatile("" : "+s"(bid2), "+s"(ksl) :: "memory");
        pg8::Gemm gc{((bf16*)(a.ws + WS_BIG)), (const bf16*)(a.ws + WS_W_FD), T_ALL, DM, ksl, DFF}; pg8::OrderCtxSplitT<256> Sc{4, 11, G, bid2};
        pg8::EpiPartialT<8, 2048> Ec{(float*)(a.ws + WS_PARTC)};
        if (SPLIT_G4) pg8::gemm_phase<pg8::EpiPartialT<8, 2048>, pg8::OrderCtxSplitT<256>, true, true, true, true>(lds, gc, Sc, Ec, wave);
        if (bid >= 88) conv_moe_S(a, lds, 17408, 20864, bid - 88, 168);
    }
    SEAM(9);
    if (IN(10)) {
        norm_ctx_partial<11>((const float*)(a.ws + WS_XC), a.in[23], (const float*)(a.ws + WS_ADA) + 3 * 6144, 0, 1024, (bf16*)(a.ws + WS_H), (const float*)(a.ws + WS_PARTC), (const float*)(a.ws + WS_ADA) + 2 * 6144 + 5120, nullptr, NGW - 1 - gw, NGW, lane_id());
        norm_rows(a.out, ((float*)(a.ws + WS_XC)), a.in[23], ((const float*)(a.ws + WS_ADA) + 3 * 6144), 0, 1024, ((bf16*)(a.ws + WS_H)), T_LAT, gw, NGW, lane_id());
    }
    SEAM(10);
    if (IN(11)) {
        pg8::Gemm g{((bf16*)(a.ws + WS_H)), (const bf16*)(a.ws + WS_W_OIN), T_ALL, N2, DM}; pg8::OrderL1In S; S.init(G, bid);
        pg8::EpiStoreBf16 E{((bf16*)(a.ws + WS_BIG)), N2};
        pg8::gemm_phase<pg8::EpiStoreBf16, pg8::OrderL1In, true, true>(lds, g, S, E, wave);
        if (bid >= 130) conv_moe_S(a, lds, 20864, 28672, bid - 130, 126);
    }
    SEAM(11);
    PH_BEGIN(12) prep1_phase(a, lds); PH_END(12)
    PH_BEGIN(13) attn_phase(a, lds); PH_END(13)
    if (IN(14)) {
        pg8::Gemm g{((bf16*)(a.ws + WS_A2)), (const bf16*)(a.ws + WS_W_OOUT), T_LAT, DM, DM}; pg8::StaticOrder S; S.init(T_LAT, DM, G, bid);
        pg8::EpiResid E{a.out, ((float*)(a.ws + WS_XC)), a.out, ((float*)(a.ws + WS_XC)), ((const float*)(a.ws + WS_ADA) + 3 * 6144) + 2048};
        pg8::gemm_phase<pg8::EpiResid, pg8::StaticOrder, true, true>(lds, g, S, E, wave);
    }
    SEAM(14);
    PH_BEGIN(15) { norm_router_phase(a, lds); conv_moe_weights(a, lds); } PH_END(15)
    PH_BEGIN(16) slot_phase(a, lds); PH_END(16)
#pragma unroll 1
    for (int st = 0; st < 2 * NCHUNK; ++st) {
        const int kk = 18 + st;
        if (!IN(kk)) continue;
        const int* panel_e = (const int*)(a.ws + WS_PANELE);
        if (st >= __builtin_amdgcn_readfirstlane(panel_e[PE_NSTEP])) break;
        const int sdn = __builtin_amdgcn_readfirstlane(panel_e[PE_SD + st]), sgu = __builtin_amdgcn_readfirstlane(panel_e[PE_SG + st]), sfl = __builtin_amdgcn_readfirstlane(panel_e[PE_SX + st]), snd = __builtin_amdgcn_readfirstlane(panel_e[PE_SND + st]);
        if (sdn >= 0) {
            pg8::Gemm g{(const bf16*)(a.ws + ((sfl & 1) ? WS_ACTX : ((sfl & 4) ? WS_ACTM2 : WS_ACTM))), (const bf16*)(a.ws + WS_WMD), 0, 0, DFE};
            pg8::OrderMoe S{panel_e, panel_e + PE_LIST + sdn * CHUNKP, __builtin_amdgcn_readfirstlane(panel_e[PE_CNP + sdn]), 4, G, bid, 1, 0};
            pg8::EpiMoeDown E{a.out, ((const float*)(a.ws + WS_ADA) + 3 * 6144) + 5120, (const int*)(a.ws + WS_SLOTTOK), (const float*)(a.ws + WS_SLOTW), panel_e + PE_RES + sdn * CHUNKP};
            pg8::gemm_phase<pg8::EpiMoeDown, pg8::OrderMoe, true, true, false, true>(lds, g, S, E, wave);
        }
        if (sgu >= 0) {
            pg8::Gemm g{((bf16*)(a.ws + WS_BIG)), (const bf16*)(a.ws + WS_WMGU), 0, 0, DM};
            pg8::OrderMoe S{panel_e, panel_e + PE_LIST + sgu * CHUNKP, __builtin_amdgcn_readfirstlane(panel_e[PE_CNP + sgu]), 28, G, bid, 0, snd};
            pg8::EpiSwigluF8 E{a.ws + ((sfl & 2) ? WS_ACTX : ((sfl & 8) ? WS_ACTM2 : WS_ACTM)), DFE, CHUNKP - 1, 28};
            pg8::gemm_phase<pg8::EpiSwigluF8, pg8::OrderMoe, true, true, false, true>(lds, g, S, E, wave);
        }
        SEAM(kk);
    }
#ifdef SELFCHECK
    GRID_BAR();
    if (__hip_atomic_load((unsigned*)(a.ws + WS_CTL) + 8, __ATOMIC_RELAXED, __HIP_MEMORY_SCOPE_AGENT) != 0u) { for (int i = gw * 64 + lane_id(); i < T_LAT * DM; i += NGW * 64) a.out[i] = __builtin_nanf(""); }
#endif
#undef IN
#undef SEAM
}

extern "C" void kernel_launch(void* const* d_in, const int* in_sizes, int n_in, void* d_out, int out_size, void* d_ws, size_t ws_size, hipStream_t stream) {
    static int grid = 0;
    if (grid == 0) {
        int dev = 0, cus = 0;
        if (n_in != 36 || out_size != T_LAT * DM || ws_size < WS_END) { fprintf(stderr, "kernel_launch: unexpected problem shape (n_in %d, out %d, ws %zu < %zu)\n", n_in, out_size, ws_size, (size_t)WS_END); grid = -1; return; }
        if (hipGetDevice(&dev) != hipSuccess || hipDeviceGetAttribute(&cus, hipDeviceAttributeMultiprocessorCount, dev) != hipSuccess) { grid = -1; return; }
        if (hipFuncSetAttribute((const void*)fwd_kernel, hipFuncAttributeMaxDynamicSharedMemorySize, LDS_BYTES) != hipSuccess) { grid = -1; return; }
        (void)hipGetLastError();
        if (cus < 256) { fprintf(stderr, "kernel_launch: needs 256 CUs, device has %d\n", cus); grid = -1; return; }
        grid = 256;
    }
    if (grid < 0) return;
    (void)hipMemsetAsync((char*)d_ws + WS_CTL, 0, 65536, stream);
    Args a{};
    for (int i = 0; i < 36; ++i) a.in[i] = (const float*)d_in[i];
    a.out = (float*)d_out; a.ws = (unsigned char*)d_ws;
#if LAST_PHASE <= 6
    (void)hipMemcpyAsync(d_out, d_in[0], (size_t)T_LAT * DM * 4, hipMemcpyDeviceToDevice, stream);
#endif
#if N_LAUNCH_MODE == 1
    a.ph_lo = 0; a.ph_hi = LAST_PHASE;
    hipLaunchKernelGGL(fwd_kernel, dim3(grid), dim3(NTHR), LDS_BYTES, stream, a);
#else
    for (int ph = 0; ph < LAST_PHASE; ++ph) { a.ph_lo = ph; a.ph_hi = ph + 1; hipLaunchKernelGGL(fwd_kernel, dim3(grid), dim3(NTHR), LDS_BYTES, stream, a); }
#endif
}
```

```cpp
#include <hip/hip_runtime.h>
#include <cstdio>
#include <cstdint>
#ifndef N_LAUNCH_MODE
#define N_LAUNCH_MODE 1
#endif
#ifndef LAST_PHASE
#define LAST_PHASE 30
#endif
namespace pg8 {
#define PG8_LAS __attribute__((address_space(3)))
typedef unsigned short bf16_t;
typedef short bf16x8 __attribute__((ext_vector_type(8)));
typedef float f32x4 __attribute__((ext_vector_type(4)));
typedef unsigned u32x4 __attribute__((ext_vector_type(4)));
typedef int i32x4 __attribute__((ext_vector_type(4)));
typedef int i32x8 __attribute__((ext_vector_type(8)));
__device__ __forceinline__ i32x8 cat8(bf16x8 a, bf16x8 b) { const i32x4 x = __builtin_bit_cast(i32x4, a), y = __builtin_bit_cast(i32x4, b); return __builtin_shufflevector(x, y, 0, 1, 2, 3, 4, 5, 6, 7); }
constexpr int BM = 256, BK = 64, HALF = 128, HTB = HALF * BK * 2  , STAGE_BYTES = 8 * HTB, NXCD = 8, WGM = 8;

__host__ __device__ __forceinline__ int lds_byte(int r, int c) { const int st = (r >> 4) * 2 + (c >> 5), rr = r & 15, cc = c & 31, ob = rr * 64 + cc * 2; return st * 1024 + (ob ^ (((ob >> 9) & 1) << 5)); }
__host__ __device__ __forceinline__ void stage_rc(int b, int& R, int& C) { const int st = b / 1024, sb = b % 1024, swz = sb ^ (((sb >> 9) & 1) << 5); R = (st >> 1) * 16 + swz / 64; C = (st & 1) * 32 + (swz % 64) / 2; }
__host__ __device__ __forceinline__ int perm32(int rho) { const int n = rho >> 4, i = rho & 15; return 8 * (i >> 2) + 4 * n + (i & 3); }

struct Unit { int pm, pn, ko; };
struct Gemm { const bf16_t* A; const bf16_t* Bt; int M, N, K, ld; };
__device__ __forceinline__ unsigned cvt_pk_bf16(float lo, float hi) { unsigned r; asm volatile("v_cvt_pk_bf16_f32 %0, %1, %2" : "=v"(r) : "v"(lo), "v"(hi)); return r; }
template <class Epi, class Sched, bool ALIGN_EPI = false, bool SP2 = false, bool KSPLIT = false, bool FP8 = false>
__device__ __forceinline__ void gemm_phase(PG8_LAS unsigned char* lds, const Gemm g, const Sched& S, const Epi& E, int wid) {
    asm volatile("" : "+s"(wid));
    int lane; asm volatile("v_mbcnt_lo_u32_b32 %0, -1, 0\n\tv_mbcnt_hi_u32_b32 %0, -1, %0" : "=v"(lane)); lane &= 63;
    const int tid = (wid << 6) | lane, wr = wid >> 2, wc = wid & 3, fr = lane & 15, fq = lane >> 4;
    const int K = FP8 ? (g.K >> 1) : g.K, LD = KSPLIT ? (FP8 ? (g.ld >> 1) : g.ld) : K, nt = K / BK;
    unsigned voffA[2], voffB[2];
#pragma unroll
    for (int i = 0; i < 2; ++i) { int R, C; stage_rc(tid * 16 + i * 8192, R, C); const int Rb = Epi::PERM ? ((R & ~31) + perm32(R & 31)) : R;
        voffA[i] = (unsigned)(R * LD + C) * 2u; voffB[i] = (unsigned)(Rb * LD + C) * 2u; }
    const size_t kstep = (size_t)(BK * 2);
    const size_t hstep = (size_t)HALF * LD * 2;
    const size_t tstep = 2 * hstep;
    const unsigned ldsw = (unsigned)wid * 1024u;
    const int aoff = lds_byte(wr * 64 + fr, fq * 8), boff = lds_byte(wc * 32 + fr, fq * 8);
#define PG8_SA(b, h) (((b) * 2 + (h)) * HTB)
#define PG8_SB(b, h) ((4 + (b) * 2 + (h)) * HTB)
#define PG8_STAGE(bufoff, gbase, voff) do { const char* _g = (const char*)(gbase); asm volatile("" : "+s"(_g)); _Pragma("unroll") for (int _i = 0; _i < 2; ++_i) { unsigned _v = (voff)[_i]; asm volatile("" : "+v"(_v));   \
        __builtin_amdgcn_global_load_lds((const unsigned*)(_g + _v), (PG8_LAS unsigned*)(lds + (bufoff) + ldsw + _i * 8192), 16, 0, 0); } } while (0)
#define PG8_LDA(dst, b, h) do { _Pragma("unroll") for (int m = 0; m < 4; ++m) _Pragma("unroll") for (int k = 0; k < 2; ++k) dst[m][k] = *(const PG8_LAS bf16x8*)(lds + PG8_SA(b, h) + aoff + m * 2048 + k * 1024); } while (0)
#define PG8_LDB(dst, b, h) do { _Pragma("unroll") for (int n = 0; n < 2; ++n) _Pragma("unroll") for (int k = 0; k < 2; ++k) dst[n][k] = *(const PG8_LAS bf16x8*)(lds + PG8_SB(b, h) + boff + n * 2048 + k * 1024); } while (0)
#define PG8_MMA(ai, bj, At, Bt) do { __builtin_amdgcn_s_setprio(1); _Pragma("unroll") for (int m = 0; m < 4; ++m) _Pragma("unroll") for (int n = 0; n < 2; ++n) { \
        if constexpr (FP8) acc[ai][bj][m][n] = __builtin_amdgcn_mfma_scale_f32_16x16x128_f8f6f4(cat8(Bt[n][0], Bt[n][1]), cat8(At[m][0], At[m][1]), acc[ai][bj][m][n], 0, 0, 0, 0, 0, 0); \
        else { _Pragma("unroll") for (int k = 0; k < 2; ++k) acc[ai][bj][m][n] = __builtin_amdgcn_mfma_f32_16x16x32_bf16(Bt[n][k], At[m][k], acc[ai][bj][m][n], 0, 0, 0); } } __builtin_amdgcn_s_setprio(0); } while (0)
#define PG8_WAIT_V(n) asm volatile("s_waitcnt vmcnt(" #n ")" ::: "memory")
#define PG8_WAIT_L(n) asm volatile("s_waitcnt lgkmcnt(" #n ")" ::: "memory")
#define PG8_BAR __builtin_amdgcn_s_barrier()
#define PG8_SCHED __builtin_amdgcn_sched_barrier(0)
    Unit cur, nxt; int ui = 0;
    if (!S.next(0, cur)) return;
    f32x4 acc[2][2][4][2];
#pragma unroll
    for (int a = 0; a < 2; ++a)
#pragma unroll
        for (int b = 0; b < 2; ++b)
#pragma unroll
            for (int m = 0; m < 4; ++m)
#pragma unroll
                for (int n = 0; n < 2; ++n) acc[a][b][m][n] = (f32x4){0.f, 0.f, 0.f, 0.f};
    bf16x8 At[4][2], B0[2][2], B1[2][2];
    const char* cA = (const char*)g.A + (size_t)cur.pm * tstep + (KSPLIT ? cur.ko : 0); const char* cB = (const char*)g.Bt + (size_t)cur.pn * tstep + (KSPLIT ? cur.ko : 0);
    S.a_ready(cur);
    if constexpr (SP2) {
        PG8_STAGE(PG8_SB(0, 0), cB, voffB); PG8_STAGE(PG8_SB(0, 1), cB + hstep, voffB); PG8_STAGE(PG8_SA(0, 0), cA, voffA); PG8_STAGE(PG8_SA(0, 1), cA + hstep, voffA);
        if (wr == 1) PG8_BAR;
        PG8_WAIT_V(2); PG8_BAR;
        PG8_STAGE(PG8_SB(1, 0), cB + kstep, voffB); PG8_STAGE(PG8_SA(1, 0), cA + kstep, voffA); PG8_STAGE(PG8_SB(1, 1), cB + hstep + kstep, voffB);
        PG8_WAIT_V(6); PG8_BAR;
    } else {
        PG8_STAGE(PG8_SB(0, 0), cB, voffB); PG8_STAGE(PG8_SA(0, 0), cA, voffA); PG8_STAGE(PG8_SB(0, 1), cB + hstep, voffB); PG8_STAGE(PG8_SA(0, 1), cA + hstep, voffA);
        if (wr == 1) PG8_BAR;
        PG8_WAIT_V(4); PG8_BAR;
        PG8_STAGE(PG8_SB(1, 0), cB + kstep, voffB); PG8_STAGE(PG8_SA(1, 0), cA + kstep, voffA); PG8_STAGE(PG8_SB(1, 1), cB + hstep + kstep, voffB);
        PG8_WAIT_V(6); PG8_BAR;
    }
    for (;;) {
        const bool has_next = S.next(ui + 1, nxt);
        const char* nA = has_next ? (const char*)g.A + (size_t)nxt.pm * tstep + (KSPLIT ? nxt.ko : 0) : cA; const char* nB = has_next ? (const char*)g.Bt + (size_t)nxt.pn * tstep + (KSPLIT ? nxt.ko : 0) : cB;
        for (int t = 0; t < nt; t += 2) {
            const bool last = (t == nt - 2);
            const char* a1 = cA + (size_t)(t + 1) * kstep;
            const char* a2 = last ? nA : cA + (size_t)(t + 2) * kstep; const char* b2 = last ? nB : cB + (size_t)(t + 2) * kstep;
            const char* a3 = a2 + kstep; const char* b3 = b2 + kstep;
            if (last && has_next) S.a_ready(nxt);
            if constexpr (SP2) {
            PG8_LDB(B0, 0, 0); PG8_LDB(B1, 0, 1); PG8_SCHED; PG8_LDA(At, 0, 0); PG8_STAGE(PG8_SA(1, 1), a1 + hstep, voffA);
            PG8_WAIT_V(8); PG8_WAIT_L(0); PG8_BAR; PG8_MMA(0, 0, At, B0); PG8_MMA(0, 1, At, B1); PG8_BAR; PG8_SCHED;
            PG8_LDA(At, 0, 1); PG8_STAGE(PG8_SB(0, 0), b2, voffB); PG8_STAGE(PG8_SB(0, 1), b2 + hstep, voffB); PG8_STAGE(PG8_SA(0, 0), a2, voffA);
            PG8_WAIT_V(8); PG8_WAIT_L(0); PG8_BAR; PG8_MMA(1, 0, At, B0); PG8_MMA(1, 1, At, B1); PG8_BAR; PG8_SCHED;
            PG8_LDB(B0, 1, 0); PG8_LDB(B1, 1, 1); PG8_SCHED; PG8_LDA(At, 1, 0); PG8_STAGE(PG8_SA(0, 1), a2 + hstep, voffA);
            PG8_WAIT_V(8); PG8_WAIT_L(0); PG8_BAR; PG8_MMA(0, 0, At, B0); PG8_MMA(0, 1, At, B1); PG8_BAR; PG8_SCHED;
            PG8_LDA(At, 1, 1); PG8_STAGE(PG8_SB(1, 0), b3, voffB); PG8_STAGE(PG8_SB(1, 1), b3 + hstep, voffB); PG8_STAGE(PG8_SA(1, 0), a3, voffA);
            PG8_WAIT_V(8); PG8_WAIT_L(0); PG8_BAR; PG8_MMA(1, 0, At, B0); PG8_MMA(1, 1, At, B1); PG8_BAR; PG8_SCHED;
            } else {
            PG8_LDB(B0, 0, 0); PG8_SCHED; PG8_LDA(At, 0, 0); PG8_STAGE(PG8_SA(1, 1), a1 + hstep, voffA);
            PG8_WAIT_L(8); PG8_BAR; PG8_WAIT_L(0); PG8_MMA(0, 0, At, B0); PG8_BAR; PG8_SCHED;
            PG8_LDB(B1, 0, 1); PG8_STAGE(PG8_SB(0, 0), b2, voffB);
            PG8_BAR; PG8_WAIT_L(0); PG8_MMA(0, 1, At, B1); PG8_BAR;
            PG8_LDA(At, 0, 1); PG8_STAGE(PG8_SA(0, 0), a2, voffA);
            PG8_BAR; PG8_WAIT_L(0); PG8_MMA(1, 0, At, B0); PG8_BAR; PG8_SCHED;
            PG8_STAGE(PG8_SB(0, 1), b2 + hstep, voffB);
            PG8_WAIT_V(6); PG8_BAR; PG8_MMA(1, 1, At, B1); PG8_BAR;
            PG8_LDB(B0, 1, 0); PG8_SCHED; PG8_LDA(At, 1, 0); PG8_STAGE(PG8_SA(0, 1), a2 + hstep, voffA);
            PG8_WAIT_L(8); PG8_BAR; PG8_WAIT_L(0); PG8_MMA(0, 0, At, B0); PG8_BAR; PG8_SCHED;
            PG8_LDB(B1, 1, 1); PG8_STAGE(PG8_SB(1, 0), b3, voffB);
            PG8_BAR; PG8_WAIT_L(0); PG8_MMA(0, 1, At, B1); PG8_BAR;
            PG8_LDA(At, 1, 1); PG8_STAGE(PG8_SA(1, 0), a3, voffA);
            PG8_BAR; PG8_WAIT_L(0); PG8_MMA(1, 0, At, B0); PG8_BAR; PG8_SCHED;
            PG8_STAGE(PG8_SB(1, 1), b3 + hstep, voffB);
            PG8_WAIT_V(6); PG8_BAR; PG8_MMA(1, 1, At, B1); PG8_BAR;
            }
        }
        if constexpr (ALIGN_EPI) { if (wr == 0) PG8_BAR; }
        if constexpr (!Epi::AFTER_DRAIN) { E(acc, cur, wr, wc, fr, fq); S.done(cur); }
        if (!has_next) break;
#pragma unroll
        for (int a = 0; a < 2; ++a)
#pragma unroll
            for (int b = 0; b < 2; ++b)
#pragma unroll
                for (int m = 0; m < 4; ++m)
#pragma unroll
                    for (int n = 0; n < 2; ++n) acc[a][b][m][n] = (f32x4){0.f, 0.f, 0.f, 0.f};
        cur = nxt; cA = nA; cB = nB; ++ui;
        if constexpr (ALIGN_EPI) { if (wr == 1) PG8_BAR; }
    }
    PG8_WAIT_V(0);
    if constexpr (!ALIGN_EPI) { if (wr == 0) PG8_BAR; }
    PG8_BAR;
    if constexpr (Epi::AFTER_DRAIN) { E.fused(acc, cur, wr, wc, fr, fq, lds, wid, lane); S.done(cur); }
#undef PG8_SA
#undef PG8_SB
#undef PG8_STAGE
#undef PG8_LDA
#undef PG8_LDB
#undef PG8_MMA
#undef PG8_WAIT_V
#undef PG8_WAIT_L
#undef PG8_BAR
#undef PG8_SCHED
}
}

constexpr int DM = 1024, SEQL = 16384, CTXL = 256, T_LAT = 32768, T_CTX = 512, T_ALL = 33280;
constexpr int N1 = 2816;
constexpr int DFF = 2816, N2 = 2304, DFE = 3584, NEXP = 8;
constexpr int HYW = 768;
constexpr int UTP = SEQL + 64;
constexpr int F1P = SEQL + 32;
constexpr int NWAVES = 8, NTHR = 512;
constexpr int MAXPANELS = 272;
constexpr int CHUNKP = 128;
constexpr int NCHUNK = 6;
constexpr int PE_NSTEP = 403, PE_SD = 2600, PE_SG = 2632, PE_SX = 2664, PE_SND = 2696;
constexpr int XPANELS = 16;
constexpr int PE_CNP = 416, PE_LIST = 512, PE_RES = 1536;

constexpr size_t MiB = 1u << 20;
constexpr size_t WS_CTL = 0, CTL_ZERO_BYTES = 1 * MiB;
constexpr size_t WS_ADA = 1 * MiB;
constexpr size_t WS_XC = 2 * MiB;
constexpr size_t WS_TOKE = 4 * MiB;
constexpr size_t WS_TOKG = 4 * MiB + 256 * 1024;
constexpr size_t WS_BLKCNT = 4 * MiB + 512 * 1024;
constexpr size_t WS_PANELE = 4 * MiB + 528 * 1024;
constexpr size_t WS_SLOTTOK = 5 * MiB;
constexpr size_t WS_SLOTW = 5 * MiB + 512 * 1024;
constexpr size_t WS_KC = 6 * MiB;
constexpr size_t WS_VCT = 6 * MiB + 256 * 1024;
constexpr size_t WS_H2C = 7 * MiB;
constexpr size_t WS_KTC = 8 * MiB;
constexpr size_t WS_H2 = 11 * MiB;
constexpr size_t WS_W_EIN = 16 * MiB, WS_W_EOUT = 22 * MiB, WS_W_FGU = 24 * MiB, WS_W_FD = 35 * MiB, WS_W_OIN = 41 * MiB, WS_W_OOUT = 46 * MiB;
constexpr size_t WS_H = 48 * MiB;
constexpr size_t WS_A2 = 113 * MiB;
constexpr size_t ACTM_HALF = (size_t)CHUNKP * 256 * DFE;
constexpr size_t WS_ACTM2 = 246 * MiB;
constexpr size_t WS_ACTM = 48 * MiB;
constexpr size_t WS_ACTX = 16 * MiB;
constexpr size_t WS_BIG = 178 * MiB;
constexpr size_t WS_X0C = 48 * MiB;
constexpr size_t WS_YT = 178 * MiB;
constexpr size_t WS_YF = 178 * MiB + 64 * MiB;
constexpr size_t WS_T = 358 * MiB;
constexpr size_t WS_UT = WS_T;
constexpr size_t WS_PART = WS_T + 49 * MiB;
constexpr size_t WS_F1T = WS_T + 81 * MiB;
constexpr size_t WS_KT = WS_T + 114 * MiB;
constexpr size_t WS_PARTC = WS_T;
constexpr size_t WS_QR = WS_T;
constexpr size_t WS_KR = WS_T + 32 * MiB;
constexpr size_t WS_VT = WS_T + 40 * MiB;
constexpr size_t WS_WMGU = WS_T + 56 * MiB;
constexpr size_t WS_WMD = WS_T + 112 * MiB;
constexpr size_t WS_END = 526 * MiB;
static_assert(WS_KT + (size_t)1536 * UTP * 2 <= WS_END && WS_UT + (size_t)1536 * UTP * 2 <= WS_PART && WS_F1T + (size_t)512 * F1P * 4 <= WS_KT && WS_VT + (size_t)256 * UTP * 2 <= WS_T + 49 * MiB && WS_WMD + (size_t)8 * 1024 * 3584 * 2 <= WS_END, "ws map");
static_assert(WS_BIG + (size_t)T_ALL * N1 * 2 <= WS_T && WS_A2 + (size_t)T_ALL * DM * 2 <= WS_BIG && WS_ACTM + ACTM_HALF <= WS_BIG && WS_BIG + (size_t)69632 * 1024 <= WS_ACTM2 && WS_ACTM2 + ACTM_HALF <= WS_T, "ws map");
constexpr int CW_BAR = 4096;

constexpr int LDS_BYTES = 147456;
constexpr int LDS_WORK = 139264;
constexpr int LDS_RED = 139264;
constexpr int LDS_MISC = 146432;
constexpr int WAVE_SCR = 17408;

#define LAS __attribute__((address_space(3)))
typedef unsigned short bf16;
typedef unsigned v4u __attribute__((ext_vector_type(4)));
typedef unsigned v2u __attribute__((ext_vector_type(2)));
typedef float f32x4 __attribute__((ext_vector_type(4)));
typedef float f32x2 __attribute__((ext_vector_type(2)));
typedef float f32x16 __attribute__((ext_vector_type(16)));
typedef short bf16x8 __attribute__((ext_vector_type(8)));
typedef short s16x4 __attribute__((ext_vector_type(4)));

struct Args { const float* in[36]; float* out; unsigned char* ws; int ph_lo, ph_hi; };
struct Ctx { const float* const (&in)[36]; float* const& out; unsigned char* const& ws; const int wv; };
__device__ __forceinline__ int lane_id() { int l; asm volatile("v_mbcnt_lo_u32_b32 %0, -1, 0\n\tv_mbcnt_hi_u32_b32 %0, -1, %0" : "=v"(l)); return l & 63; }
__device__ __forceinline__ int wave_of(int wv) { asm volatile("" : "+s"(wv)); return wv; }
__device__ __forceinline__ int tid_of(int wv) { return (wave_of(wv) << 6) | lane_id(); }

__device__ __forceinline__ unsigned f2bf(float f) { unsigned u = __float_as_uint(f); return (u + 0x7fffu + ((u >> 16) & 1u)) >> 16; }
__device__ __forceinline__ unsigned pk2(float lo, float hi) { return f2bf(lo) | (f2bf(hi) << 16); }
__device__ __forceinline__ float bf2f(unsigned h) { return __uint_as_float(h << 16); }
__device__ __forceinline__ float bflo(unsigned w) { return __uint_as_float(w << 16); }
__device__ __forceinline__ float bfhi(unsigned w) { return __uint_as_float(w & 0xffff0000u); }
__device__ __forceinline__ float wave_sum(float v) {
#pragma unroll
    for (int o = 1; o < 64; o <<= 1) v += __shfl_xor(v, o);
    return v;
}
__device__ __forceinline__ float siluf(float x) { return x / (1.0f + __expf(-x)); }

#define XB_TMO      128
#define XB_XCNT(j)  (256  + 64 * (j))
#define XB_XSUB(j)  (1280 + 64 * (j))
#define XB_XGEN(j)  (2304 + 64 * (j))
#define XB_TOP      3328
#define XB_TOPGEN   3392
#define XCD_BAR_WORDS 3456
#define XB_SPIN_CAP (1u << 20)

__device__ __forceinline__ unsigned xb_ld(unsigned* p)              { return __hip_atomic_load(p, __ATOMIC_RELAXED, __HIP_MEMORY_SCOPE_AGENT); }
__device__ __forceinline__ unsigned xb_add(unsigned* p, unsigned v) { return __hip_atomic_fetch_add(p, v, __ATOMIC_RELAXED, __HIP_MEMORY_SCOPE_AGENT); }
__device__ __forceinline__ unsigned xb_xcc_id() { return (unsigned)__builtin_amdgcn_s_getreg((3 << 11) | 20) & 0xFu; }
#define XB_SPIN(cond, bar) do { unsigned _sp = 0; while (cond) { __builtin_amdgcn_s_sleep(1); \
    if ((++_sp & 255u) == 0u) { if (xb_ld(&(bar)[XB_TMO])) break; if (_sp > XB_SPIN_CAP) { atomicAdd(&(bar)[XB_TMO], 1u); break; } } } } while (0)

struct XcdBarrier {
    unsigned* bar; unsigned x; int wv;
    volatile LAS unsigned* st;
};
__device__ __forceinline__ XcdBarrier xcd_barrier_post(unsigned* bar, volatile LAS unsigned* st, int wv) {
    XcdBarrier b; b.bar = bar; b.x = xb_xcc_id(); b.st = st; b.wv = wv;
    if (tid_of(wv) == 0) (void)xb_add(&bar[XB_XCNT(b.x)], 1u);
    return b;
}
__device__ __forceinline__ void xcd_barrier_complete(unsigned* bar, unsigned x, unsigned& nloc, unsigned& nx) {
    const unsigned G = gridDim.x * gridDim.y * gridDim.z;
    unsigned sum, cnt, mine, sp = 0u;
    for (;;) {
        sum = 0u; cnt = 0u; mine = 0u;
#pragma unroll
        for (unsigned j = 0; j < 16; ++j) { const unsigned c = xb_ld(&bar[XB_XCNT(j)]); sum += c; cnt += (c > 0u) ? 1u : 0u; mine = (j == x) ? c : mine; }
        if (sum == G) break;
        __builtin_amdgcn_s_sleep(1);
        if ((++sp & 255u) == 0u) { if (xb_ld(&bar[XB_TMO])) break; if (sp > XB_SPIN_CAP) { atomicAdd(&bar[XB_TMO], 1u); break; } }
    }
    nloc = mine > 0u ? mine : 1u; nx = cnt > 0u ? cnt : 1u;
}
__device__ __forceinline__ void xcd_barrier(const XcdBarrier& b) {
    asm volatile("s_waitcnt vmcnt(0)" ::: "memory");
    __syncthreads();
    if (tid_of(b.wv) == 0) {
        unsigned* bar = b.bar;
        __builtin_amdgcn_s_waitcnt(0);
        unsigned nloc = b.st[0], nx = b.st[1];
        if (nloc == 0u) { xcd_barrier_complete(bar, b.x, nloc, nx); b.st[0] = nloc; b.st[1] = nx; }
        const unsigned old = xb_add(&bar[XB_XSUB(b.x)], 1u);
        const unsigned gen = old / nloc;
        if (old + 1u == (gen + 1u) * nloc) {
            __builtin_amdgcn_fence(__ATOMIC_RELEASE, "agent");
            asm volatile("s_waitcnt vmcnt(0)" ::: "memory");
            const unsigned og = xb_add(&bar[XB_TOP], 1u);
            const unsigned tg = og / nx;
            if (og + 1u == (tg + 1u) * nx) xb_add(&bar[XB_TOPGEN], 1u);
            else XB_SPIN(xb_ld(&bar[XB_TOPGEN]) == tg, bar);
            __builtin_amdgcn_fence(__ATOMIC_ACQUIRE, "agent");
            xb_add(&bar[XB_XGEN(b.x)], 1u);
            asm volatile("s_waitcnt vmcnt(0)" ::: "memory");
        } else {
            XB_SPIN(xb_ld(&bar[XB_XGEN(b.x)]) == gen, bar);
            __builtin_amdgcn_fence(__ATOMIC_ACQUIRE, "agent");
            asm volatile("s_waitcnt vmcnt(0)" ::: "memory");
        }
    }
    __syncthreads();
}

namespace pg8 {
struct StaticOrder {
    int nM, nN, nwg, G, c;
    __device__ __forceinline__ void init(int M, int N, int G_, int c_) { nM = M / BM; nN = N / BM; nwg = nM * nN; G = G_; c = c_; }
    __device__ __forceinline__ bool next(int i, Unit& u) const {
        const long L = (long)i * G + c; if (L >= nwg) return false;
        int wgid = (int)L; { const int q = nwg / NXCD, r = nwg % NXCD, xcd = wgid % NXCD, off = wgid / NXCD; wgid = (xcd < r ? xcd * (q + 1) : r * (q + 1) + (xcd - r) * q) + off; }
        const int nig = WGM * nN, gid = wgid / nig, fm = gid * WGM, gsz = (nM - fm) < WGM ? (nM - fm) : WGM;
        u.pm = fm + ((wgid % nig) % gsz); u.pn = (wgid % nig) / gsz; u.ko = 0; return true;
    }
    __device__ __forceinline__ void a_ready(const Unit&) const {}
    __device__ __forceinline__ void done(const Unit&) const {}
};
struct OrderL1In {
    StaticOrder S; int G, c;
    __device__ __forceinline__ void init(int G_, int c_) { S.init(32768, 2304, G_, c_); G = G_; c = c_; }
    __device__ __forceinline__ bool next(int i, Unit& u) const {
        const long L = (long)i * G + c;
        if (L < S.nwg) return S.next(i, u);
        const int r = (int)(L - S.nwg); if (r >= 2) return false;
        u.pm = 128 + r; u.pn = 2; u.ko = 0; return true;
    }
    __device__ __forceinline__ void a_ready(const Unit&) const {}
    __device__ __forceinline__ void done(const Unit&) const {}
};
struct OrderMoe {
    const int* panel_e; const int* list; int np, ncol, G, c, down, nd;
    __device__ __forceinline__ bool next(int i, Unit& u) const {
        int pl, j;
        if (np == 128 && G == 256) {
            int ii = i, cc = c;
            if (nd > 0) {
                const int sk = (5 * nd <= 256) ? 4 : 3;
                if (c < nd) { ii = i + sk; if (ii >= ncol / 2) return false; }
                else if (i >= ncol / 2) { const int e = c - nd; if (i > ncol / 2 || e >= sk * nd) return false; ii = e / nd; cc = e % nd; }
            } else if ((long)i * G + c >= (long)np * ncol) return false;
            const int x = cc & 7, k = cc >> 3, ntg = ncol >> 2, hf = ii / ntg, tg = ii - hf * ntg; pl = 16 * x + 8 * hf + (k & 7); j = 4 * tg + (k >> 3);
        } else { const long L = (long)i * G + c; if (L >= (long)np * ncol) return false; pl = (int)(L % np); j = (int)(L / np); }
        const int pabs = __builtin_amdgcn_readfirstlane(list[pl]);
        u.pm = down ? (pabs & 127) : pabs; u.pn = __builtin_amdgcn_readfirstlane(panel_e[pabs]) * ncol + j; u.ko = 0; return true;
    }
    __device__ __forceinline__ void a_ready(const Unit&) const {}
    __device__ __forceinline__ void done(const Unit&) const {}
};

template <int KOB = 512>
struct OrderCtxSplitT {
    int ntile, nks, G, c;
    __device__ __forceinline__ bool next(int i, Unit& u) const {
        const int e = i * G + c; if (e >= 2 * ntile * nks) return false;
        u.pm = 128 + (e & 1); u.pn = (e >> 1) % ntile; u.ko = ((e >> 1) / ntile) * KOB; return true;
    }
    __device__ __forceinline__ void a_ready(const Unit&) const {}
    __device__ __forceinline__ void done(const Unit&) const {}
};
typedef OrderCtxSplitT<512> OrderCtxSplit;

struct EpiStoreBf16 {
    static constexpr bool PERM = true, AFTER_DRAIN = false;
    bf16_t* O; int ldc;
    __device__ __forceinline__ void operator()(const f32x4 (&acc)[2][2][4][2], const Unit& u, int wr, int wc, int fr, int fq) const {
        const int row0 = u.pm * BM + wr * 64 + fr, col0 = u.pn * BM + wc * 32 + 8 * fq;
#pragma unroll
        for (int ai = 0; ai < 2; ++ai)
#pragma unroll
            for (int m = 0; m < 4; ++m) { bf16_t* rowp = O + (size_t)(row0 + ai * HALF + m * 16) * ldc + col0;
#pragma unroll
                for (int bj = 0; bj < 2; ++bj) { const f32x4 v0 = acc[ai][bj][m][0], v1 = acc[ai][bj][m][1];
                    u32x4 w; w.x = cvt_pk_bf16(v0[0], v0[1]); w.y = cvt_pk_bf16(v0[2], v0[3]); w.z = cvt_pk_bf16(v1[0], v1[1]); w.w = cvt_pk_bf16(v1[2], v1[3]);
                    *(u32x4*)(rowp + bj * HALF) = w; } }
    }
};
__device__ __forceinline__ float silu_fast(float x) { return x * __builtin_amdgcn_rcpf(1.0f + __expf(-x)); }
typedef float f32x2 __attribute__((ext_vector_type(2)));
__device__ __forceinline__ f32x2 swiglu2(f32x2 g, f32x2 u, float gs, float us) {
    const f32x2 t = g * (-1.4426950408889634f * gs);
    f32x2 d; d.x = __builtin_amdgcn_exp2f(t.x); d.y = __builtin_amdgcn_exp2f(t.y);
    d = d + 1.0f;
    f32x2 rc; rc.x = __builtin_amdgcn_rcpf(d.x); rc.y = __builtin_amdgcn_rcpf(d.y);
    return (g * rc) * (u * (gs * us));
}
struct EpiSwiglu {
    static constexpr bool PERM = true, AFTER_DRAIN = false;
    bf16_t* O; int ldc; int pm_mask; int ncol;
    __device__ __forceinline__ void operator()(const f32x4 (&acc)[2][2][4][2], const Unit& u, int wr, int wc, int fr, int fq) const {
        const int row0 = (u.pm & pm_mask) * BM + wr * 64 + fr, col0 = (u.pn % ncol) * HALF + wc * 32 + 8 * fq;
#pragma unroll
        for (int ai = 0; ai < 2; ++ai)
#pragma unroll
            for (int m = 0; m < 4; ++m) { bf16_t* rowp = O + (size_t)(row0 + ai * HALF + m * 16) * ldc + col0;
                const f32x4 g0 = acc[ai][0][m][0], g1 = acc[ai][0][m][1], u0 = acc[ai][1][m][0], u1 = acc[ai][1][m][1];
                float r[8];
#pragma unroll
                for (int j = 0; j < 2; ++j) { const f32x2 a0 = swiglu2((f32x2){g0[2 * j], g0[2 * j + 1]}, (f32x2){u0[2 * j], u0[2 * j + 1]}, 1.0f, 1.0f), a1 = swiglu2((f32x2){g1[2 * j], g1[2 * j + 1]}, (f32x2){u1[2 * j], u1[2 * j + 1]}, 1.0f, 1.0f);
                    r[2 * j] = a0.x; r[2 * j + 1] = a0.y; r[4 + 2 * j] = a1.x; r[5 + 2 * j] = a1.y; }
                u32x4 w; w.x = cvt_pk_bf16(r[0], r[1]); w.y = cvt_pk_bf16(r[2], r[3]); w.z = cvt_pk_bf16(r[4], r[5]); w.w = cvt_pk_bf16(r[6], r[7]);
                *(u32x4*)rowp = w; }
    }
};
constexpr float F8_SX = 16.f, F8_SW = 256.f, F8_SA = 8.f;
__device__ __forceinline__ unsigned pk4_fp8(float a, float b, float c, float d) {
    a = __builtin_amdgcn_fmed3f(a, -448.f, 448.f); b = __builtin_amdgcn_fmed3f(b, -448.f, 448.f); c = __builtin_amdgcn_fmed3f(c, -448.f, 448.f); d = __builtin_amdgcn_fmed3f(d, -448.f, 448.f);
    int w = __builtin_amdgcn_cvt_pk_fp8_f32(a, b, 0, false); w = __builtin_amdgcn_cvt_pk_fp8_f32(c, d, w, true); return (unsigned)w; }
template <int INSC = 4096>
struct EpiSwigluF8T {
    static constexpr bool PERM = true, AFTER_DRAIN = false;
    unsigned char* O; int ldc; int pm_mask; int ncol;
    __device__ __forceinline__ void operator()(const f32x4 (&acc)[2][2][4][2], const Unit& u, int wr, int wc, int fr, int fq) const {
        const int row0 = (u.pm & pm_mask) * BM + wr * 64 + fr, col0 = (u.pn % ncol) * HALF + wc * 32 + 8 * fq;
        constexpr float gi = 1.0f / (float)INSC, ui = F8_SA / (float)INSC;
#pragma unroll
        for (int ai = 0; ai < 2; ++ai)
#pragma unroll
            for (int m = 0; m < 4; ++m) { unsigned char* rowp = O + (size_t)(row0 + ai * HALF + m * 16) * ldc + col0;
                const f32x4 g0 = acc[ai][0][m][0], g1 = acc[ai][0][m][1], u0 = acc[ai][1][m][0], u1 = acc[ai][1][m][1];
                float r[8];
#pragma unroll
                for (int j = 0; j < 2; ++j) { const f32x2 a0 = swiglu2((f32x2){g0[2 * j], g0[2 * j + 1]}, (f32x2){u0[2 * j], u0[2 * j + 1]}, gi, ui), a1 = swiglu2((f32x2){g1[2 * j], g1[2 * j + 1]}, (f32x2){u1[2 * j], u1[2 * j + 1]}, gi, ui);
                    r[2 * j] = a0.x; r[2 * j + 1] = a0.y; r[4 + 2 * j] = a1.x; r[5 + 2 * j] = a1.y; }
                typedef unsigned u32x2 __attribute__((ext_vector_type(2)));
                u32x2 w; w.x = pk4_fp8(r[0], r[1], r[2], r[3]); w.y = pk4_fp8(r[4], r[5], r[6], r[7]);
                *(u32x2*)rowp = w; }
    }
};
typedef EpiSwigluF8T<4096> EpiSwigluF8;
template <int SDIV = 1>
struct EpiResidT {
    static constexpr bool PERM = false, AFTER_DRAIN = false;
    const float* src_lat; const float* src_ctx; float* dst_lat; float* dst_ctx; const float* gate;
    __device__ __forceinline__ void operator()(const f32x4 (&acc)[2][2][4][2], const Unit& u, int wr, int wc, int fr, int fq) const {
        const bool isctx = u.pm >= 128; const int cond = isctx ? 2 : (u.pm >> 6);
        const int row0 = (isctx ? u.pm - 128 : u.pm) * BM + wr * 64 + fr, col0 = u.pn * BM + wc * 32 + 4 * fq;
        const float* sp = isctx ? src_ctx : src_lat; float* dp = isctx ? dst_ctx : dst_lat;
        f32x4 gv[2][2];
#pragma unroll
        for (int bj = 0; bj < 2; ++bj)
#pragma unroll
            for (int n = 0; n < 2; ++n) gv[bj][n] = *(const f32x4*)(gate + cond * 6144 + col0 + bj * HALF + n * 16) * (1.0f / (float)SDIV);
#pragma unroll
        for (int ai = 0; ai < 2; ++ai)
#pragma unroll
            for (int m = 0; m < 4; ++m) { const size_t off = (size_t)(row0 + ai * HALF + m * 16) * 1024 + col0;
#pragma unroll
                for (int bj = 0; bj < 2; ++bj)
#pragma unroll
                    for (int n = 0; n < 2; ++n) { const f32x4 s = *(const f32x4*)(sp + off + bj * HALF + n * 16); *(f32x4*)(dp + off + bj * HALF + n * 16) = s + gv[bj][n] * acc[ai][bj][m][n]; } }
    }
};
typedef EpiResidT<1> EpiResid;
template <int KOSH = 9, int SDIV = 1>
struct EpiPartialT {
    static constexpr bool PERM = false, AFTER_DRAIN = false;
    float* P;
    __device__ __forceinline__ void operator()(const f32x4 (&acc)[2][2][4][2], const Unit& u, int wr, int wc, int fr, int fq) const {
        const int row0 = (u.pm - 128) * BM + wr * 64 + fr, col0 = u.pn * BM + wc * 32 + 4 * fq;
        float* base = P + (size_t)(u.ko >> KOSH) * 512 * 1024;
#pragma unroll
        for (int ai = 0; ai < 2; ++ai)
#pragma unroll
            for (int m = 0; m < 4; ++m) { float* rp = base + (size_t)(row0 + ai * HALF + m * 16) * 1024 + col0;
#pragma unroll
                for (int bj = 0; bj < 2; ++bj)
#pragma unroll
                    for (int n = 0; n < 2; ++n) *(f32x4*)(rp + bj * HALF + n * 16) = acc[ai][bj][m][n] * (1.0f / (float)SDIV); }
    }
};
typedef EpiPartialT<9, 1> EpiPartial;
struct EpiMoeDown {
    static constexpr bool PERM = false, AFTER_DRAIN = false;
    float* out; const float* gate; const int* slot_tok; const float* slot_w; const int* res2abs;
    __device__ __forceinline__ void operator()(const f32x4 (&acc)[2][2][4][2], const Unit& u, int wr, int wc, int fr, int fq) const {
        const int slot0 = __builtin_amdgcn_readfirstlane(res2abs[u.pm]) * BM + wr * 64 + fr, col0 = (u.pn & 3) * BM + wc * 32 + 4 * fq;
#pragma unroll
        for (int ai = 0; ai < 2; ++ai)
#pragma unroll
            for (int m = 0; m < 4; ++m) { const int s = slot0 + ai * HALF + m * 16; const int tok = slot_tok[s];
                if (tok >= 0) { const float w = slot_w[s] * (1.0f / (F8_SA * F8_SW)); const float* gp = gate + (tok >> 14) * 6144 + col0; float* op = out + (size_t)tok * 1024 + col0;
#pragma unroll
                    for (int bj = 0; bj < 2; ++bj)
#pragma unroll
                        for (int n = 0; n < 2; ++n) { const f32x4 g = *(const f32x4*)(gp + bj * HALF + n * 16); const f32x4 o = *(const f32x4*)(op + bj * HALF + n * 16);
                            *(f32x4*)(op + bj * HALF + n * 16) = o + (g * w) * acc[ai][bj][m][n]; } } }
    }
};
}

#define DI __device__ __forceinline__
#define GW_DECL const int lane = lane_id(), wave = wave_of(a.wv), tid = (wave << 6) | lane, G = gridDim.x, gw = blockIdx.x * NWAVES + wave, NGW = G * NWAVES; (void)gw; (void)NGW; (void)lane; (void)wave; (void)G

DI void ada_item(const Ctx& a, int item, LAS float* red) {
    GW_DECL;
    const int lyr = item / 128, cc = item % 128;
    const float* W = a.in[lyr ? 21 : 4]; const float* B = a.in[lyr ? 22 : 5];
    float* ADA = (float*)(a.ws + WS_ADA);
    LAS float* sil = red + 2048;
    for (int i = tid; i < 3072; i += NTHR) { const int j = i >> 10, k = i & 1023; const float cv = (j == 0) ? a.in[1][k] : (j == 1) ? a.in[1][1024 + k] : a.in[3][k]; sil[i] = siluf(cv); }
    __syncthreads();
    const int col = cc * 48 + (lane < 48 ? lane : 47);
    float acc0 = 0.f, acc1 = 0.f, acc2 = 0.f;
    const int k0 = wave * 128;
#pragma unroll 16
    for (int k = k0; k < k0 + 128; ++k) {
        const float wv = W[(size_t)k * 6144 + col];
        acc0 += sil[k] * wv; acc1 += sil[1024 + k] * wv; acc2 += sil[2048 + k] * wv;
    }
    red[(wave * 3 + 0) * 64 + lane] = acc0; red[(wave * 3 + 1) * 64 + lane] = acc1; red[(wave * 3 + 2) * 64 + lane] = acc2;
    __syncthreads();
    if (tid < 192) { const int j = tid >> 6, l = tid & 63;
        if (l < 48) { float s = B[cc * 48 + l];
#pragma unroll
            for (int w = 0; w < 8; ++w) s += red[(w * 3 + j) * 64 + l];
            ADA[(lyr * 3 + j) * 6144 + cc * 48 + l] = s; } }
    __syncthreads();
}

DI void filt_hidden_item(const Ctx& a, int item, LAS float* sm) {
    GW_DECL;
    LAS float* w1s = sm;
    LAS float* b1s = sm + 2112;
    LAS float* frs = sm + 2176;
    LAS float* w2s = sm + 2240;
    LAS float* b2s = sm + 6336;
    const float* w1 = a.in[10]; const float* b1 = a.in[11]; const float* fr = a.in[12]; const float* w2 = a.in[13]; const float* b2 = a.in[14];
    for (int i = tid; i < 2112; i += NTHR) w1s[i] = w1[i];
    for (int i = tid; i < 4096; i += NTHR) w2s[i] = w2[i];
    if (tid < 64) { b1s[tid] = b1[tid]; frs[tid] = fr[tid]; b2s[tid] = b2[tid]; }
    __syncthreads();
    const bool isctx = item >= 32;
    const int Ln = isctx ? CTXL : SEQL;
    const int n = isctx ? tid : item * 512 + tid;
    float* H = isctx ? (float*)(a.ws + WS_H2C) : (float*)(a.ws + WS_H2);
    if (n < Ln) {
        float z[33];
        z[0] = (float)n / (float)(Ln - 1);
#pragma unroll
        for (int q = 0; q < 16; ++q) { const float fq = 1e-4f + (float)q * ((15.0f - 1e-4f) / 15.0f); const float x = (float)n * fq / (float)Ln;
            z[1 + q] = __builtin_amdgcn_cosf(x); z[17 + q] = -__builtin_amdgcn_sinf(x); }
        f32x4 acc2[16];
#pragma unroll
        for (int o4 = 0; o4 < 16; ++o4) acc2[o4] = *(LAS f32x4*)(b2s + o4 * 4);
#pragma unroll 2
        for (int i = 0; i < 64; ++i) {
            float acc = b1s[i];
#pragma unroll
            for (int q = 0; q < 33; ++q) acc += z[q] * w1s[q * 64 + i];
            const float h1 = __builtin_amdgcn_sinf(frs[i] * acc * 0.15915494309189535f);
#pragma unroll
            for (int o4 = 0; o4 < 16; ++o4) acc2[o4] += h1 * *(LAS f32x4*)(w2s + i * 64 + o4 * 4);
        }
#pragma unroll
        for (int o4 = 0; o4 < 16; ++o4) { const f32x4 f = *(LAS f32x4*)(frs + o4 * 4); f32x4 v;
#pragma unroll
            for (int j = 0; j < 4; ++j) v[j] = __builtin_amdgcn_sinf(f[j] * acc2[o4][j] * 0.15915494309189535f);
            *(f32x4*)(H + (size_t)n * 64 + o4 * 4) = v; }
    }
    __syncthreads();
}

DI void transpose_item(const float* W, int K, int N, bf16* WT, int dst_row0, LAS float* scr, int kb, int n0, int lane) {
    const int k0 = 64 * kb;
    float wv[32];
#pragma unroll
    for (int i = 0; i < 32; ++i) { const int kk = 2 * i + (lane >> 5); wv[i] = W[(size_t)(k0 + kk) * N + n0 + (lane & 31)]; }
#pragma unroll
    for (int i = 0; i < 32; ++i) { const int kk = 2 * i + (lane >> 5); scr[kk * 33 + (lane & 31)] = wv[i]; }
    asm volatile("s_waitcnt lgkmcnt(0)" ::: "memory");
    const int c = lane & 7;
#pragma unroll
    for (int j = 0; j < 4; ++j) { const int n = (lane >> 3) + 8 * j; const LAS float* s = scr + (8 * c) * 33 + n;
        v4u o; o.x = pk2(s[0 * 33], s[1 * 33]); o.y = pk2(s[2 * 33], s[3 * 33]); o.z = pk2(s[4 * 33], s[5 * 33]); o.w = pk2(s[6 * 33], s[7 * 33]);
        *(v4u*)(WT + (size_t)(dst_row0 + n) * K + k0 + 8 * c) = o; }
    asm volatile("s_waitcnt lgkmcnt(0)" ::: "memory");
}
DI void transpose_item_f8(const float* W, int K, int N, unsigned char* WT, int dst_row0, LAS float* scr, int kb, int n0, int lane) {
    const int k0 = 64 * kb;
    float wv[32];
#pragma unroll
    for (int i = 0; i < 32; ++i) { const int kk = 2 * i + (lane >> 5); wv[i] = __builtin_nontemporal_load(W + (size_t)(k0 + kk) * N + n0 + (lane & 31)); }
#pragma unroll
    for (int i = 0; i < 32; ++i) { const int kk = 2 * i + (lane >> 5); scr[kk * 33 + (lane & 31)] = wv[i] * pg8::F8_SW; }
    asm volatile("s_waitcnt lgkmcnt(0)" ::: "memory");
    const int c = lane & 7;
#pragma unroll
    for (int j = 0; j < 4; ++j) { const int n = (lane >> 3) + 8 * j; const LAS float* s = scr + (8 * c) * 33 + n;
        v2u o; o.x = pg8::pk4_fp8(s[0 * 33], s[1 * 33], s[2 * 33], s[3 * 33]); o.y = pg8::pk4_fp8(s[4 * 33], s[5 * 33], s[6 * 33], s[7 * 33]);
        *(v2u*)(WT + (size_t)(dst_row0 + n) * K + k0 + 8 * c) = o; }
    asm volatile("s_waitcnt lgkmcnt(0)" ::: "memory");
}
template <bool F8 = false>
DI void conv_matrix(const float* W, int K, int N, bf16* WT, int mode, int rowbase, LAS float* scr, int& goff, int gw, int NGW, int lane) {
    const int nblk = N / 32, items = (K / 64) * nblk;
    int first = (gw - (goff % NGW)); if (first < 0) first += NGW;
    for (int it = first; it < items; it += NGW) {
        const int kb = it / nblk, n0 = (it % nblk) * 32;
        const int drow = rowbase + (mode == 0 ? n0 : ((n0 >> 7) * 256 + (mode == 2 ? 128 : 0) + (n0 & 127)));
        if constexpr (F8) transpose_item_f8(W, K, N, (unsigned char*)WT, drow, scr, kb, n0, lane); else transpose_item(W, K, N, WT, drow, scr, kb, n0, lane);
    }
    goff += items;
}
DI void fold_item(const float* W  , bf16* WT  , LAS float* scr  , const LAS float* cosT, int kb, int g, int qtr, int lane) {
    const int k0 = kb * 64;
    float wv[64];
#pragma unroll
    for (int i = 0; i < 64; ++i) wv[i] = W[(size_t)(k0 + i) * 2560 + 2304 + g * 64 + lane];
#pragma unroll
    for (int i = 0; i < 64; ++i) scr[i * 65 + lane] = wv[i];
    asm volatile("s_waitcnt lgkmcnt(0)" ::: "memory");
    float row[64];
#pragma unroll
    for (int c = 0; c < 64; ++c) row[c] = scr[lane * 65 + c];
    for (int jp = qtr * 32; jp < qtr * 32 + 32; ++jp) {
        const int jj = jp & 63, off = (jp >= 64) ? 16 : 0;
        float acc = 0.f;
#pragma unroll
        for (int c = 0; c < 64; ++c) acc += row[c] * cosT[(jj * c + off) & 63];
        WT[(size_t)(2304 + g * 128 + jp) * 1024 + k0 + lane] = (bf16)f2bf(acc);
    }
    asm volatile("s_waitcnt lgkmcnt(0)" ::: "memory");
}

DI void phase0(const Ctx& a, LAS unsigned char* lds) {
    for (int it = blockIdx.x; it < 256; it += (int)gridDim.x) ada_item(a, it, (LAS float*)lds);
    for (int it = (int)gridDim.x - 1 - (int)blockIdx.x; it < 33; it += (int)gridDim.x) filt_hidden_item(a, it, (LAS float*)lds);
    GW_DECL;
    LAS float* cosT = (LAS float*)(lds + LDS_RED);
    if (tid < 64) { float s, c; sincospif((float)tid / 32.0f, &s, &c); cosT[tid] = c; }
    __syncthreads();
    LAS float* scr = (LAS float*)(lds + wave * WAVE_SCR);
    unsigned char* ws = a.ws;
    int goff = 0;
    for (int it = gw; it < 256; it += NGW) fold_item(a.in[8], (bf16*)(ws + WS_W_EIN), scr, cosT, it >> 4, (it >> 2) & 3, it & 3, lane);
    goff += 256;
    {   const int nblk = 2304 / 32, items = 16 * nblk; int first = gw - (goff % NGW); if (first < 0) first += NGW;
        for (int it = first; it < items; it += NGW) { const int kb = it / nblk, n0 = (it % nblk) * 32; transpose_item(a.in[8], 1024, 2560, (bf16*)(ws + WS_W_EIN), n0, scr, kb, n0, lane); }
        goff += items; }
    conv_matrix(a.in[17], 1024, 1024, (bf16*)(ws + WS_W_EOUT), 0, 0, scr, goff, gw, NGW, lane);
    conv_matrix<true>(a.in[18], 1024, DFF, (bf16*)(ws + WS_W_FGU), 1, 0, scr, goff, gw, NGW, lane);
    conv_matrix<true>(a.in[19], 1024, DFF, (bf16*)(ws + WS_W_FGU), 2, 0, scr, goff, gw, NGW, lane);
    conv_matrix<true>(a.in[20], DFF, 1024, (bf16*)(ws + WS_W_FD), 0, 0, scr, goff, gw, NGW, lane);
    conv_matrix(a.in[25], 1024, N2, (bf16*)(ws + WS_W_OIN), 0, 0, scr, goff, gw, NGW, lane);
    conv_matrix(a.in[30], 1024, 1024, (bf16*)(ws + WS_W_OOUT), 0, 0, scr, goff, gw, NGW, lane);
}
DI void conv_moe_weights(const Ctx& a, LAS unsigned char* lds) {
    GW_DECL;
    LAS float* scr = (LAS float*)(lds + wave * WAVE_SCR);
    unsigned char* ws = a.ws; int goff = 0;
    for (int e = 0; e < 4; ++e) {
        conv_matrix<true>(a.in[33] + (size_t)e * 1024 * DFE, 1024, DFE, (bf16*)(ws + WS_WMGU), 1, e * 2 * DFE, scr, goff, gw, NGW, lane);
        conv_matrix<true>(a.in[34] + (size_t)e * 1024 * DFE, 1024, DFE, (bf16*)(ws + WS_WMGU), 2, e * 2 * DFE, scr, goff, gw, NGW, lane);
    }
}

DI void conv_moe_S(const Ctx& a, LAS unsigned char* lds, int it_begin, int it_end, int rank, int nranks) {
    const int lane = lane_id(), wave = wave_of(a.wv);
    LAS float* scr = (LAS float*)(lds + wave * WAVE_SCR);
#pragma unroll 1
    for (int it = it_begin + rank * NWAVES + wave; it < it_end; it += nranks * NWAVES) {
        const int m = it / 1792, r = it % 1792;
        if (m < 8) { const int e = 4 + (m >> 1), t = m & 1, kb = r / 112, n0 = (r % 112) * 32;
            transpose_item_f8(a.in[33 + t] + (size_t)e * 1024 * DFE, 1024, DFE, a.ws + WS_WMGU, e * 2 * DFE + (n0 >> 7) * 256 + (t ? 128 : 0) + (n0 & 127), scr, kb, n0, lane); }
        else { const int e = m - 8, kb = r >> 5, n0 = (r & 31) * 32;
            transpose_item_f8(a.in[35] + (size_t)e * DFE * 1024, DFE, 1024, a.ws + WS_WMD, e * 1024 + n0, scr, kb, n0, lane); }
    }
}

DI void taps_mfma_item(const Ctx& a, int item, LAS unsigned char* lds) {
    GW_DECL;
    const bool isctx = item >= 256;
    const int q = isctx ? item - 256 : item >> 6, posblk = isctx ? 0 : item & 63, cbase = q * 384;
    const int Ln = isctx ? CTXL : SEQL;
    const float* w3 = a.in[15]; const float* H = isctx ? (const float*)(a.ws + WS_H2C) : (const float*)(a.ws + WS_H2);
    bf16* KT = (bf16*)(a.ws + WS_KT); float* KTCp = (float*)(a.ws + WS_KTC);
    for (int e = tid; e < 12 * 4 * 64; e += NTHR) { const int l = e & 63, sidx = (e >> 6) & 3, cgp = e >> 8; const int r = l & 31, h = l >> 5;
        const float* src = w3 + (size_t)(16 * sidx + 8 * h) * 1536 + cbase + 32 * cgp + r;
        v4u o; o.x = pk2(src[0], src[1536]); o.y = pk2(src[2 * 1536], src[3 * 1536]); o.z = pk2(src[4 * 1536], src[5 * 1536]); o.w = pk2(src[6 * 1536], src[7 * 1536]);
        *(LAS v4u*)(lds + (size_t)e * 16) = o; }
    const int r = lane & 31, h = lane >> 5, n = posblk * 256 + wave * 32 + r;
    bf16x8 bfr[4];
#pragma unroll
    for (int sidx = 0; sidx < 4; ++sidx) { const f32x4 v0 = *(const f32x4*)(H + (size_t)n * 64 + 16 * sidx + 8 * h), v1 = *(const f32x4*)(H + (size_t)n * 64 + 16 * sidx + 8 * h + 4);
        v4u o; o.x = pk2(v0[0], v0[1]); o.y = pk2(v0[2], v0[3]); o.z = pk2(v1[0], v1[1]); o.w = pk2(v1[2], v1[3]); bfr[sidx] = __builtin_bit_cast(bf16x8, o); }
    __syncthreads();
    const float tn = (float)n / (float)(Ln - 1);
    const float min_decay = -3.0701134573253945f, max_decay = -15.350567286626973f;
    const bool bwd = cbase >= HYW;
    const int idx = (!bwd || n == 0) ? n : SEQL - n;
#pragma unroll 1
    for (int cgp = 0; cgp < 12; ++cgp) {
        f32x16 acc;
#pragma unroll
        for (int i = 0; i < 16; ++i) acc[i] = 0.f;
#pragma unroll
        for (int sidx = 0; sidx < 4; ++sidx) { const bf16x8 af = *(LAS bf16x8*)(lds + ((cgp * 4 + sidx) * 64 + lane) * 16); acc = __builtin_amdgcn_mfma_f32_32x32x16_bf16(af, bfr[sidx], acc, 0, 0, 0); }
#pragma unroll
        for (int i = 0; i < 16; ++i) { const int c = cbase + 32 * cgp + (i & 3) + 8 * (i >> 2) + 4 * h, cc = c % HYW;
            const float delta = fabsf(min_decay + (float)cc * ((max_decay - min_decay) / 767.0f));
            const float val = acc[i] * __builtin_amdgcn_exp2f(-tn * delta * 1.4426950408889634f);
            if (isctx) KTCp[(size_t)c * CTXL + n] = val;
            else KT[(size_t)c * UTP + idx] = (bf16)((bwd && n == 0) ? 0u : f2bf(val)); }
    }
    __syncthreads();
}

template <bool F8 = false>
DI void norm_rows(const float* xlat, const float* xctx, const float* gain, const float* ADA  , int sh_off, int sc_off, bf16* H, int nrows, int gw, int NGW, int lane) {
    f32x4 nv[2][4];
#pragma unroll
    for (int q = 0; q < 2; ++q) { const int r = gw + q * NGW;
        if (r < nrows) { const float* xr = (r < T_LAT) ? xlat + (size_t)r * DM : xctx + (size_t)(r - T_LAT) * DM;
#pragma unroll
            for (int j = 0; j < 4; ++j) nv[q][j] = *(const f32x4*)(xr + 4 * lane + 256 * j); } }
    for (int r0 = gw; r0 < nrows; r0 += 2 * NGW) {
        f32x4 v[2][4];
#pragma unroll
        for (int q = 0; q < 2; ++q)
#pragma unroll
            for (int j = 0; j < 4; ++j) v[q][j] = nv[q][j];
#pragma unroll
        for (int q = 0; q < 2; ++q) { const int rn = r0 + (2 + q) * NGW;
            if (rn < nrows) { const float* xr = (rn < T_LAT) ? xlat + (size_t)rn * DM : xctx + (size_t)(rn - T_LAT) * DM;
#pragma unroll
                for (int j = 0; j < 4; ++j) nv[q][j] = *(const f32x4*)(xr + 4 * lane + 256 * j); } }
#pragma unroll
        for (int q = 0; q < 2; ++q) { const int r = r0 + q * NGW;
            if (r < nrows) {
                const int cond = r >> 14;
                float ss = 0.f;
#pragma unroll
                for (int j = 0; j < 4; ++j) ss += (v[q][j].x * v[q][j].x + v[q][j].y * v[q][j].y) + (v[q][j].z * v[q][j].z + v[q][j].w * v[q][j].w);
                const float rstd = 1.0f / sqrtf(wave_sum(ss) * (1.0f / DM) + 1e-6f);
#pragma unroll
                for (int j = 0; j < 4; ++j) {
                    const int c = 4 * lane + 256 * j;
                    const f32x4 g = *(const f32x4*)(gain + c), sc = *(const f32x4*)(ADA + cond * 6144 + sc_off + c), sh = *(const f32x4*)(ADA + cond * 6144 + sh_off + c);
                    const f32x4 y = (v[q][j] * rstd) * g * (sc + 1.0f) + sh;
                    if constexpr (F8) *(unsigned*)((unsigned char*)H + (size_t)r * DM + c) = pg8::pk4_fp8(y.x * pg8::F8_SX, y.y * pg8::F8_SX, y.z * pg8::F8_SX, y.w * pg8::F8_SX);
                    else { v2u o; o.x = pk2(y.x, y.y); o.y = pk2(y.z, y.w);
                    *(v2u*)(H + (size_t)r * DM + c) = o; }
                } } }
    }
}

template <int NKS, bool F8 = false>
DI void norm_ctx_partial(const float* xsrc, const float* gain, const float* ADA, int sh_off, int sc_off, bf16* Hout, const float* part, const float* pgate, float* wb, int gw, int NGW, int lane) {
    for (int rc = gw; rc < T_CTX; rc += NGW) {
        f32x4 v[4]; float ss = 0.f;
#pragma unroll
        for (int j = 0; j < 4; ++j) { const int c = 4 * lane + 256 * j;
            f32x4 pl[NKS];
#pragma unroll
            for (int sl = 0; sl < NKS; ++sl) pl[sl] = *(const f32x4*)(part + ((size_t)sl * 512 + rc) * 1024 + c);
            const f32x4 x0 = *(const f32x4*)(xsrc + (size_t)rc * DM + c), pg = *(const f32x4*)(pgate + c);
            f32x4 sum = pl[0];
#pragma unroll
            for (int sl = 1; sl < NKS; ++sl) sum += pl[sl];
            const f32x4 x = x0 + pg * sum;
            if (wb) *(f32x4*)(wb + (size_t)rc * DM + c) = x;
            v[j] = x;
            ss += (x.x * x.x + x.y * x.y) + (x.z * x.z + x.w * x.w); }
        const float rstd = 1.0f / sqrtf(wave_sum(ss) * (1.0f / DM) + 1e-6f);
#pragma unroll
        for (int j = 0; j < 4; ++j) { const int c = 4 * lane + 256 * j;
            const f32x4 g = *(const f32x4*)(gain + c), sc = *(const f32x4*)(ADA + 2 * 6144 + sc_off + c), sh = *(const f32x4*)(ADA + 2 * 6144 + sh_off + c);
            const f32x4 y = (v[j] * rstd) * g * (sc + 1.0f) + sh;
            if constexpr (F8) *(unsigned*)((unsigned char*)Hout + (size_t)(T_LAT + rc) * DM + c) = pg8::pk4_fp8(y.x * pg8::F8_SX, y.y * pg8::F8_SX, y.z * pg8::F8_SX, y.w * pg8::F8_SX);
            else { v2u o; o.x = pk2(y.x, y.y); o.y = pk2(y.z, y.w);
            *(v2u*)(Hout + (size_t)(T_LAT + rc) * DM + c) = o; } }
    }
}

DI void norm_router_phase(const Ctx& a, LAS unsigned char* lds) {
    GW_DECL;
    LAS float* rw = (LAS float*)lds;
    LAS int* cnt = (LAS int*)(lds + LDS_RED);
    const float* RW = a.in[31]; const float* RB = a.in[32];
    for (int i = tid; i < 8192; i += NTHR) rw[i] = RW[i];
    if (tid < 16) cnt[tid] = 0;
    __syncthreads();
    const float* ADA = (const float*)(a.ws + WS_ADA) + 3 * 6144;
    const float* gain = a.in[24];
    bf16* H = (bf16*)(a.ws + WS_H);
    int* toke = (int*)(a.ws + WS_TOKE); float* tokg = (float*)(a.ws + WS_TOKG);
    const int RPB = T_LAT / G;
    f32x4 nv[4];
    {   const float* xr = a.out + (size_t)(blockIdx.x * RPB + wave) * DM;
#pragma unroll
        for (int j = 0; j < 4; ++j) nv[j] = *(const f32x4*)(xr + 4 * lane + 256 * j); }
    for (int rr = wave; rr < RPB; rr += NWAVES) {
        const int r = blockIdx.x * RPB + rr, cond = r >> 14;
        f32x4 v[4]; float ss = 0.f;
#pragma unroll
        for (int j = 0; j < 4; ++j) { v[j] = nv[j]; ss += (v[j].x * v[j].x + v[j].y * v[j].y) + (v[j].z * v[j].z + v[j].w * v[j].w); }
        if (rr + NWAVES < RPB) { const float* xr = a.out + (size_t)(r + NWAVES) * DM;
#pragma unroll
            for (int j = 0; j < 4; ++j) nv[j] = *(const f32x4*)(xr + 4 * lane + 256 * j); }
        const float rstd = 1.0f / sqrtf(wave_sum(ss) * (1.0f / DM) + 1e-6f);
        float lg[8];
#pragma unroll
        for (int e = 0; e < 8; ++e) lg[e] = 0.f;
#pragma unroll
        for (int j = 0; j < 4; ++j) {
            const int c = 4 * lane + 256 * j;
            const f32x4 g = *(const f32x4*)(gain + c), sc = *(const f32x4*)(ADA + cond * 6144 + 4096 + c), sh = *(const f32x4*)(ADA + cond * 6144 + 3072 + c);
            const f32x4 y = (v[j] * rstd) * g * (sc + 1.0f) + sh;
            *(unsigned*)((unsigned char*)H + (size_t)r * DM + c) = pg8::pk4_fp8(y.x * pg8::F8_SX, y.y * pg8::F8_SX, y.z * pg8::F8_SX, y.w * pg8::F8_SX);
#pragma unroll
            for (int q = 0; q < 4; ++q) { const f32x4 w0 = *(LAS f32x4*)(rw + (c + q) * 8), w1 = *(LAS f32x4*)(rw + (c + q) * 8 + 4);
                lg[0] += y[q] * w0[0]; lg[1] += y[q] * w0[1]; lg[2] += y[q] * w0[2]; lg[3] += y[q] * w0[3];
                lg[4] += y[q] * w1[0]; lg[5] += y[q] * w1[1]; lg[6] += y[q] * w1[2]; lg[7] += y[q] * w1[3]; }
        }
#pragma unroll
        for (int e = 0; e < 8; ++e) lg[e] = wave_sum(lg[e]) + RB[e];
        int e1 = 0; float v1 = lg[0];
#pragma unroll
        for (int e = 1; e < 8; ++e) if (lg[e] > v1) { v1 = lg[e]; e1 = e; }
        int e2 = -1; float v2 = -3.0e38f;
#pragma unroll
        for (int e = 0; e < 8; ++e) if (e != e1 && lg[e] > v2) { v2 = lg[e]; e2 = e; }
        const float g1 = 1.0f / (1.0f + expf(v2 - v1)), g2 = 1.0f - g1;
        if (lane == 0) { toke[2 * r] = e1; toke[2 * r + 1] = e2; tokg[2 * r] = g1; tokg[2 * r + 1] = g2; __hip_atomic_fetch_add(&cnt[e1], 1, __ATOMIC_RELAXED, __HIP_MEMORY_SCOPE_WORKGROUP); __hip_atomic_fetch_add(&cnt[8 + e2], 1, __ATOMIC_RELAXED, __HIP_MEMORY_SCOPE_WORKGROUP); }
    }
    __syncthreads();
    if (tid < 16) ((int*)(a.ws + WS_BLKCNT))[blockIdx.x * 16 + tid] = cnt[tid];
    __syncthreads();
}

DI void slot_phase(const Ctx& a, LAS unsigned char* lds) {
    GW_DECL;
    LAS int* tot = (LAS int*)lds;
    LAS int* pre = tot + 16;
    LAS int* segstart = tot + 32;
    LAS int* cntL = tot + 64;
    LAS int* tokL = cntL + 4096;
    const int* blkcnt = (const int*)(a.ws + WS_BLKCNT);
    const int* toke = (const int*)(a.ws + WS_TOKE); const float* tokg = (const float*)(a.ws + WS_TOKG);
    const int RPB = T_LAT / G;
    for (int i = tid; i < G * 16; i += NTHR) cntL[i] = blkcnt[i];
    for (int i = tid; i < RPB * 2; i += NTHR) tokL[i] = toke[(size_t)blockIdx.x * RPB * 2 + i];
    __syncthreads();
    if (tid < 16) { int t = 0, p = 0; for (int b = 0; b < G; ++b) { const int c = cntL[b * 16 + tid]; if (b < (int)blockIdx.x) p += c; t += c; } tot[tid] = t; pre[tid] = p; }
    __syncthreads();
    if (tid == 0) { int s = 0; for (int g = 0; g < 16; ++g) { segstart[g] = s; s += ((tot[g] + 255) >> 8) << 8; } segstart[16] = s; }
    __syncthreads();
    int* slot_tok = (int*)(a.ws + WS_SLOTTOK); float* slot_w = (float*)(a.ws + WS_SLOTW);
    LAS int* posL = tokL + 2 * RPB;
    {
        LAS int* wcnt = posL + 2 * RPB;
        const bool act = tid < 2 * RPB;
        const int myseg = act ? (tid & 1) * 8 + tokL[tid] : -1;
        int rank = 0;
#pragma unroll
        for (int sg = 0; sg < 16; ++sg) { const unsigned long long m = __ballot(myseg == sg); if (myseg == sg) rank = __popcll(m & ((1ull << lane) - 1ull)); if (lane == 0 && wave < 4) wcnt[wave * 16 + sg] = __popcll(m); }
        __syncthreads();
        if (act) { int off = 0; for (int w = 0; w < wave; ++w) off += wcnt[w * 16 + myseg];
            const int pos = segstart[myseg] + pre[myseg] + off + rank, r = blockIdx.x * RPB + (tid >> 1);
            slot_tok[pos] = r; slot_w[pos] = tokg[2 * r + (tid & 1)]; posL[tid] = pos; }
    }
    __syncthreads();
    {
        const unsigned char* Hn = a.ws + WS_H; unsigned char* HP = a.ws + WS_BIG;
        for (int q0 = wave * 8; q0 < 2 * RPB; q0 += NWAVES * 8) {
            v4u v0[8]; int ps[8];
#pragma unroll
            for (int q = 0; q < 8; ++q) { const int r = blockIdx.x * RPB + ((q0 + q) >> 1); ps[q] = posL[q0 + q];
                v0[q] = *(const v4u*)(Hn + (size_t)r * DM + 16 * lane); }
#pragma unroll
            for (int q = 0; q < 8; ++q) *(v4u*)(HP + (size_t)ps[q] * DM + 16 * lane) = v0[q];
        }
        const v4u z = {0u, 0u, 0u, 0u};
        for (int g = 0; g < 16; ++g) { const int s0 = segstart[g] + tot[g], s1 = segstart[g + 1];
            for (int sl = s0 + gw; sl < s1; sl += NGW) { if (lane == 0) { slot_tok[sl] = -1; slot_w[sl] = 0.f; }
                *(v4u*)(HP + (size_t)sl * DM + 16 * lane) = z; } }
    }
    if (blockIdx.x == 0) {
        int* panel_e = (int*)(a.ws + WS_PANELE);
        for (int g = 0; g < 16; ++g) {
            for (int p = (segstart[g] >> 8) + tid; p < (segstart[g + 1] >> 8); p += NTHR) panel_e[p] = g & 7; }
    }
    if (blockIdx.x == (unsigned)(G - 1)) {
        int* panel_e = (int*)(a.ws + WS_PANELE);
        {
            const int P0 = segstart[8] >> 8, P = segstart[16] >> 8, P1 = P - P0, n0 = P0 >> 7, n1 = P1 >> 7;
            int* cnp = panel_e + PE_CNP; int* clist = panel_e + PE_LIST; int* cres = panel_e + PE_RES;
            for (int e = tid; e < (n0 + n1) * 128; e += NTHR) { const int i = e >> 7, q = e & 127, pa = (i < n0) ? 128 * i + q : P0 + 128 * (i - n0) + q;
                clist[i * 128 + q] = pa; cres[i * 128 + (pa & 127)] = pa; if (q == 0) cnp[i] = 128; }
        }
        if (tid == 0) {
            const int P0 = segstart[8] >> 8, P = segstart[16] >> 8, P1 = P - P0;
            const int n0 = P0 >> 7, r0 = P0 & 127, n1 = P1 >> 7, r1 = P1 & 127;
            int nc = n0 + n1, lastnp = 128;
            int* cnp = panel_e + PE_CNP; int* clist = panel_e + PE_LIST; int* cres = panel_e + PE_RES;
            int eA = -1, eB = -1; bool single = (r0 + r1 <= 128);
            for (int q = 0; q < r0 && single; ++q) { const int pa = 128 * n0 + q; int g = 0; while ((segstart[g + 1] >> 8) <= pa) ++g; const int e = g & 7; if (eA < 0) eA = e; else if (eA != e) single = false; }
            for (int q = 0; q < r1 && single; ++q) { const int pa = P0 + 128 * n1 + q; int g = 8; while ((segstart[g + 1] >> 8) <= pa) ++g; const int e = g & 7; if (eB < 0) eB = e; else if (eB != e) single = false; }
            if (single && r0 > 0 && r1 > 0 && eA != eB) single = false;
            if (single) { int k = 0;
                for (int q = 0; q < r0; ++q) { const int pa = 128 * n0 + q; clist[nc * 128 + k++] = pa; cres[nc * 128 + (pa & 127)] = pa; }
                for (int q = 0; q < r1; ++q) { const int pa = P0 + 128 * n1 + q; clist[nc * 128 + k++] = pa; cres[nc * 128 + (pa & 127)] = pa; }
                if (k > 0) { cnp[nc] = k; lastnp = k; ++nc; }
            } else {
                if (r0 > 0) { for (int q = 0; q < r0; ++q) { const int pa = 128 * n0 + q; clist[nc * 128 + q] = pa; cres[nc * 128 + (pa & 127)] = pa; } cnp[nc] = r0; lastnp = r0; ++nc; }
                if (r1 > 0) { for (int q = 0; q < r1; ++q) { const int pa = P0 + 128 * n1 + q; clist[nc * 128 + q] = pa; cres[nc * 128 + (pa & 127)] = pa; } cnp[nc] = r1; lastnp = r1; ++nc; }
            }
            panel_e[400] = P; panel_e[401] = P0; panel_e[402] = nc;
            int* sd = panel_e + PE_SD; int* sg = panel_e + PE_SG; int* sx = panel_e + PE_SX; int* snd = panel_e + PE_SND; int ns = 0;
            const int last = nc - 1;
            bool xok = (nc >= 2) && lastnp <= XPANELS;
            if (xok) for (int q = 0; q < lastnp; ++q) if ((clist[last * 128 + q] & 127) >= XPANELS) xok = false;
            if (xok && (n0 + n1) > 0 && G == 256) {
                sd[ns] = -1; sg[ns] = last; sx[ns] = 2; snd[ns] = 0; ++ns;
                sd[ns] = last; sg[ns] = 0; sx[ns] = 1; snd[ns] = lastnp * 4; ++ns;
                for (int chh = 1; chh < last; ++chh) { sd[ns] = chh - 1; sg[ns] = chh; sx[ns] = (((chh - 1) & 1) ? 4 : 0) | ((chh & 1) ? 8 : 0); snd[ns] = 0; ++ns; }
                sd[ns] = last - 1; sg[ns] = -1; sx[ns] = ((last - 1) & 1) ? 4 : 0; snd[ns] = 0; ++ns;
            } else {
                sd[ns] = -1; sg[ns] = 0; sx[ns] = 0; snd[ns] = 0; ++ns;
                for (int chh = 1; chh < nc; ++chh) { sd[ns] = chh - 1; sg[ns] = chh; sx[ns] = (((chh - 1) & 1) ? 4 : 0) | ((chh & 1) ? 8 : 0); snd[ns] = 0; ++ns; }
                sd[ns] = nc - 1; sg[ns] = -1; sx[ns] = ((nc - 1) & 1) ? 4 : 0; snd[ns] = 0; ++ns;
            }
            panel_e[PE_NSTEP] = ns;
        }
    }
    __syncthreads();
}

DI void gather_phase(const Ctx& a) {
    GW_DECL;
    const int P = ((const int*)(a.ws + WS_PANELE))[400];
    const int* slot_tok = (const int*)(a.ws + WS_SLOTTOK);
    const bf16* H = (const bf16*)(a.ws + WS_H); bf16* HP = (bf16*)(a.ws + WS_BIG);
    const int nslots = P * 256;
    for (int s0 = gw * 4; s0 < nslots; s0 += NGW * 4) {
        int tok[4]; v4u v0[4], v1[4];
#pragma unroll
        for (int q = 0; q < 4; ++q) tok[q] = slot_tok[s0 + q];
#pragma unroll
        for (int q = 0; q < 4; ++q) { v0[q] = (v4u){0u, 0u, 0u, 0u}; v1[q] = (v4u){0u, 0u, 0u, 0u};
            if (tok[q] >= 0) { v0[q] = *(const v4u*)(H + (size_t)tok[q] * DM + 8 * lane); v1[q] = *(const v4u*)(H + (size_t)tok[q] * DM + 512 + 8 * lane); } }
#pragma unroll
        for (int q = 0; q < 4; ++q) { *(v4u*)(HP + (size_t)(s0 + q) * DM + 8 * lane) = v0[q]; *(v4u*)(HP + (size_t)(s0 + q) * DM + 512 + 8 * lane) = v1[q]; }
    }
}

DI void prep0_phase(const Ctx& a, LAS unsigned char* lds) {
    GW_DECL;
    const bf16* P = (const bf16*)(a.ws + WS_BIG);
    bf16* A2 = (bf16*)(a.ws + WS_X0C); bf16* UT = (bf16*)(a.ws + WS_UT); unsigned* F1T = (unsigned*)(a.ws + WS_F1T);
    const float* SW = a.in[9];
    LAS bf16* raw = (LAS bf16*)lds;
    const int NH = 2 * 256 * 3, NF = 2 * 256;
    for (int it = blockIdx.x; it < NH + NF; it += G) {
        if (it < NH) {
            const int cq = it % 3, tch = (it / 3) % 256, b = it / 768, t0 = tch * 64, c0 = cq * 256;
            const size_t rowb = (size_t)b * SEQL;
            {   v4u sv[13];
#pragma unroll
                for (int i = 0; i < 13; ++i) { const int p = tid + NTHR * i; const int pc = p & 31, r = (p >> 5) % 66, sidx = p / (66 * 32); const int t = t0 - 1 + r;
                    sv[i] = (v4u){0u, 0u, 0u, 0u}; if (p < 3 * 66 * 32 && t >= 0 && t < SEQL) sv[i] = *(const v4u*)(P + (rowb + t) * N1 + sidx * HYW + c0 + pc * 8); }
#pragma unroll
                for (int i = 0; i < 13; ++i) { const int p = tid + NTHR * i; const int pc = p & 31, r = (p >> 5) % 66, sidx = p / (66 * 32);
                    if (p < 3 * 66 * 32) *(LAS v4u*)(raw + (sidx * 66 + r) * 256 + pc * 8) = sv[i]; } }
            __syncthreads();
            const int c = tid & 255, tg = tid >> 8;
            float w[3][3];
#pragma unroll
            for (int k = 0; k < 3; ++k)
#pragma unroll
                for (int sidx = 0; sidx < 3; ++sidx) w[k][sidx] = SW[k * 2304 + sidx * HYW + c0 + c];
            float pv[3], cu[3];
#pragma unroll
            for (int sidx = 0; sidx < 3; ++sidx) { pv[sidx] = bf2f(raw[(sidx * 66 + tg * 32) * 256 + c]); cu[sidx] = bf2f(raw[(sidx * 66 + tg * 32 + 1) * 256 + c]); }
            unsigned up[16];
#pragma unroll
            for (int tt = 0; tt < 32; ++tt) {
                float cv[3];
#pragma unroll
                for (int sidx = 0; sidx < 3; ++sidx) { const float nx = bf2f(raw[(sidx * 66 + tg * 32 + tt + 2) * 256 + c]);
                    cv[sidx] = w[0][sidx] * pv[sidx] + w[1][sidx] * cu[sidx] + w[2][sidx] * nx; pv[sidx] = cu[sidx]; cu[sidx] = nx; }
                A2[(rowb + t0 + tg * 32 + tt) * DM + c0 + c] = (bf16)f2bf(cv[0]);
                const unsigned ub = f2bf(cv[2] * cv[1]);
                if (tt & 1) up[tt >> 1] |= ub << 16; else up[tt >> 1] = ub;
            }
            v4u* dst = (v4u*)(UT + ((size_t)(c0 + c) * 2 + b) * UTP + t0 + tg * 32);
#pragma unroll
            for (int q = 0; q < 4; ++q) dst[q] = (v4u){up[4 * q], up[4 * q + 1], up[4 * q + 2], up[4 * q + 3]};
            __syncthreads();
        } else {
            const int f = it - NH, tch = f % 256, b = f / 256, t0 = tch * 64; const size_t rowb = (size_t)b * SEQL;
            {   v4u sv[8];
#pragma unroll
                for (int i = 0; i < 8; ++i) { const int p = tid + NTHR * i, pc = p & 63, r = p >> 6; sv[i] = *(const v4u*)(P + (rowb + t0 + r) * N1 + 2304 + pc * 8); }
#pragma unroll
                for (int i = 0; i < 8; ++i) { const int p = tid + NTHR * i, pc = p & 63, r = p >> 6; *(LAS v4u*)(raw + r * 512 + pc * 8) = sv[i]; } }
            __syncthreads();
            const int jb = tid & 255, g = jb >> 6, j = jb & 63, tg = tid >> 8;
            unsigned o[32];
#pragma unroll
            for (int tt = 0; tt < 32; ++tt) { const unsigned re = raw[(tg * 32 + tt) * 512 + g * 128 + j], im = raw[(tg * 32 + tt) * 512 + g * 128 + 64 + j]; o[tt] = re | (im << 16); }
            v4u* dst = (v4u*)(F1T + ((size_t)((b * 4 + g) * 64 + j)) * F1P + t0 + tg * 32);
#pragma unroll
            for (int q = 0; q < 8; ++q) dst[q] = (v4u){o[4 * q], o[4 * q + 1], o[4 * q + 2], o[4 * q + 3]};
            __syncthreads();
        }
    }
}

DI void untr0_phase(const Ctx& a, LAS unsigned char* lds) {
    GW_DECL;
    bf16* A2 = (bf16*)(a.ws + WS_A2); const bf16* X0C = (const bf16*)(a.ws + WS_X0C); const bf16* YT = (const bf16*)(a.ws + WS_YT); const bf16* YF = (const bf16*)(a.ws + WS_YF);
    LAS unsigned* tile32 = (LAS unsigned*)lds;
    LAS bf16* tile = (LAS bf16*)lds;
    const int NH = 2 * 256 * 3, NF = 2 * 256;
    for (int it = blockIdx.x; it < NH + NF; it += G) {
        const bool hy = it < NH;
        const int f = it - NH;
        const int cq = hy ? it % 3 : 0, tch = hy ? (it / 3) % 256 : f % 256, b = hy ? it / 768 : f / 256, t0 = tch * 64, c0 = cq * 256;
        const size_t rowb = (size_t)b * SEQL;
        {   v4u sv[4];
#pragma unroll
            for (int i = 0; i < 4; ++i) { const int p = tid + NTHR * i, pc = p & 7, c = p >> 3;
                const bf16* src = hy ? YT + ((size_t)(c0 + c) * 2 + b) * UTP + t0 + pc * 8 : YF + ((size_t)(b * 256 + c)) * UTP + t0 + pc * 8; sv[i] = *(const v4u*)src; }
#pragma unroll
            for (int i = 0; i < 4; ++i) { const int p = tid + NTHR * i, pc = p & 7, c = p >> 3; LAS unsigned* d = tile32 + c * 33 + pc * 4; d[0] = sv[i].x; d[1] = sv[i].y; d[2] = sv[i].z; d[3] = sv[i].w; } }
        __syncthreads();
        const int c8 = tid & 31, tr = tid >> 5;
        v4u xq[4];
#pragma unroll
        for (int q = 0; q < 4; ++q) { xq[q] = (v4u){0u, 0u, 0u, 0u}; if (hy) xq[q] = *(const v4u*)(X0C + (rowb + t0 + tr + 16 * q) * DM + c0 + c8 * 8); }
#pragma unroll
        for (int q = 0; q < 4; ++q) { const int t = tr + 16 * q;
            float y[8];
#pragma unroll
            for (int j = 0; j < 8; ++j) y[j] = bf2f(tile[(c8 * 8 + j) * 66 + t]);
            bf16* ap = A2 + (rowb + t0 + t) * DM + (hy ? c0 : HYW) + c8 * 8;
            v4u o;
            if (hy) { const v4u x = xq[q];
                o.x = pk2(bflo(x.x) * y[0], bfhi(x.x) * y[1]); o.y = pk2(bflo(x.y) * y[2], bfhi(x.y) * y[3]); o.z = pk2(bflo(x.z) * y[4], bfhi(x.z) * y[5]); o.w = pk2(bflo(x.w) * y[6], bfhi(x.w) * y[7]); }
            else { o.x = pk2(y[0], y[1]); o.y = pk2(y[2], y[3]); o.z = pk2(y[4], y[5]); o.w = pk2(y[6], y[7]); }
            *(v4u*)ap = o; }
        __syncthreads();
    }
}

DI void prep1_phase(const Ctx& a, LAS unsigned char* lds) {
    GW_DECL;
    const bf16* P = (const bf16*)(a.ws + WS_BIG);
    bf16* A2 = (bf16*)(a.ws + WS_A2); bf16* QR = (bf16*)(a.ws + WS_QR); bf16* KR = (bf16*)(a.ws + WS_KR); bf16* VT = (bf16*)(a.ws + WS_VT);
    bf16* KC = (bf16*)(a.ws + WS_KC); bf16* VCT = (bf16*)(a.ws + WS_VCT);
    const float* qn = a.in[26]; const float* kn = a.in[27]; const float* CW = a.in[29];
    LAS bf16* raw = (LAS bf16*)lds;
    const int NC = 1024, NQ = 1024, NQC = 16;
    const float QSCALE = 0.125f * 1.4426950408889634f;
    for (int it = blockIdx.x; it < NC + NQ + NQC; it += G) {
        if (it < NC) {
            const int b = it / 512, t0 = (it % 512) * 32; const size_t rowb = (size_t)b * SEQL;
            {   v4u sv[13];
#pragma unroll
                for (int i = 0; i < 13; ++i) { const int p = tid + NTHR * i, pc = p % 192, r = p / 192, t = t0 - 1 + r; sv[i] = (v4u){0u, 0u, 0u, 0u};
                    if (p < 34 * 192 && t >= 0 && t < SEQL) sv[i] = *(const v4u*)(P + (rowb + t) * N2 + 768 + pc * 8); }
#pragma unroll
                for (int i = 0; i < 13; ++i) { const int p = tid + NTHR * i, pc = p % 192, r = p / 192; if (p < 34 * 192) *(LAS v4u*)(raw + r * 1536 + pc * 8) = sv[i]; } }
            __syncthreads();
            const int c8 = tid & 63, tr = tid >> 6, c = 8 * c8;
            float w[3][8];
#pragma unroll
            for (int k = 0; k < 3; ++k) { const f32x4 w0 = *(const f32x4*)(CW + k * 512 + c), w1 = *(const f32x4*)(CW + k * 512 + c + 4);
                w[k][0] = w0[0]; w[k][1] = w0[1]; w[k][2] = w0[2]; w[k][3] = w0[3]; w[k][4] = w1[0]; w[k][5] = w1[1]; w[k][6] = w1[2]; w[k][7] = w1[3]; }
            float pr[6][8];
#pragma unroll
            for (int q = 0; q < 6; ++q) { const v4u gc = *(LAS v4u*)(raw + (tr * 4 + q) * 1536 + 512 + c), hx = *(LAS v4u*)(raw + (tr * 4 + q) * 1536 + 1024 + c);
                pr[q][0] = bflo(gc.x) * bflo(hx.x); pr[q][1] = bfhi(gc.x) * bfhi(hx.x); pr[q][2] = bflo(gc.y) * bflo(hx.y); pr[q][3] = bfhi(gc.y) * bfhi(hx.y);
                pr[q][4] = bflo(gc.z) * bflo(hx.z); pr[q][5] = bfhi(gc.z) * bfhi(hx.z); pr[q][6] = bflo(gc.w) * bflo(hx.w); pr[q][7] = bfhi(gc.w) * bfhi(hx.w); }
#pragma unroll
            for (int k = 0; k < 4; ++k) { const int rr = tr * 4 + k;
                const v4u gb = *(LAS v4u*)(raw + (rr + 1) * 1536 + c);
                const float gbf[8] = {bflo(gb.x), bfhi(gb.x), bflo(gb.y), bfhi(gb.y), bflo(gb.z), bfhi(gb.z), bflo(gb.w), bfhi(gb.w)};
                float y[8];
#pragma unroll
                for (int j = 0; j < 8; ++j) y[j] = gbf[j] * (w[0][j] * pr[k][j] + w[1][j] * pr[k + 1][j] + w[2][j] * pr[k + 2][j]);
                v4u o; o.x = pk2(y[0], y[1]); o.y = pk2(y[2], y[3]); o.z = pk2(y[4], y[5]); o.w = pk2(y[6], y[7]);
                *(v4u*)(A2 + (rowb + t0 + rr) * DM + 512 + c) = o; }
            __syncthreads();
        } else {
            const int i2 = it - NC; const bool isctx = i2 >= NQ;
            const int row0 = isctx ? T_LAT + (i2 - NQ) * 32 : i2 * 32;
            if (!isctx) { v4u sv[6];
#pragma unroll
                for (int i = 0; i < 6; ++i) { const int p = tid + NTHR * i, pc = p % 96, r = p / 96; sv[i] = *(const v4u*)(P + (size_t)(row0 + r) * N2 + pc * 8); }
#pragma unroll
                for (int i = 0; i < 6; ++i) { const int p = tid + NTHR * i, pc = p % 96, r = p / 96; *(LAS v4u*)(raw + r * 768 + pc * 8) = sv[i]; } }
            else { for (int p = tid; p < 32 * 32; p += NTHR) { const int pc = p & 31, r = p >> 5; *(LAS v4u*)(raw + r * 768 + 512 + pc * 8) = *(const v4u*)(P + (size_t)(row0 + r) * N2 + 512 + pc * 8); } }
            __syncthreads();
            const int d = lane, fi = d & 15;
            const float inv_freq = exp2f(-(float)fi * (13.287712379549449f / 16.0f)) * 0.15915494309189535f;
            const float gq = qn[d], gk = kn[d];
#pragma unroll 1
            for (int k = 0; k < 4; ++k) { const int rr = wave * 4 + k, row = row0 + rr;
                if (!isctx) {
                    const int t = row & (SEQL - 1);
                    const float pos = (float)((d < 32) ? (t >> 6) : (t & 63));
                    const float sn = __builtin_amdgcn_sinf(pos * inv_freq), cs = __builtin_amdgcn_cosf(pos * inv_freq);
#pragma unroll
                    for (int hh = 0; hh < 10; ++hh) {
                        const float x = bf2f(raw[rr * 768 + hh * 64 + d]);
                        const float ss = wave_sum(x * x);
                        const float xn = x * (1.0f / sqrtf(ss * (1.0f / 64.0f) + 1e-6f)) * (hh < 8 ? gq : gk);
                        const float pr = __shfl_xor(xn, 16);
                        const float o = (d & 16) ? (xn * cs + pr * sn) : (xn * cs - pr * sn);
                        if (hh < 8) QR[(size_t)row * 512 + hh * 64 + d] = (bf16)f2bf(o * QSCALE);
                        else KR[(size_t)row * 128 + (hh - 8) * 64 + d] = (bf16)f2bf(o);
                    }
                } else {
                    const int cr = row - T_LAT, bb = cr >> 8, j = cr & 255;
#pragma unroll
                    for (int kh = 0; kh < 2; ++kh) {
                        const float x = bf2f(raw[rr * 768 + 512 + kh * 64 + d]);
                        const float ss = wave_sum(x * x);
                        KC[((size_t)(bb * 256 + j) * 2 + kh) * 64 + d] = (bf16)f2bf(x * (1.0f / sqrtf(ss * (1.0f / 64.0f) + 1e-6f)) * gk);
                    }
                }
            }
            {
                const int dd = tid & 127, tg = tid >> 7;
                unsigned o[4];
#pragma unroll
                for (int q = 0; q < 4; ++q) o[q] = (unsigned)raw[(tg * 8 + 2 * q) * 768 + 640 + dd] | ((unsigned)raw[(tg * 8 + 2 * q + 1) * 768 + 640 + dd] << 16);
                if (!isctx) { const int bb = row0 >> 14, t0 = row0 & (SEQL - 1);
                    *(v4u*)(VT + ((size_t)(bb * 128 + dd)) * UTP + t0 + tg * 8) = (v4u){o[0], o[1], o[2], o[3]}; }
                else { const int cr = row0 - T_LAT, bb = cr >> 8, j0 = cr & 255;
                    *(v4u*)(VCT + ((size_t)(bb * 128 + dd)) * CTXL + j0 + tg * 8) = (v4u){o[0], o[1], o[2], o[3]}; }
            }
            __syncthreads();
        }
    }
}

DI int pidx(int i) { return i + (i >> 4); }
DI void sincos_rev(float x, float& s, float& c) { s = __builtin_amdgcn_sinf(x); c = __builtin_amdgcn_cosf(x); }
DI f32x2 cmul(f32x2 a, f32x2 b) { return (f32x2){a.x * b.x - a.y * b.y, a.x * b.y + a.y * b.x}; }
DI float c32(int i) { const float t[16] = {1.0000000000000000f, 0.9807852804032304f, 0.9238795325112867f, 0.8314696123025452f, 0.7071067811865476f, 0.5555702330196023f, 0.3826834323650898f, 0.1950903220161283f, 0.0000000000000001f, -0.1950903220161282f, -0.3826834323650897f, -0.5555702330196020f, -0.7071067811865475f, -0.8314696123025453f, -0.9238795325112867f, -0.9807852804032304f}; return t[i]; }
DI float s32(int i) { const float t[16] = {0.0000000000000000f, 0.1950903220161282f, 0.3826834323650898f, 0.5555702330196022f, 0.7071067811865475f, 0.8314696123025452f, 0.9238795325112867f, 0.9807852804032304f, 1.0000000000000000f, 0.9807852804032304f, 0.9238795325112867f, 0.8314696123025455f, 0.7071067811865476f, 0.5555702330196022f, 0.3826834323650899f, 0.1950903220161286f}; return t[i]; }

DI f32x2 cmulr(f32x2 a, f32x2 t, f32x2 tr) { return a.xx * t + a.yy * tr; }
DI f32x2 rot90(f32x2 t) { return (f32x2){-t.y, t.x}; }
template <int HPL2, int RL2, bool INV, bool FUSE = false>
DI void fft_pass(LAS f32x2* X, int tid, const f32x2* kr = nullptr) {
    constexpr int R = 1 << RL2, hp = 1 << HPL2, NB = 16384 >> RL2;
    int b0 = tid; asm volatile("" : "+v"(b0));
#pragma unroll 1
    for (int b = b0; b < NB; b += NTHR) {
        const int lo = b & (hp - 1), hi = b >> HPL2;
        const int base = hi * (hp * R) + lo, pbase = base + (base >> 4);
        f32x2 r[R];
#pragma unroll
        for (int j = 0; j < R; ++j) r[j] = X[pbase + j * hp + ((j * hp) >> 4)];
        f32x2 wp[RL2], wr[RL2];
        if (HPL2 > 0) { float s, c; sincos_rev((INV ? 1.0f : -1.0f) * (float)lo / (float)(R * hp), s, c); wp[0] = (f32x2){c, s}; wr[0] = (f32x2){-s, c};
#pragma unroll
            for (int q = 1; q < RL2; ++q) { wp[q] = cmulr(wp[q - 1], wp[q - 1], wr[q - 1]); wr[q] = rot90(wp[q]); } }
        if (!INV) {
#pragma unroll
            for (int ms = RL2 - 1; ms >= 0; --ms) {
                const int m = 1 << ms;
#pragma unroll
                for (int j = 0; j < R; ++j) if ((j & m) == 0) {
                    const f32x2 x0 = r[j], x1 = r[j + m];
                    r[j] = x0 + x1;
                    f32x2 d = x0 - x1;
                    const int idx = (j & (m - 1)) * 16 / m;
                    if (idx == 8) d = (f32x2){d.y, -d.x};
                    else if (idx != 0) d = cmulr(d, (f32x2){c32(idx), -s32(idx)}, (f32x2){s32(idx), c32(idx)});
                    if (HPL2 > 0) d = cmulr(d, wp[RL2 - 1 - ms], wr[RL2 - 1 - ms]);
                    r[j + m] = d;
                }
            }
        }
        if constexpr (FUSE) {
#pragma unroll
            for (int j = 0; j < R; ++j) r[j] = cmul(r[j], kr[j]);
        }
        if (INV || FUSE) {
#pragma unroll
            for (int ms = 0; ms < RL2; ++ms) {
                const int m = 1 << ms;
#pragma unroll
                for (int j = 0; j < R; ++j) if ((j & m) == 0) {
                    f32x2 x1 = r[j + m];
                    const int idx = (j & (m - 1)) * 16 / m;
                    if (idx == 8) x1 = (f32x2){-x1.y, x1.x};
                    else if (idx != 0) x1 = cmulr(x1, (f32x2){c32(idx), s32(idx)}, (f32x2){-s32(idx), c32(idx)});
                    if (HPL2 > 0) x1 = cmulr(x1, wp[RL2 - 1 - ms], wr[RL2 - 1 - ms]);
                    const f32x2 x0 = r[j];
                    r[j] = x0 + x1; r[j + m] = x0 - x1;
                }
            }
        }
#pragma unroll
        for (int j = 0; j < R; ++j) X[pbase + j * hp + ((j * hp) >> 4)] = r[j];
    }
}
DI void fft_fwd(LAS f32x2* X, int tid) {
    fft_pass<10, 4, false>(X, tid); __syncthreads(); fft_pass<5, 5, false>(X, tid); __syncthreads(); fft_pass<0, 5, false>(X, tid); __syncthreads();
}
DI void fft_conv_a(LAS f32x2* X, int tid, const f32x2* kr) {
    fft_pass<10, 4, false>(X, tid); __syncthreads(); fft_pass<5, 5, false>(X, tid); __syncthreads(); fft_pass<0, 5, false, true>(X, tid, kr); __syncthreads();
}
DI void fft_conv_b(LAS f32x2* X, int tid) {
    fft_pass<5, 5, true>(X, tid); __syncthreads(); fft_pass<10, 4, true>(X, tid); __syncthreads();
}
DI void fft_inv(LAS f32x2* X, int tid) {
    fft_pass<0, 5, true>(X, tid); __syncthreads(); fft_pass<5, 5, true>(X, tid); __syncthreads(); fft_pass<10, 4, true>(X, tid); __syncthreads();
}

DI void hyena_job(const Ctx& a, int c, LAS unsigned char* lds) {
    int tid_ = tid_of(a.wv);
    const int tid = tid_, lane = tid & 63, wave = tid >> 6, pb = tid + (tid >> 4);
    LAS f32x2* X = (LAS f32x2*)lds; LAS float* red = (LAS float*)(lds + LDS_RED);
    const bf16* kf = (const bf16*)(a.ws + WS_KT) + (size_t)c * UTP; const bf16* kb = (const bf16*)(a.ws + WS_KT) + (size_t)(HYW + c) * UTP;
    const bf16* U0 = (const bf16*)(a.ws + WS_UT) + (size_t)(c * 2) * UTP; const bf16* U1 = U0 + UTP;
    bf16* Y0 = (bf16*)(a.ws + WS_YT) + (size_t)(c * 2) * UTP; bf16* Y1 = Y0 + UTP;
    const float skip = a.in[16][c];
    f32x2 kreg[32];
    unsigned* PART = (unsigned*)(a.ws + WS_PART) + (size_t)blockIdx.x * SEQL;
    const float sc = 0.5f / (float)SEQL;
    float l1 = 0.f;
    v4u fv[4], bv[4], u0v[4], u1v[4];
#pragma unroll
    for (int i = 0; i < 4; ++i) { const int n0 = 8 * tid + 4096 * i; fv[i] = *(const v4u*)(kf + n0); bv[i] = *(const v4u*)(kb + n0); }
    {
#pragma unroll
        for (int i = 0; i < 4; ++i) { const int n0 = 8 * tid + 4096 * i; const unsigned fw[4] = {fv[i].x, fv[i].y, fv[i].z, fv[i].w}, bw[4] = {bv[i].x, bv[i].y, bv[i].z, bv[i].w};
#pragma unroll
            for (int j = 0; j < 4; ++j) { const float f0 = bflo(fw[j]), f1 = bfhi(fw[j]), b0 = bflo(bw[j]), b1 = bfhi(bw[j]);
                l1 += (fabsf(f0) + fabsf(b0)) + (fabsf(f1) + fabsf(b1));
                X[pidx(n0 + 2 * j)] = (f32x2){f0 + b0, 0.f}; X[pidx(n0 + 2 * j + 1)] = (f32x2){f1 + b1, 0.f}; } }
    }
    l1 = wave_sum(l1); if (lane == 0) red[wave] = l1;
    __syncthreads();
    float tot = 0.f;
#pragma unroll
    for (int w = 0; w < 8; ++w) tot += red[w];
    const float inv = 1.0f / tot;
#pragma unroll
    for (int i = 0; i < 4; ++i) { const int n0 = 8 * tid + 4096 * i; u0v[i] = *(const v4u*)(U0 + n0); u1v[i] = *(const v4u*)(U1 + n0); }
    fft_fwd(X, tid);
#pragma unroll
    for (int i = 0; i < 32; ++i) { const f32x2 v = X[34 * tid + i + (i >> 4)]; kreg[i] = (f32x2){v.x * inv + skip, v.y * inv}; }
    __syncthreads();
    {
#pragma unroll
        for (int i = 0; i < 4; ++i) { const int n0 = 8 * tid + 4096 * i; const unsigned aw[4] = {u0v[i].x, u0v[i].y, u0v[i].z, u0v[i].w}, bw[4] = {u1v[i].x, u1v[i].y, u1v[i].z, u1v[i].w};
#pragma unroll
            for (int j = 0; j < 4; ++j) { X[pidx(n0 + 2 * j)] = (f32x2){bflo(aw[j]), bflo(bw[j])}; X[pidx(n0 + 2 * j + 1)] = (f32x2){bfhi(aw[j]), bfhi(bw[j])}; } }
    }
    __syncthreads();
    fft_conv_a(X, tid, kreg);
#pragma unroll
    for (int i = 0; i < 4; ++i) { const int n0 = 8 * tid + 4096 * i; fv[i] = *(const v4u*)(kf + n0); bv[i] = *(const v4u*)(kb + n0); }
    fft_conv_b(X, tid);
#pragma unroll
    for (int i = 0; i < 4; ++i) { const int n0 = 8 * tid + 4096 * i; unsigned pw[8];
#pragma unroll
        for (int j = 0; j < 8; ++j) { const f32x2 v0 = X[pidx(n0 + j)] * sc; pw[j] = pk2(v0.x, v0.y); }
        *(v4u*)(PART + n0) = (v4u){pw[0], pw[1], pw[2], pw[3]}; *(v4u*)(PART + n0 + 4) = (v4u){pw[4], pw[5], pw[6], pw[7]}; }
    __syncthreads();
    {
#pragma unroll
        for (int i = 0; i < 4; ++i) { const int n0 = 8 * tid + 4096 * i; const unsigned fw[4] = {fv[i].x, fv[i].y, fv[i].z, fv[i].w}, bw[4] = {bv[i].x, bv[i].y, bv[i].z, bv[i].w};
#pragma unroll
            for (int j = 0; j < 8; ++j) { const float d = (j & 1) ? (bfhi(fw[j >> 1]) - bfhi(bw[j >> 1])) : (bflo(fw[j >> 1]) - bflo(bw[j >> 1]));
                float s, cs; sincos_rev(-(float)(n0 + j) / (float)(2 * SEQL), s, cs); X[pidx(n0 + j)] = (f32x2){d * cs, d * s}; } }
    }
    __syncthreads();
    { int t2 = tid; asm volatile("" : "+v"(t2));
#pragma unroll
    for (int i = 0; i < 4; ++i) { const int n0 = 8 * t2 + 4096 * i; u0v[i] = *(const v4u*)(U0 + n0); u1v[i] = *(const v4u*)(U1 + n0); } }
    fft_fwd(X, tid);
#pragma unroll
    for (int i = 0; i < 32; ++i) { const f32x2 v = X[34 * tid + i + (i >> 4)]; kreg[i] = (f32x2){v.x * inv + skip, v.y * inv}; }
    __syncthreads();
    {
#pragma unroll
        for (int i = 0; i < 4; ++i) { const int n0 = 8 * tid + 4096 * i; const unsigned aw[4] = {u0v[i].x, u0v[i].y, u0v[i].z, u0v[i].w}, bw[4] = {u1v[i].x, u1v[i].y, u1v[i].z, u1v[i].w};
#pragma unroll
            for (int j = 0; j < 8; ++j) { const f32x2 z = (j & 1) ? (f32x2){bfhi(aw[j >> 1]), bfhi(bw[j >> 1])} : (f32x2){bflo(aw[j >> 1]), bflo(bw[j >> 1])};
                float s, cs; sincos_rev(-(float)(n0 + j) / (float)(2 * SEQL), s, cs); X[pidx(n0 + j)] = cmul(z, (f32x2){cs, s}); } }
    }
    __syncthreads();
    fft_conv_a(X, tid, kreg); fft_conv_b(X, tid);
#pragma unroll 1
    for (int ih = 0; ih < 2; ++ih) {
        v4u pv[2][2];
#pragma unroll
        for (int i = 0; i < 2; ++i)
#pragma unroll
            for (int j = 0; j < 2; ++j) pv[i][j] = *(const v4u*)(PART + 8 * tid + 4096 * (2 * ih + i) + 4 * j);
#pragma unroll
        for (int i = 0; i < 2; ++i) { const int n0 = 8 * tid + 4096 * (2 * ih + i); unsigned o0[4], o1[4];
#pragma unroll
            for (int j = 0; j < 4; ++j) { float s, cs; f32x2 y[2];
#pragma unroll
                for (int q = 0; q < 2; ++q) { const int n = n0 + 2 * j + q; sincos_rev((float)n / (float)(2 * SEQL), s, cs);
                    const unsigned pwd = pv[i][j >> 1][2 * (j & 1) + q]; const f32x2 pe = {bflo(pwd), bfhi(pwd)};
                    y[q] = pe + cmul(X[pidx(n)], (f32x2){cs, s}) * sc; }
                o0[j] = pk2(y[0].x, y[1].x); o1[j] = pk2(y[0].y, y[1].y); }
            *(v4u*)(Y0 + n0) = (v4u){o0[0], o0[1], o0[2], o0[3]}; *(v4u*)(Y1 + n0) = (v4u){o1[0], o1[1], o1[2], o1[3]}; }
    }
    __syncthreads();
}

DI void fnet_job(const Ctx& a, int job, LAS unsigned char* lds) {
    int tid_ = tid_of(a.wv);
    const int tid = tid_;
    LAS f32x2* X = (LAS f32x2*)lds;
    const unsigned* F = (const unsigned*)(a.ws + WS_F1T) + (size_t)job * F1P;
    {   v4u fv[8];
#pragma unroll
        for (int i = 0; i < 8; ++i) fv[i] = *(const v4u*)(F + 4 * tid + 2048 * i);
#pragma unroll
        for (int i = 0; i < 8; ++i) { const int n0 = 4 * tid + 2048 * i; const unsigned w[4] = {fv[i].x, fv[i].y, fv[i].z, fv[i].w};
#pragma unroll
            for (int j = 0; j < 4; ++j) X[pidx(n0 + j)] = (f32x2){bflo(w[j]), bfhi(w[j])}; }
    }
    __syncthreads();
    fft_fwd(X, tid);
    bf16* Y = (bf16*)(a.ws + WS_YF) + (size_t)job * UTP;
    const int pb = tid + (tid >> 4);
    float re[32];
#pragma unroll
    for (int i = 0; i < 32; ++i) re[i] = X[pb + 544 * i].x * (1.0f / 1024.0f);
    __syncthreads();
    LAS float* Yl = (LAS float*)lds;
#pragma unroll
    for (int i = 0; i < 32; ++i) { const int k = (int)(__brev((unsigned)(tid + 512 * i)) >> 18); Yl[k + (k >> 9)] = re[i]; }
    __syncthreads();
#pragma unroll
    for (int i = 0; i < 16; ++i) { const int k = 2 * tid + 1024 * i; const int ad = k + (k >> 9);
        *(unsigned*)(Y + k) = pk2(Yl[ad], Yl[ad + 1]); }
    __syncthreads();
}

DI void ctx_hyena_job(const Ctx& a, int b, int cg, LAS unsigned char* lds) {
    int tid_ = tid_of(a.wv);
    const int tid = tid_, c = tid & 15, tq = tid >> 4, ch = cg * 16 + c;
    LAS float* U = (LAS float*)lds; LAS float* TF = U + 256 * 16; LAS float* TB = TF + 256 * 16;
    const bf16* P = (const bf16*)(a.ws + WS_BIG) + (size_t)(T_LAT + b * CTXL) * N1;
    const float* SW = a.in[9];
    const float* kfw = (const float*)(a.ws + WS_KTC) + (size_t)ch * CTXL; const float* kbw = (const float*)(a.ws + WS_KTC) + (size_t)(HYW + ch) * CTXL;
    float w[3][3];
#pragma unroll
    for (int k = 0; k < 3; ++k)
#pragma unroll
        for (int s = 0; s < 3; ++s) w[k][s] = SW[k * 2304 + s * HYW + ch];
    float x0r[8], l1p = 0.f;
#pragma unroll
    for (int i = 0; i < 8; ++i) { const int t = tq + 32 * i; float cv[3];
#pragma unroll
        for (int s = 0; s < 3; ++s) { const float pm = (t > 0) ? bf2f(P[(size_t)(t - 1) * N1 + s * HYW + ch]) : 0.f, p0 = bf2f(P[(size_t)t * N1 + s * HYW + ch]),
            pp = (t < CTXL - 1) ? bf2f(P[(size_t)(t + 1) * N1 + s * HYW + ch]) : 0.f; cv[s] = w[0][s] * pm + w[1][s] * p0 + w[2][s] * pp; }
        U[t * 16 + c] = cv[2] * cv[1]; x0r[i] = cv[0];
        const float kf = kfw[t], kb = (t >= 1) ? kbw[t] : 0.f; TF[t * 16 + c] = kf; TB[t * 16 + c] = kb; l1p += fabsf(kf) + fabsf(kb); }
    LAS float* red = (LAS float*)(lds + LDS_RED);
    red[tid] = l1p;
    __syncthreads();
    float l1 = 0.f;
#pragma unroll 8
    for (int q = 0; q < 32; ++q) l1 += red[q * 16 + c];
    float acc[8];
#pragma unroll
    for (int i = 0; i < 8; ++i) acc[i] = 0.f;
    for (int d = 0; d < CTXL; ++d) { const float kd = TF[d * 16 + c], km = TB[d * 16 + c];
#pragma unroll
        for (int i = 0; i < 8; ++i) { const int t = tq + 32 * i; const int s0 = t - d, s1 = t + d;
            if (s0 >= 0) acc[i] += kd * U[s0 * 16 + c];
            if (s1 < CTXL) acc[i] += km * U[s1 * 16 + c]; } }
    const float inv = 1.0f / l1, skip = a.in[16][ch];
    bf16* A2 = (bf16*)(a.ws + WS_A2);
#pragma unroll
    for (int i = 0; i < 8; ++i) { const int t = tq + 32 * i; const float y = acc[i] * inv + skip * U[t * 16 + c];
        A2[(size_t)(T_LAT + b * CTXL + t) * DM + ch] = (bf16)f2bf(x0r[i] * y); }
    __syncthreads();
}
DI void ctx_fnet_job(const Ctx& a, int b, int g, LAS unsigned char* lds) {
    int tid_ = tid_of(a.wv);
    const int tid = tid_, j = tid & 63, kq = tid >> 6;
    LAS float* RE = (LAS float*)lds; LAS float* IM = RE + 256 * 64; LAS float* cosT = (LAS float*)(lds + LDS_RED);
    const bf16* P = (const bf16*)(a.ws + WS_BIG) + (size_t)(T_LAT + b * CTXL) * N1 + 2304 + g * 128;
    for (int i = 0; i < 32; ++i) { const int t = kq + 8 * i; RE[t * 64 + j] = bf2f(P[(size_t)t * N1 + j]); IM[t * 64 + j] = bf2f(P[(size_t)t * N1 + 64 + j]); }
    if (tid < 256) cosT[tid] = cospif((float)tid / 128.0f);
    __syncthreads();
    float acc[32];
#pragma unroll
    for (int i = 0; i < 32; ++i) acc[i] = 0.f;
    for (int t = 0; t < CTXL; ++t) { const float re = RE[t * 64 + j], im = IM[t * 64 + j];
#pragma unroll
        for (int i = 0; i < 32; ++i) { const int m = ((kq + 8 * i) * t) & 255; acc[i] += re * cosT[m] + im * cosT[(m - 64) & 255]; } }
    bf16* A2 = (bf16*)(a.ws + WS_A2);
#pragma unroll
    for (int i = 0; i < 32; ++i) A2[(size_t)(T_LAT + b * CTXL + kq + 8 * i) * DM + HYW + g * 64 + j] = (bf16)f2bf(acc[i] * (1.0f / 128.0f));
    __syncthreads();
}
DI void fft_phase(const Ctx& a, LAS unsigned char* lds, int mask = 7) {
    const int G = gridDim.x;
#pragma unroll 1
    for (int sl = 0; sl < 6; ++sl) {
        const int bx = blockIdx.x; int job = bx + G * sl;
        if (G == 256 && ((bx >> 3) & 1)) job = (sl == 0) ? 768 + bx : (sl <= 3) ? bx + 256 * (sl - 1) : (sl == 4) ? 1024 + bx : 1280 + bx;
        if (job >= 768 + 512 + 96 + 8) continue;
        if (job < 768) { if (mask & 1) hyena_job(a, job, lds); }
        else if (job < 1280) { if (mask & 2) fnet_job(a, job - 768, lds); }
        else if (!(mask & 4)) continue;
        else if (job < 1376) ctx_hyena_job(a, (job - 1280) / 48, (job - 1280) % 48, lds);
        else ctx_fnet_job(a, (job - 1376) / 4, (job - 1376) % 4, lds);
    }
}

#ifdef SELFCHECK
DI void hyena_selfcheck(const Ctx& a, LAS unsigned char* lds) {
    if (blockIdx.x != 0) return;
    const int lane = lane_id(), wave = wave_of(a.wv), tid = (wave << 6) | lane;
    LAS float* red = (LAS float*)lds;
    const int cs[4] = {0, 5, 300, 767}; const int ts[5] = {0, 1, 777, 8191, 16383};
    float sdiff = 0.f, sconv = 0.f;
    for (int ci = 0; ci < 4; ++ci) {
        const int c = cs[ci];
        const bf16* kf = (const bf16*)(a.ws + WS_KT) + (size_t)c * UTP; const bf16* kb = (const bf16*)(a.ws + WS_KT) + (size_t)(HYW + c) * UTP;
        float l1 = 0.f;
        for (int n = tid; n < SEQL; n += NTHR) l1 += fabsf(bf2f(kf[n])) + fabsf(bf2f(kb[n]));
        l1 = wave_sum(l1); __syncthreads(); if (lane == 0) red[wave] = l1; __syncthreads();
        float tot = 0.f; for (int w = 0; w < 8; ++w) tot += red[w];
        const float skip = a.in[16][c];
        for (int b = 0; b < 2; ++b) {
            const bf16* U = (const bf16*)(a.ws + WS_UT) + (size_t)(c * 2 + b) * UTP; const bf16* Y = (const bf16*)(a.ws + WS_YT) + (size_t)(c * 2 + b) * UTP;
            for (int ti = 0; ti < 5; ++ti) { const int t = ts[ti];
                float p = 0.f;
                for (int sidx = tid; sidx < SEQL; sidx += NTHR) { const int lag = t - sidx; const float kv = (lag >= 0) ? bf2f(kf[lag]) : bf2f(kb[SEQL + lag]); p += kv * bf2f(U[sidx]); }
                p = wave_sum(p); __syncthreads(); if (lane == 0) red[wave] = p; __syncthreads();
                float conv = 0.f; for (int w = 0; w < 8; ++w) conv += red[w];
                conv /= tot;
                const float yref = conv + skip * bf2f(U[t]); const float d = bf2f(Y[t]) - yref;
                sdiff += d * d; sconv += conv * conv; } } }
    if (tid == 0 && !(sdiff < 0.3f * sconv)) ((unsigned*)(a.ws + WS_CTL))[8] = 1u;
    if (tid < 64) {
        const int tcs[8] = {0, 5, 300, 767, 768, 1000, 1301, 1535}; const int tns[8] = {0, 1, 2, 33, 777, 8191, 12345, 16383};
        const int c = tcs[tid >> 3], n = tns[tid & 7];
        const float* w3 = a.in[15]; const float* H = (const float*)(a.ws + WS_H2);
        float acc = 0.f; for (int i = 0; i < 64; ++i) acc += H[(size_t)n * 64 + i] * w3[(size_t)i * 1536 + c];
        const int cc = c % HYW; const float delta = fabsf(-3.0701134573253945f + (float)cc * ((-15.350567286626973f + 3.0701134573253945f) / 767.0f));
        float ref = acc * expf(-((float)n / (float)(SEQL - 1)) * delta);
        const bool bwd = c >= HYW; if (bwd && n == 0) ref = 0.f;
        const int idx = (!bwd || n == 0) ? n : SEQL - n;
        const float got = bf2f(((const bf16*)(a.ws + WS_KT))[(size_t)c * UTP + idx]);
        if (!(fabsf(got - ref) <= 0.02f * fabsf(ref) + 2e-3f)) ((unsigned*)(a.ws + WS_CTL))[8] = 1u;
    }
}
#endif

#define MFMA32(a_, b_, c_) __builtin_amdgcn_mfma_f32_32x32x16_bf16((a_), (b_), (c_), 0, 0, 0)
template <int S>
DI bf16x8 pack_step(const f32x16& x) {
    v4u p;
    asm volatile("v_cvt_pk_bf16_f32 %0, %4, %5\n\tv_cvt_pk_bf16_f32 %1, %6, %7\n\tv_cvt_pk_bf16_f32 %2, %8, %9\n\tv_cvt_pk_bf16_f32 %3, %10, %11\n\ts_nop 1"
                 : "=&v"(p[0]), "=&v"(p[1]), "=&v"(p[2]), "=&v"(p[3])
                 : "v"(x[8 * S]), "v"(x[8 * S + 1]), "v"(x[8 * S + 2]), "v"(x[8 * S + 3]), "v"(x[8 * S + 4]), "v"(x[8 * S + 5]), "v"(x[8 * S + 6]), "v"(x[8 * S + 7]));
    return __builtin_bit_cast(bf16x8, p);
}
constexpr int AT_KPITCH = 144, AT_VOFF = 46080, AT_VPL = 648, AT_VPC = 520;
template <bool LOCAL>
DI void attn_chunk(LAS unsigned char* Ks, LAS unsigned char* Vs, int ch, const bf16x8 (&qf)[4], float& m, float& l, f32x16& o0, f32x16& o1, int r, int h, int tq, int kp_base) {
    constexpr int vpitch = LOCAL ? AT_VPL : AT_VPC;
    const int cr0 = ch * 32;
    f32x16 s;
#pragma unroll
    for (int i = 0; i < 16; ++i) s[i] = 0.f;
#pragma unroll
    for (int ks = 0; ks < 4; ++ks) { const bf16x8 kf = *(LAS bf16x8*)(Ks + (cr0 + r) * AT_KPITCH + (16 * ks + 8 * h) * 2); s = MFMA32(kf, qf[ks], s); }
    float cmax = -1e30f;
#pragma unroll
    for (int i = 0; i < 16; ++i) {
        if (LOCAL) { const int kp = kp_base + cr0 + (i & 3) + 8 * (i >> 2) + 4 * h; const int dl = kp - tq;
            const bool ok = (dl <= 128) && (dl >= -128) && (kp >= 0) && (kp < SEQL); s[i] = ok ? s[i] : -1e30f; }
        cmax = fmaxf(cmax, s[i]);
    }
    cmax = fmaxf(cmax, __shfl_xor(cmax, 32));
    const float mn = fmaxf(m, cmax), alpha = __builtin_amdgcn_exp2f(m - mn);
    m = mn;
    float ps = 0.f;
#pragma unroll
    for (int i = 0; i < 16; ++i) { s[i] = __builtin_amdgcn_exp2f(s[i] - mn); ps += s[i]; }
    l = l * alpha + ps;
#pragma unroll
    for (int i = 0; i < 16; ++i) { o0[i] *= alpha; o1[i] *= alpha; }
    const bf16x8 p0 = pack_step<0>(s), p1 = pack_step<1>(s);
#pragma unroll
    for (int mt = 0; mt < 2; ++mt) {
#pragma unroll
        for (int sp = 0; sp < 2; ++sp) {
            LAS unsigned char* vp = Vs + (32 * mt + r) * vpitch + (cr0 + 16 * sp + 4 * h) * 2;
            const s16x4 vlo = *(LAS s16x4*)vp, vhi = *(LAS s16x4*)(vp + 16);
            const bf16x8 vf = __builtin_shufflevector(vlo, vhi, 0, 1, 2, 3, 4, 5, 6, 7);
            if (mt == 0) o0 = MFMA32(vf, sp == 0 ? p0 : p1, o0); else o1 = MFMA32(vf, sp == 0 ? p0 : p1, o1);
        }
    }
}
DI void attn_load_local(const bf16* KR, const bf16* VT, int b, int kvh, int t0, int tid, v4u (&kv)[10]) {
#pragma unroll
    for (int i = 0; i < 5; ++i) { const int p = tid + NTHR * i, row = p >> 3, pc = p & 7, kp = t0 - 128 + row; kv[i] = (v4u){0u, 0u, 0u, 0u};
        if (kp >= 0 && kp < SEQL) kv[i] = *(const v4u*)(KR + ((size_t)(b * SEQL + kp)) * 128 + kvh * 64 + pc * 8); }
#pragma unroll
    for (int i = 0; i < 5; ++i) { const int p = tid + NTHR * i, d = p / 40, pc = p % 40, kp0 = t0 - 128 + pc * 8; kv[5 + i] = (v4u){0u, 0u, 0u, 0u};
        if (kp0 >= 0 && kp0 < SEQL) kv[5 + i] = *(const v4u*)(VT + ((size_t)((b * 2 + kvh) * 64 + d)) * UTP + kp0); }
}
DI void attn_store_local(LAS unsigned char* Ks, LAS unsigned char* Vs, int tid, const v4u (&kv)[10]) {
#pragma unroll
    for (int i = 0; i < 5; ++i) { const int p = tid + NTHR * i, row = p >> 3, pc = p & 7; *(LAS v4u*)(Ks + row * AT_KPITCH + pc * 16) = kv[i]; }
#pragma unroll
    for (int i = 0; i < 5; ++i) { const int p = tid + NTHR * i, d = p / 40, pc = p % 40; LAS v2u* dst = (LAS v2u*)(Vs + d * AT_VPL + pc * 16);
        dst[0] = (v2u){kv[5 + i].x, kv[5 + i].y}; dst[1] = (v2u){kv[5 + i].z, kv[5 + i].w}; }
}
DI void attn_load_ctx(const bf16* KC, const bf16* VCT, int b, int kvh, int tid, v4u (&cv)[8]) {
#pragma unroll
    for (int i = 0; i < 4; ++i) { const int p = tid + NTHR * i, row = p >> 3, pc = p & 7; cv[i] = *(const v4u*)(KC + ((size_t)(b * CTXL + row) * 2 + kvh) * 64 + pc * 8); }
#pragma unroll
    for (int i = 0; i < 4; ++i) { const int p = tid + NTHR * i, d = p >> 5, pc = p & 31; cv[4 + i] = *(const v4u*)(VCT + ((size_t)((b * 2 + kvh) * 64 + d)) * CTXL + pc * 8); }
}
DI void attn_store_ctx(LAS unsigned char* Ks, LAS unsigned char* Vs, int tid, const v4u (&cv)[8]) {
#pragma unroll
    for (int i = 0; i < 4; ++i) { const int p = tid + NTHR * i, row = p >> 3, pc = p & 7; *(LAS v4u*)(Ks + row * AT_KPITCH + pc * 16) = cv[i]; }
#pragma unroll
    for (int i = 0; i < 4; ++i) { const int p = tid + NTHR * i, d = p >> 5, pc = p & 31; LAS v2u* dst = (LAS v2u*)(Vs + d * AT_VPC + pc * 16);
        dst[0] = (v2u){cv[4 + i].x, cv[4 + i].y}; dst[1] = (v2u){cv[4 + i].z, cv[4 + i].w}; }
}
DI void attn_phase(const Ctx& a, LAS unsigned char* lds) {
    const int lane = lane_id(), wave = wave_of(a.wv), tid = (wave << 6) | lane, G = gridDim.x;
    const int r = lane & 31, h = lane >> 5;
    const bf16* QR = (const bf16*)(a.ws + WS_QR); const bf16* KR = (const bf16*)(a.ws + WS_KR); const bf16* VT = (const bf16*)(a.ws + WS_VT);
    const bf16* KC = (const bf16*)(a.ws + WS_KC); const bf16* VCT = (const bf16*)(a.ws + WS_VCT);
    bf16* A2 = (bf16*)(a.ws + WS_A2); const float* sink = a.in[28];
    LAS unsigned char* Ks = lds; LAS unsigned char* Vs = lds + AT_VOFF;
    v4u kv[10], cv[8];
    if ((int)blockIdx.x < 1024) { const int u = blockIdx.x; attn_load_local(KR, VT, u >> 9, (u >> 8) & 1, (u & 255) * 64, tid, kv); }
    for (int u = blockIdx.x; u < 1024; u += G) {
        const int qb = u & 255, kvh = (u >> 8) & 1, b = u >> 9;
        const int t0 = qb * 64, g = wave >> 1, qs = wave & 1, h8 = kvh * 4 + g, tq = t0 + qs * 32 + r;
        bf16x8 qf[4];
#pragma unroll
        for (int s = 0; s < 4; ++s) qf[s] = *(const bf16x8*)(QR + ((size_t)(b * SEQL + tq)) * 512 + h8 * 64 + 16 * s + 8 * h);
        float m = sink[h8] * 1.4426950408889634f, l = (h == 0) ? 1.0f : 0.0f;
        f32x16 o0, o1;
#pragma unroll
        for (int i = 0; i < 16; ++i) { o0[i] = 0.f; o1[i] = 0.f; }
        __syncthreads();
        attn_store_local(Ks, Vs, tid, kv);
        attn_load_ctx(KC, VCT, b, kvh, tid, cv);
        __syncthreads();
#pragma unroll 1
        for (int ch = 0; ch < 10; ++ch) attn_chunk<true>(Ks, Vs, ch, qf, m, l, o0, o1, r, h, tq, t0 - 128);
        __syncthreads();
        attn_store_ctx(Ks, Vs, tid, cv);
        { const int un = u + G; if (un < 1024) attn_load_local(KR, VT, un >> 9, (un >> 8) & 1, (un & 255) * 64, tid, kv); }
        __syncthreads();
#pragma unroll 1
        for (int ch = 0; ch < 8; ++ch) attn_chunk<false>(Ks, Vs, ch, qf, m, l, o0, o1, r, h, tq, 0);
        const float inv = 1.0f / (l + __shfl_xor(l, 32));
        bf16* op = A2 + ((size_t)(b * SEQL + tq)) * DM + h8 * 64 + 4 * h;
#pragma unroll
        for (int g4 = 0; g4 < 4; ++g4) {
            v2u w0; w0.x = pk2(o0[4 * g4] * inv, o0[4 * g4 + 1] * inv); w0.y = pk2(o0[4 * g4 + 2] * inv, o0[4 * g4 + 3] * inv);
            v2u w1; w1.x = pk2(o1[4 * g4] * inv, o1[4 * g4 + 1] * inv); w1.y = pk2(o1[4 * g4 + 2] * inv, o1[4 * g4 + 3] * inv);
            *(v2u*)(op + 8 * g4) = w0; *(v2u*)(op + 32 + 8 * g4) = w1;
        }
    }
    __syncthreads();
}

#ifndef SPLIT_G2
#define SPLIT_G2 1
#endif
#ifndef SPLIT_G4
#define SPLIT_G4 1
#endif
__global__ void __launch_bounds__(NTHR, 2) fwd_kernel(Args ka) {
    extern __shared__ __attribute__((aligned(16))) unsigned char lds_raw[];
    LAS unsigned char* lds = (LAS unsigned char*)lds_raw;
    const int wave = __builtin_amdgcn_readfirstlane((int)threadIdx.x >> 6), G = gridDim.x, gw = blockIdx.x * NWAVES + wave, NGW = G * NWAVES;
    const Ctx a{ka.in, ka.out, ka.ws, wave};
    { const int tid = tid_of(wave); if (tid < 4) ((LAS unsigned*)(lds + LDS_MISC))[tid] = 0u; }
    __syncthreads();
#if N_LAUNCH_MODE == 1
    XcdBarrier bar = xcd_barrier_post((unsigned*)(a.ws + WS_CTL) + CW_BAR, (volatile LAS unsigned*)(lds + LDS_MISC), wave);
#define GRID_BAR() xcd_barrier(bar)
#else
#define GRID_BAR() do { } while (0)
#endif
    const int lo = ka.ph_lo, hi = ka.ph_hi;
#ifdef ONLY_PHASE
#define IN(k) (((k) == ONLY_PHASE || (ONLY_PHASE >= 18 && (k) >= 18 && (((k) - ONLY_PHASE) % 2 == 0))) && lo <= (k) && (k) < hi)
#else
#define IN(k) (lo <= (k) && (k) < hi)
#endif
#define SEAM(k) do { if (IN(k) && IN((k) + 1)) GRID_BAR(); } while (0)
#ifndef DUP_MASK
#define DUP_MASK 0
#endif
#ifndef DUP_G345
#define DUP_G345 0
#endif
#define REPS(k) ((((DUP_MASK) >> (k)) & 1) + 1)
#define PH_BEGIN(k) if (IN(k)) { _Pragma("unroll 1") for (int rep_ = 0; rep_ < REPS(k); ++rep_) { if (rep_) GRID_BAR();
#define PH_END(k) } } SEAM(k);
    const int bid = (int)blockIdx.x;

    PH_BEGIN(0) phase0(a, lds); PH_END(0)
    PH_BEGIN(1) {
        for (int it = bid; it < 256; it += G) taps_mfma_item(a, it, lds);
        for (int it = 256 + (G - 1 - bid); it < 260; it += G) taps_mfma_item(a, it, lds);
        norm_rows(a.in[0], a.in[2], a.in[6], ((const float*)(a.ws + WS_ADA)), 0, 1024, ((bf16*)(a.ws + WS_H)), T_ALL, gw, NGW, lane_id());
    } PH_END(1)
    if (IN(2)) {
        pg8::Gemm g{((bf16*)(a.ws + WS_H)), (const bf16*)(a.ws + WS_W_EIN), T_ALL, N1, DM}; pg8::StaticOrder S; S.init(T_ALL, N1, G, bid);
        pg8::EpiStoreBf16 E{((bf16*)(a.ws + WS_BIG)), N1};
        pg8::gemm_phase<pg8::EpiStoreBf16, pg8::StaticOrder, true, true>(lds, g, S, E, wave);
        if (REPS(2) > 1) { GRID_BAR(); pg8::gemm_phase<pg8::EpiStoreBf16, pg8::StaticOrder, true, true>(lds, g, S, E, wave); }
    }
    SEAM(2);
#pragma unroll 1
    for (int grep_ = 0; grep_ < 1 + DUP_G345; ++grep_) {
    if (grep_) GRID_BAR();
    PH_BEGIN(3) prep0_phase(a, lds); PH_END(3)
#ifdef SELFCHECK
    if (IN(4)) { fft_phase(a, lds); GRID_BAR(); hyena_selfcheck(a, lds); } SEAM(4);
#else
#ifdef PROBE_FFT_MASK
    if (IN(4)) { fft_phase(a, lds); GRID_BAR(); fft_phase(a, lds, PROBE_FFT_MASK); } SEAM(4);
#else
    PH_BEGIN(4) fft_phase(a, lds); PH_END(4)
#endif
#endif
    PH_BEGIN(5) untr0_phase(a, lds); } }
    if (grep_ + 1 < 1 + DUP_G345) continue;
    SEAM(5);
    }
    if (IN(6)) {
        pg8::Gemm g{((bf16*)(a.ws + WS_A2)), (const bf16*)(a.ws + WS_W_EOUT), T_ALL, DM, DM}; pg8::StaticOrder S; S.init(T_LAT, DM, G, bid);
        pg8::EpiResid E{a.in[0], a.in[2], a.out, ((float*)(a.ws + WS_XC)), ((const float*)(a.ws + WS_ADA)) + 2048};
        pg8::gemm_phase<pg8::EpiResid, pg8::StaticOrder, true, true>(lds, g, S, E, wave);
        int bid2 = bid, ksl = 256; asm volatile("" : "+s"(bid2), "+s"(ksl) :: "memory");
        pg8::Gemm gc{((bf16*)(a.ws + WS_A2)), (const bf16*)(a.ws + WS_W_EOUT), T_ALL, DM, ksl, DM}; pg8::OrderCtxSplit Sc{4, 4, G, bid2};
        pg8::EpiPartial Ec{(float*)(a.ws + WS_PARTC)};
        if (SPLIT_G2) pg8::gemm_phase<pg8::EpiPartial, pg8::OrderCtxSplit, true, true, true>(lds, gc, Sc, Ec, wave);
        if (bid >= 32) conv_moe_S(a, lds, 0, 4608, bid - 32, 224);
    }
    SEAM(6);
    PH_BEGIN(7) {
        norm_ctx_partial<4, true>(a.in[2], a.in[7], (const float*)(a.ws + WS_ADA), 3072, 4096, (bf16*)(a.ws + WS_H), (const float*)(a.ws + WS_PARTC), (const float*)(a.ws + WS_ADA) + 2 * 6144 + 2048, (float*)(a.ws + WS_XC), NGW - 1 - gw, NGW, lane_id());
        norm_rows<true>(a.out, a.in[2], a.in[7], ((const float*)(a.ws + WS_ADA)), 3072, 4096, ((bf16*)(a.ws + WS_H)), T_LAT, gw, NGW, lane_id());
    } PH_END(7)
    if (IN(8)) {
        pg8::Gemm g{((bf16*)(a.ws + WS_H)), (const bf16*)(a.ws + WS_W_FGU), T_ALL, 2 * DFF, DM}; pg8::StaticOrder S; S.init(T_ALL, 2 * DFF, G, bid);
        pg8::EpiSwigluF8 E{a.ws + WS_BIG, DFF, 0x7fffffff, 22};
        pg8::gemm_phase<pg8::EpiSwigluF8, pg8::StaticOrder, true, true, false, true>(lds, g, S, E, wave);
        if (bid >= 44) conv_moe_S(a, lds, 4608, 17408, bid - 44, 212);
    }
    SEAM(8);
    if (IN(9)) {
        pg8::Gemm g{((bf16*)(a.ws + WS_BIG)), (const bf16*)(a.ws + WS_W_FD), T_ALL, DM, DFF}; pg8::StaticOrder S; S.init(T_LAT, DM, G, bid);
        pg8::EpiResidT<2048> E{a.out, ((float*)(a.ws + WS_XC)), a.out, ((float*)(a.ws + WS_XC)), ((const float*)(a.ws + WS_ADA)) + 5120};
        pg8::gemm_phase<pg8::EpiResidT<2048>, pg8::StaticOrder, true, true, false, true>(lds, g, S, E, wave);
        int bid2 = bid, ksl = 256; asm volatile("" : "+s"(bid2), "+s"(ksl) :: "memory");
        pg8::Gemm gc{((bf16*)(a.ws + WS_BIG)), (const bf16*)(a.ws + WS_W_FD), T_ALL, DM, ksl, DFF}; pg8::OrderCtxSplitT<256> Sc{4, 11, G, bid2};
        pg8::EpiPartialT<8, 2048> Ec{(float*)(a.ws + WS_PARTC)};
        if (SPLIT_G4) pg8::gemm_phase<pg8::EpiPartialT<8, 2048>, pg8::OrderCtxSplitT<256>, true, true, true, true>(lds, gc, Sc, Ec, wave);
        if (bid >= 88) conv_moe_S(a, lds, 17408, 20864, bid - 88, 168);
    }
    SEAM(9);
    if (IN(10)) {
        norm_ctx_partial<11>((const float*)(a.ws + WS_XC), a.in[23], (const float*)(a.ws + WS_ADA) + 3 * 6144, 0, 1024, (bf16*)(a.ws + WS_H), (const float*)(a.ws + WS_PARTC), (const float*)(a.ws + WS_ADA) + 2 * 6144 + 5120, nullptr, NGW - 1 - gw, NGW, lane_id());
        norm_rows(a.out, ((float*)(a.ws + WS_XC)), a.in[23], ((const float*)(a.ws + WS_ADA) + 3 * 6144), 0, 1024, ((bf16*)(a.ws + WS_H)), T_LAT, gw, NGW, lane_id());
    }
    SEAM(10);
    if (IN(11)) {
        pg8::Gemm g{((bf16*)(a.ws + WS_H)), (const bf16*)(a.ws + WS_W_OIN), T_ALL, N2, DM}; pg8::OrderL1In S; S.init(G, bid);
        pg8::EpiStoreBf16 E{((bf16*)(a.ws + WS_BIG)), N2};
        pg8::gemm_phase<pg8::EpiStoreBf16, pg8::OrderL1In, true, true>(lds, g, S, E, wave);
        if (bid >= 130) conv_moe_S(a, lds, 20864, 28672, bid - 130, 126);
    }
    SEAM(11);
    PH_BEGIN(12) prep1_phase(a, lds); PH_END(12)
    PH_BEGIN(13) attn_phase(a, lds); PH_END(13)
    if (IN(14)) {
        pg8::Gemm g{((bf16*)(a.ws + WS_A2)), (const bf16*)(a.ws + WS_W_OOUT), T_LAT, DM, DM}; pg8::StaticOrder S; S.init(T_LAT, DM, G, bid);
        pg8::EpiResid E{a.out, ((float*)(a.ws + WS_XC)), a.out, ((float*)(a.ws + WS_XC)), ((const float*)(a.ws + WS_ADA) + 3 * 6144) + 2048};
        pg8::gemm_phase<pg8::EpiResid, pg8::StaticOrder, true, true>(lds, g, S, E, wave);
    }
    SEAM(14);
    PH_BEGIN(15) { norm_router_phase(a, lds); conv_moe_weights(a, lds); } PH_END(15)
    PH_BEGIN(16) slot_phase(a, lds); PH_END(16)
#pragma unroll 1
    for (int st = 0; st < 2 * NCHUNK; ++st) {
        const int kk = 18 + st;
        if (!IN(kk)) continue;
        const int* panel_e = (const int*)(a.ws + WS_PANELE);
        if (st >= __builtin_amdgcn_readfirstlane(panel_e[PE_NSTEP])) break;
        const int sdn = __builtin_amdgcn_readfirstlane(panel_e[PE_SD + st]), sgu = __builtin_amdgcn_readfirstlane(panel_e[PE_SG + st]), sfl = __builtin_amdgcn_readfirstlane(panel_e[PE_SX + st]), snd = __builtin_amdgcn_readfirstlane(panel_e[PE_SND + st]);
        if (sdn >= 0) {
            pg8::Gemm g{(const bf16*)(a.ws + ((sfl & 1) ? WS_ACTX : ((sfl & 4) ? WS_ACTM2 : WS_ACTM))), (const bf16*)(a.ws + WS_WMD), 0, 0, DFE};
            pg8::OrderMoe S{panel_e, panel_e + PE_LIST + sdn * CHUNKP, __builtin_amdgcn_readfirstlane(panel_e[PE_CNP + sdn]), 4, G, bid, 1, 0};
            pg8::EpiMoeDown E{a.out, ((const float*)(a.ws + WS_ADA) + 3 * 6144) + 5120, (const int*)(a.ws + WS_SLOTTOK), (const float*)(a.ws + WS_SLOTW), panel_e + PE_RES + sdn * CHUNKP};
            pg8::gemm_phase<pg8::EpiMoeDown, pg8::OrderMoe, true, true, false, true>(lds, g, S, E, wave);
        }
        if (sgu >= 0) {
            pg8::Gemm g{((bf16*)(a.ws + WS_BIG)), (const bf16*)(a.ws + WS_WMGU), 0, 0, DM};
            pg8::OrderMoe S{panel_e, panel_e + PE_LIST + sgu * CHUNKP, __builtin_amdgcn_readfirstlane(panel_e[PE_CNP + sgu]), 28, G, bid, 0, snd};
            pg8::EpiSwigluF8 E{a.ws + ((sfl & 2) ? WS_ACTX : ((sfl & 8) ? WS_ACTM2 : WS_ACTM)), DFE, CHUNKP - 1, 28};
            pg8::gemm_phase<pg8::EpiSwigluF8, pg8::OrderMoe, true, true, false, true>(lds, g, S, E, wave);
        }
        SEAM(kk);
    }
#ifdef SELFCHECK
    GRID_BAR();
    if (__hip_atomic_load((unsigned*)(a.ws + WS_CTL) + 8, __ATOMIC_RELAXED, __HIP_MEMORY_SCOPE_AGENT) != 0u) { for (int i = gw * 64 + lane_id(); i < T_LAT * DM; i += NGW * 64) a.out[i] = __builtin_nanf(""); }
#endif
#undef IN
#undef SEAM
}

extern "C" void kernel_launch(void* const* d_in, const int* in_sizes, int n_in, void* d_out, int out_size, void* d_ws, size_t ws_size, hipStream_t stream) {
    static int grid = 0;
    if (grid == 0) {
        int dev = 0, cus = 0;
        if (n_in != 36 || out_size != T_LAT * DM || ws_size < WS_END) { fprintf(stderr, "kernel_launch: unexpected problem shape (n_in %d, out %d, ws %zu < %zu)\n", n_in, out_size, ws_size, (size_t)WS_END); grid = -1; return; }
        if (hipGetDevice(&dev) != hipSuccess || hipDeviceGetAttribute(&cus, hipDeviceAttributeMultiprocessorCount, dev) != hipSuccess) { grid = -1; return; }
        if (hipFuncSetAttribute((const void*)fwd_kernel, hipFuncAttributeMaxDynamicSharedMemorySize, LDS_BYTES) != hipSuccess) { grid = -1; return; }
        (void)hipGetLastError();
        if (cus < 256) { fprintf(stderr, "kernel_launch: needs 256 CUs, device has %d\n", cus); grid = -1; return; }
        grid = 256;
    }
    if (grid < 0) return;
    (void)hipMemsetAsync((char*)d_ws + WS_CTL, 0, 65536, stream);
    Args a{};
    for (int i = 0; i < 36; ++i) a.in[i] = (const float*)d_in[i];
    a.out = (float*)d_out; a.ws = (unsigned char*)d_ws;
#if LAST_PHASE <= 6
    (void)hipMemcpyAsync(d_out, d_in[0], (size_t)T_LAT * DM * 4, hipMemcpyDeviceToDevice, stream);
#endif
#if N_LAUNCH_MODE == 1
    a.ph_lo = 0; a.ph_hi = LAST_PHASE;
    hipLaunchKernelGGL(fwd_kernel, dim3(grid), dim3(NTHR), LDS_BYTES, stream, a);
#else
    for (int ph = 0; ph < LAST_PHASE; ++ph) { a.ph_lo = ph; a.ph_hi = ph + 1; hipLaunchKernelGGL(fwd_kernel, dim3(grid), dim3(NTHR), LDS_BYTES, stream, a); }
#endif
}
```

```cpp
#include <hip/hip_runtime.h>
#include <cstdio>
#include <cstdint>
#ifndef N_LAUNCH_MODE
#define N_LAUNCH_MODE 1
#endif
#ifndef LAST_PHASE
#define LAST_PHASE 30
#endif
namespace pg8 {
#define PG8_LAS __attribute__((address_space(3)))
typedef unsigned short bf16_t;
typedef short bf16x8 __attribute__((ext_vector_type(8)));
typedef float f32x4 __attribute__((ext_vector_type(4)));
typedef unsigned u32x4 __attribute__((ext_vector_type(4)));
typedef int i32x4 __attribute__((ext_vector_type(4)));
typedef int i32x8 __attribute__((ext_vector_type(8)));
__device__ __forceinline__ i32x8 cat8(bf16x8 a, bf16x8 b) { const i32x4 x = __builtin_bit_cast(i32x4, a), y = __builtin_bit_cast(i32x4, b); return __builtin_shufflevector(x, y, 0, 1, 2, 3, 4, 5, 6, 7); }
constexpr int BM = 256, BK = 64, HALF = 128, HTB = HALF * BK * 2  , STAGE_BYTES = 8 * HTB, NXCD = 8, WGM = 8;

__host__ __device__ __forceinline__ int lds_byte(int r, int c) { const int st = (r >> 4) * 2 + (c >> 5), rr = r & 15, cc = c & 31, ob = rr * 64 + cc * 2; return st * 1024 + (ob ^ (((ob >> 9) & 1) << 5)); }
__host__ __device__ __forceinline__ void stage_rc(int b, int& R, int& C) { const int st = b / 1024, sb = b % 1024, swz = sb ^ (((sb >> 9) & 1) << 5); R = (st >> 1) * 16 + swz / 64; C = (st & 1) * 32 + (swz % 64) / 2; }
__host__ __device__ __forceinline__ int perm32(int rho) { const int n = rho >> 4, i = rho & 15; return 8 * (i >> 2) + 4 * n + (i & 3); }

struct Unit { int pm, pn, ko; };
struct Gemm { const bf16_t* A; const bf16_t* Bt; int M, N, K, ld; };
__device__ __forceinline__ unsigned cvt_pk_bf16(float lo, float hi) { unsigned r; asm volatile("v_cvt_pk_bf16_f32 %0, %1, %2" : "=v"(r) : "v"(lo), "v"(hi)); return r; }
template <class Epi, class Sched, bool ALIGN_EPI = false, bool SP2 = false, bool KSPLIT = false, bool FP8 = false>
__device__ __forceinline__ void gemm_phase(PG8_LAS unsigned char* lds, const Gemm g, const Sched& S, const Epi& E, int wid) {
    asm volatile("" : "+s"(wid));
    int lane; asm volatile("v_mbcnt_lo_u32_b32 %0, -1, 0\n\tv_mbcnt_hi_u32_b32 %0, -1, %0" : "=v"(lane)); lane &= 63;
    const int tid = (wid << 6) | lane, wr = wid >> 2, wc = wid & 3, fr = lane & 15, fq = lane >> 4;
    const int K = FP8 ? (g.K >> 1) : g.K, LD = KSPLIT ? (FP8 ? (g.ld >> 1) : g.ld) : K, nt = K / BK;
    unsigned voffA[2], voffB[2];
#pragma unroll
    for (int i = 0; i < 2; ++i) { int R, C; stage_rc(tid * 16 + i * 8192, R, C); const int Rb = Epi::PERM ? ((R & ~31) + perm32(R & 31)) : R;
        voffA[i] = (unsigned)(R * LD + C) * 2u; voffB[i] = (unsigned)(Rb * LD + C) * 2u; }
    const size_t kstep = (size_t)(BK * 2);
    const size_t hstep = (size_t)HALF * LD * 2;
    const size_t tstep = 2 * hstep;
    const unsigned ldsw = (unsigned)wid * 1024u;
    const int aoff = lds_byte(wr * 64 + fr, fq * 8), boff = lds_byte(wc * 32 + fr, fq * 8);
#define PG8_SA(b, h) (((b) * 2 + (h)) * HTB)
#define PG8_SB(b, h) ((4 + (b) * 2 + (h)) * HTB)
#define PG8_STAGE(bufoff, gbase, voff) do { const char* _g = (const char*)(gbase); asm volatile("" : "+s"(_g)); _Pragma("unroll") for (int _i = 0; _i < 2; ++_i) { unsigned _v = (voff)[_i]; asm volatile("" : "+v"(_v));   \
        __builtin_amdgcn_global_load_lds((const unsigned*)(_g + _v), (PG8_LAS unsigned*)(lds + (bufoff) + ldsw + _i * 8192), 16, 0, 0); } } while (0)
#define PG8_LDA(dst, b, h) do { _Pragma("unroll") for (int m = 0; m < 4; ++m) _Pragma("unroll") for (int k = 0; k < 2; ++k) dst[m][k] = *(const PG8_LAS bf16x8*)(lds + PG8_SA(b, h) + aoff + m * 2048 + k * 1024); } while (0)
#define PG8_LDB(dst, b, h) do { _Pragma("unroll") for (int n = 0; n < 2; ++n) _Pragma("unroll") for (int k = 0; k < 2; ++k) dst[n][k] = *(const PG8_LAS bf16x8*)(lds + PG8_SB(b, h) + boff + n * 2048 + k * 1024); } while (0)
#define PG8_MMA(ai, bj, At, Bt) do { __builtin_amdgcn_s_setprio(1); _Pragma("unroll") for (int m = 0; m < 4; ++m) _Pragma("unroll") for (int n = 0; n < 2; ++n) { \
        if constexpr (FP8) acc[ai][bj][m][n] = __builtin_amdgcn_mfma_scale_f32_16x16x128_f8f6f4(cat8(Bt[n][0], Bt[n][1]), cat8(At[m][0], At[m][1]), acc[ai][bj][m][n], 0, 0, 0, 0, 0, 0); \
        else { _Pragma("unroll") for (int k = 0; k < 2; ++k) acc[ai][bj][m][n] = __builtin_amdgcn_mfma_f32_16x16x32_bf16(Bt[n][k], At[m][k], acc[ai][bj][m][n], 0, 0, 0); } } __builtin_amdgcn_s_setprio(0); } while (0)
#define PG8_WAIT_V(n) asm volatile("s_waitcnt vmcnt(" #n ")" ::: "memory")
#define PG8_WAIT_L(n) asm volatile("s_waitcnt lgkmcnt(" #n ")" ::: "memory")
#define PG8_BAR __builtin_amdgcn_s_barrier()
#define PG8_SCHED __builtin_amdgcn_sched_barrier(0)
    Unit cur, nxt; int ui = 0;
    if (!S.next(0, cur)) return;
    f32x4 acc[2][2][4][2];
#pragma unroll
    for (int a = 0; a < 2; ++a)
#pragma unroll
        for (int b = 0; b < 2; ++b)
#pragma unroll
            for (int m = 0; m < 4; ++m)
#pragma unroll
                for (int n = 0; n < 2; ++n) acc[a][b][m][n] = (f32x4){0.f, 0.f, 0.f, 0.f};
    bf16x8 At[4][2], B0[2][2], B1[2][2];
    const char* cA = (const char*)g.A + (size_t)cur.pm * tstep + (KSPLIT ? cur.ko : 0); const char* cB = (const char*)g.Bt + (size_t)cur.pn * tstep + (KSPLIT ? cur.ko : 0);
    S.a_ready(cur);
    if constexpr (SP2) {
        PG8_STAGE(PG8_SB(0, 0), cB, voffB); PG8_STAGE(PG8_SB(0, 1), cB + hstep, voffB); PG8_STAGE(PG8_SA(0, 0), cA, voffA); PG8_STAGE(PG8_SA(0, 1), cA + hstep, voffA);
        if (wr == 1) PG8_BAR;
        PG8_WAIT_V(2); PG8_BAR;
        PG8_STAGE(PG8_SB(1, 0), cB + kstep, voffB); PG8_STAGE(PG8_SA(1, 0), cA + kstep, voffA); PG8_STAGE(PG8_SB(1, 1), cB + hstep + kstep, voffB);
        PG8_WAIT_V(6); PG8_BAR;
    } else {
        PG8_STAGE(PG8_SB(0, 0), cB, voffB); PG8_STAGE(PG8_SA(0, 0), cA, voffA); PG8_STAGE(PG8_SB(0, 1), cB + hstep, voffB); PG8_STAGE(PG8_SA(0, 1), cA + hstep, voffA);
        if (wr == 1) PG8_BAR;
        PG8_WAIT_V(4); PG8_BAR;
        PG8_STAGE(PG8_SB(1, 0), cB + kstep, voffB); PG8_STAGE(PG8_SA(1, 0), cA + kstep, voffA); PG8_STAGE(PG8_SB(1, 1), cB + hstep + kstep, voffB);
        PG8_WAIT_V(6); PG8_BAR;
    }
    for (;;) {
        const bool has_next = S.next(ui + 1, nxt);
        const char* nA = has_next ? (const char*)g.A + (size_t)nxt.pm * tstep + (KSPLIT ? nxt.ko : 0) : cA; const char* nB = has_next ? (const char*)g.Bt + (size_t)nxt.pn * tstep + (KSPLIT ? nxt.ko : 0) : cB;
        for (int t = 0; t < nt; t += 2) {
            const bool last = (t == nt - 2);
            const char* a1 = cA + (size_t)(t + 1) * kstep;
            const char* a2 = last ? nA : cA + (size_t)(t + 2) * kstep; const char* b2 = last ? nB : cB + (size_t)(t + 2) * kstep;
            const char* a3 = a2 + kstep; const char* b3 = b2 + kstep;
            if (last && has_next) S.a_ready(nxt);
            if constexpr (SP2) {
            PG8_LDB(B0, 0, 0); PG8_LDB(B1, 0, 1); PG8_SCHED; PG8_LDA(At, 0, 0); PG8_STAGE(PG8_SA(1, 1), a1 + hstep, voffA);
            PG8_WAIT_V(8); PG8_WAIT_L(0); PG8_BAR; PG8_MMA(0, 0, At, B0); PG8_MMA(0, 1, At, B1); PG8_BAR; PG8_SCHED;
            PG8_LDA(At, 0, 1); PG8_STAGE(PG8_SB(0, 0), b2, voffB); PG8_STAGE(PG8_SB(0, 1), b2 + hstep, voffB); PG8_STAGE(PG8_SA(0, 0), a2, voffA);
            PG8_WAIT_V(8); PG8_WAIT_L(0); PG8_BAR; PG8_MMA(1, 0, At, B0); PG8_MMA(1, 1, At, B1); PG8_BAR; PG8_SCHED;
            PG8_LDB(B0, 1, 0); PG8_LDB(B1, 1, 1); PG8_SCHED; PG8_LDA(At, 1, 0); PG8_STAGE(PG8_SA(0, 1), a2 + hstep, voffA);
            PG8_WAIT_V(8); PG8_WAIT_L(0); PG8_BAR; PG8_MMA(0, 0, At, B0); PG8_MMA(0, 1, At, B1); PG8_BAR; PG8_SCHED;
            PG8_LDA(At, 1, 1); PG8_STAGE(PG8_SB(1, 0), b3, voffB); PG8_STAGE(PG8_SB(1, 1), b3 + hstep, voffB); PG8_STAGE(PG8_SA(1, 0), a3, voffA);
            PG8_WAIT_V(8); PG8_WAIT_L(0); PG8_BAR; PG8_MMA(1, 0, At, B0); PG8_MMA(1, 1, At, B1); PG8_BAR; PG8_SCHED;
            } else {
            PG8_LDB(B0, 0, 0); PG8_SCHED; PG8_LDA(At, 0, 0); PG8_STAGE(PG8_SA(1, 1), a1 + hstep, voffA);
            PG8_WAIT_L(8); PG8_BAR; PG8_WAIT_L(0); PG8_MMA(0, 0, At, B0); PG8_BAR; PG8_SCHED;
            PG8_LDB(B1, 0, 1); PG8_STAGE(PG8_SB(0, 0), b2, voffB);
            PG8_BAR; PG8_WAIT_L(0); PG8_MMA(0, 1, At, B1); PG8_BAR;
            PG8_LDA(At, 0, 1); PG8_STAGE(PG8_SA(0, 0), a2, voffA);
            PG8_BAR; PG8_WAIT_L(0); PG8_MMA(1, 0, At, B0); PG8_BAR; PG8_SCHED;
            PG8_STAGE(PG8_SB(0, 1), b2 + hstep, voffB);
            PG8_WAIT_V(6); PG8_BAR; PG8_MMA(1, 1, At, B1); PG8_BAR;
            PG8_LDB(B0, 1, 0); PG8_SCHED; PG8_LDA(At, 1, 0); PG8_STAGE(PG8_SA(0, 1), a2 + hstep, voffA);
            PG8_WAIT_L(8); PG8_BAR; PG8_WAIT_L(0); PG8_MMA(0, 0, At, B0); PG8_BAR; PG8_SCHED;
            PG8_LDB(B1, 1, 1); PG8_STAGE(PG8_SB(1, 0), b3, voffB);
            PG8_BAR; PG8_WAIT_L(0); PG8_MMA(0, 1, At, B1); PG8_BAR;
            PG8_LDA(At, 1, 1); PG8_STAGE(PG8_SA(1, 0), a3, voffA);
            PG8_BAR; PG8_WAIT_L(0); PG8_MMA(1, 0, At, B0); PG8_BAR; PG8_SCHED;
            PG8_STAGE(PG8_SB(1, 1), b3 + hstep, voffB);
            PG8_WAIT_V(6); PG8_BAR; PG8_MMA(1, 1, At, B1); PG8_BAR;
            }
        }
        if constexpr (ALIGN_EPI) { if (wr == 0) PG8_BAR; }
        if constexpr (!Epi::AFTER_DRAIN) { E(acc, cur, wr, wc, fr, fq); S.done(cur); }
        if (!has_next) break;
#pragma unroll
        for (int a = 0; a < 2; ++a)
#pragma unroll
            for (int b = 0; b < 2; ++b)
#pragma unroll
                for (int m = 0; m < 4; ++m)
#pragma unroll
                    for (int n = 0; n < 2; ++n) acc[a][b][m][n] = (f32x4){0.f, 0.f, 0.f, 0.f};
        cur = nxt; cA = nA; cB = nB; ++ui;
        if constexpr (ALIGN_EPI) { if (wr == 1) PG8_BAR; }
    }
    PG8_WAIT_V(0);
    if constexpr (!ALIGN_EPI) { if (wr == 0) PG8_BAR; }
    PG8_BAR;
    if constexpr (Epi::AFTER_DRAIN) { E.fused(acc, cur, wr, wc, fr, fq, lds, wid, lane); S.done(cur); }
#undef PG8_SA
#undef PG8_SB
#undef PG8_STAGE
#undef PG8_LDA
#undef PG8_LDB
#undef PG8_MMA
#undef PG8_WAIT_V
#undef PG8_WAIT_L
#undef PG8_BAR
#undef PG8_SCHED
}
}

constexpr int DM = 1024, SEQL = 16384, CTXL = 256, T_LAT = 32768, T_CTX = 512, T_ALL = 33280;
constexpr int N1 = 2816;
constexpr int DFF = 2816, N2 = 2304, DFE = 3584, NEXP = 8;
constexpr int HYW = 768;
constexpr int UTP = SEQL + 64;
constexpr int F1P = SEQL + 32;
constexpr int NWAVES = 8, NTHR = 512;
constexpr int MAXPANELS = 272;
constexpr int CHUNKP = 128;
constexpr int NCHUNK = 6;
constexpr int PE_NSTEP = 403, PE_SD = 2600, PE_SG = 2632, PE_SX = 2664, PE_SND = 2696;
constexpr int XPANELS = 16;
constexpr int PE_CNP = 416, PE_LIST = 512, PE_RES = 1536;

constexpr size_t MiB = 1u << 20;
constexpr size_t WS_CTL = 0, CTL_ZERO_BYTES = 1 * MiB;
constexpr size_t WS_ADA = 1 * MiB;
constexpr size_t WS_XC = 2 * MiB;
constexpr size_t WS_TOKE = 4 * MiB;
constexpr size_t WS_TOKG = 4 * MiB + 256 * 1024;
constexpr size_t WS_BLKCNT = 4 * MiB + 512 * 1024;
constexpr size_t WS_PANELE = 4 * MiB + 528 * 1024;
constexpr size_t WS_SLOTTOK = 5 * MiB;
constexpr size_t WS_SLOTW = 5 * MiB + 512 * 1024;
constexpr size_t WS_KC = 6 * MiB;
constexpr size_t WS_VCT = 6 * MiB + 256 * 1024;
constexpr size_t WS_H2C = 7 * MiB;
constexpr size_t WS_KTC = 8 * MiB;
constexpr size_t WS_H2 = 11 * MiB;
constexpr size_t WS_W_EIN = 16 * MiB, WS_W_EOUT = 22 * MiB, WS_W_FGU = 24 * MiB, WS_W_FD = 35 * MiB, WS_W_OIN = 41 * MiB, WS_W_OOUT = 46 * MiB;
constexpr size_t WS_H = 48 * MiB;
constexpr size_t WS_A2 = 113 * MiB;
constexpr size_t ACTM_HALF = (size_t)CHUNKP * 256 * DFE;
constexpr size_t WS_ACTM2 = 246 * MiB;
constexpr size_t WS_ACTM = 48 * MiB;
constexpr size_t WS_ACTX = 16 * MiB;
constexpr size_t WS_BIG = 178 * MiB;
constexpr size_t WS_X0C = 48 * MiB;
constexpr size_t WS_YT = 178 * MiB;
constexpr size_t WS_YF = 178 * MiB + 64 * MiB;
constexpr size_t WS_T = 358 * MiB;
constexpr size_t WS_UT = WS_T;
constexpr size_t WS_PART = WS_T + 49 * MiB;
constexpr size_t WS_F1T = WS_T + 81 * MiB;
constexpr size_t WS_KT = WS_T + 114 * MiB;
constexpr size_t WS_PARTC = WS_T;
constexpr size_t WS_QR = WS_T;
constexpr size_t WS_KR = WS_T + 32 * MiB;
constexpr size_t WS_VT = WS_T + 40 * MiB;
constexpr size_t WS_WMGU = WS_T + 56 * MiB;
constexpr size_t WS_WMD = WS_T + 112 * MiB;
constexpr size_t WS_END = 526 * MiB;
static_assert(WS_KT + (size_t)1536 * UTP * 2 <= WS_END && WS_UT + (size_t)1536 * UTP * 2 <= WS_PART && WS_F1T + (size_t)512 * F1P * 4 <= WS_KT && WS_VT + (size_t)256 * UTP * 2 <= WS_T + 49 * MiB && WS_WMD + (size_t)8 * 1024 * 3584 * 2 <= WS_END, "ws map");
static_assert(WS_BIG + (size_t)T_ALL * N1 * 2 <= WS_T && WS_A2 + (size_t)T_ALL * DM * 2 <= WS_BIG && WS_ACTM + ACTM_HALF <= WS_BIG && WS_BIG + (size_t)69632 * 1024 <= WS_ACTM2 && WS_ACTM2 + ACTM_HALF <= WS_T, "ws map");
constexpr int CW_BAR = 4096;

constexpr int LDS_BYTES = 147456;
constexpr int LDS_WORK = 139264;
constexpr int LDS_RED = 139264;
constexpr int LDS_MISC = 146432;
constexpr int WAVE_SCR = 17408;

#define LAS __attribute__((address_space(3)))
typedef unsigned short bf16;
typedef unsigned v4u __attribute__((ext_vector_type(4)));
typedef unsigned v2u __attribute__((ext_vector_type(2)));
typedef float f32x4 __attribute__((ext_vector_type(4)));
typedef float f32x2 __attribute__((ext_vector_type(2)));
typedef float f32x16 __attribute__((ext_vector_type(16)));
typedef short bf16x8 __attribute__((ext_vector_type(8)));
typedef short s16x4 __attribute__((ext_vector_type(4)));

struct Args { const float* in[36]; float* out; unsigned char* ws; int ph_lo, ph_hi; };
struct Ctx { const float* const (&in)[36]; float* const& out; unsigned char* const& ws; const int wv; };
__device__ __forceinline__ int lane_id() { int l; asm volatile("v_mbcnt_lo_u32_b32 %0, -1, 0\n\tv_mbcnt_hi_u32_b32 %0, -1, %0" : "=v"(l)); return l & 63; }
__device__ __forceinline__ int wave_of(int wv) { asm volatile("" : "+s"(wv)); return wv; }
__device__ __forceinline__ int tid_of(int wv) { return (wave_of(wv) << 6) | lane_id(); }

__device__ __forceinline__ unsigned f2bf(float f) { unsigned u = __float_as_uint(f); return (u + 0x7fffu + ((u >> 16) & 1u)) >> 16; }
__device__ __forceinline__ unsigned pk2(float lo, float hi) { return f2bf(lo) | (f2bf(hi) << 16); }
__device__ __forceinline__ float bf2f(unsigned h) { return __uint_as_float(h << 16); }
__device__ __forceinline__ float bflo(unsigned w) { return __uint_as_float(w << 16); }
__device__ __forceinline__ float bfhi(unsigned w) { return __uint_as_float(w & 0xffff0000u); }
__device__ __forceinline__ float wave_sum(float v) {
#pragma unroll
    for (int o = 1; o < 64; o <<= 1) v += __shfl_xor(v, o);
    return v;
}
__device__ __forceinline__ float siluf(float x) { return x / (1.0f + __expf(-x)); }

#define XB_TMO      128
#define XB_XCNT(j)  (256  + 64 * (j))
#define XB_XSUB(j)  (1280 + 64 * (j))
#define XB_XGEN(j)  (2304 + 64 * (j))
#define XB_TOP      3328
#define XB_TOPGEN   3392
#define XCD_BAR_WORDS 3456
#define XB_SPIN_CAP (1u << 20)

__device__ __forceinline__ unsigned xb_ld(unsigned* p)              { return __hip_atomic_load(p, __ATOMIC_RELAXED, __HIP_MEMORY_SCOPE_AGENT); }
__device__ __forceinline__ unsigned xb_add(unsigned* p, unsigned v) { return __hip_atomic_fetch_add(p, v, __ATOMIC_RELAXED, __HIP_MEMORY_SCOPE_AGENT); }
__device__ __forceinline__ unsigned xb_xcc_id() { return (unsigned)__builtin_amdgcn_s_getreg((3 << 11) | 20) & 0xFu; }
#define XB_SPIN(cond, bar) do { unsigned _sp = 0; while (cond) { __builtin_amdgcn_s_sleep(1); \
    if ((++_sp & 255u) == 0u) { if (xb_ld(&(bar)[XB_TMO])) break; if (_sp > XB_SPIN_CAP) { atomicAdd(&(bar)[XB_TMO], 1u); break; } } } } while (0)

struct XcdBarrier {
    unsigned* bar; unsigned x; int wv;
    volatile LAS unsigned* st;
};
__device__ __forceinline__ XcdBarrier xcd_barrier_post(unsigned* bar, volatile LAS unsigned* st, int wv) {
    XcdBarrier b; b.bar = bar; b.x = xb_xcc_id(); b.st = st; b.wv = wv;
    if (tid_of(wv) == 0) (void)xb_add(&bar[XB_XCNT(b.x)], 1u);
    return b;
}
__device__ __forceinline__ void xcd_barrier_complete(unsigned* bar, unsigned x, unsigned& nloc, unsigned& nx) {
    const unsigned G = gridDim.x * gridDim.y * gridDim.z;
    unsigned sum, cnt, mine, sp = 0u;
    for (;;) {
        sum = 0u; cnt = 0u; mine = 0u;
#pragma unroll
        for (unsigned j = 0; j < 16; ++j) { const unsigned c = xb_ld(&bar[XB_XCNT(j)]); sum += c; cnt += (c > 0u) ? 1u : 0u; mine = (j == x) ? c : mine; }
        if (sum == G) break;
        __builtin_amdgcn_s_sleep(1);
        if ((++sp & 255u) == 0u) { if (xb_ld(&bar[XB_TMO])) break; if (sp > XB_SPIN_CAP) { atomicAdd(&bar[XB_TMO], 1u); break; } }
    }
    nloc = mine > 0u ? mine : 1u; nx = cnt > 0u ? cnt : 1u;
}
__device__ __forceinline__ void xcd_barrier(const XcdBarrier& b) {
    asm volatile("s_waitcnt vmcnt(0)" ::: "memory");
    __syncthreads();
    if (tid_of(b.wv) == 0) {
        unsigned* bar = b.bar;
        __builtin_amdgcn_s_waitcnt(0);
        unsigned nloc = b.st[0], nx = b.st[1];
        if (nloc == 0u) { xcd_barrier_complete(bar, b.x, nloc, nx); b.st[0] = nloc; b.st[1] = nx; }
        const unsigned old = xb_add(&bar[XB_XSUB(b.x)], 1u);
        const unsigned gen = old / nloc;
        if (old + 1u == (gen + 1u) * nloc) {
            __builtin_amdgcn_fence(__ATOMIC_RELEASE, "agent");
            asm volatile("s_waitcnt vmcnt(0)" ::: "memory");
            const unsigned og = xb_add(&bar[XB_TOP], 1u);
            const unsigned tg = og / nx;
            if (og + 1u == (tg + 1u) * nx) xb_add(&bar[XB_TOPGEN], 1u);
            else XB_SPIN(xb_ld(&bar[XB_TOPGEN]) == tg, bar);
            __builtin_amdgcn_fence(__ATOMIC_ACQUIRE, "agent");
            xb_add(&bar[XB_XGEN(b.x)], 1u);
            asm volatile("s_waitcnt vmcnt(0)" ::: "memory");
        } else {
            XB_SPIN(xb_ld(&bar[XB_XGEN(b.x)]) == gen, bar);
            __builtin_amdgcn_fence(__ATOMIC_ACQUIRE, "agent");
            asm volatile("s_waitcnt vmcnt(0)" ::: "memory");
        }
    }
    __syncthreads();
}

namespace pg8 {
struct StaticOrder {
    int nM, nN, nwg, G, c;
    __device__ __forceinline__ void init(int M, int N, int G_, int c_) { nM = M / BM; nN = N / BM; nwg = nM * nN; G = G_; c = c_; }
    __device__ __forceinline__ bool next(int i, Unit& u) const {
        const long L = (long)i * G + c; if (L >= nwg) return false;
        int wgid = (int)L; { const int q = nwg / NXCD, r = nwg % NXCD, xcd = wgid % NXCD, off = wgid / NXCD; wgid = (xcd < r ? xcd * (q + 1) : r * (q + 1) + (xcd - r) * q) + off; }
        const int nig = WGM * nN, gid = wgid / nig, fm = gid * WGM, gsz = (nM - fm) < WGM ? (nM - fm) : WGM;
        u.pm = fm + ((wgid % nig) % gsz); u.pn = (wgid % nig) / gsz; u.ko = 0; return true;
    }
    __device__ __forceinline__ void a_ready(const Unit&) const {}
    __device__ __forceinline__ void done(const Unit&) const {}
};
struct OrderL1In {
    StaticOrder S; int G, c;
    __device__ __forceinline__ void init(int G_, int c_) { S.init(32768, 2304, G_, c_); G = G_; c = c_; }
    __device__ __forceinline__ bool next(int i, Unit& u) const {
        const long L = (long)i * G + c;
        if (L < S.nwg) return S.next(i, u);
        const int r = (int)(L - S.nwg); if (r >= 2) return false;
        u.pm = 128 + r; u.pn = 2; u.ko = 0; return true;
    }
    __device__ __forceinline__ void a_ready(const Unit&) const {}
    __device__ __forceinline__ void done(const Unit&) const {}
};
struct OrderMoe {
    const int* panel_e; const int* list; int np, ncol, G, c, down, nd;
    __device__ __forceinline__ bool next(int i, Unit& u) const {
        int pl, j;
        if (np == 128 && G == 256) {
            int ii = i, cc = c;
            if (nd > 0) {
                const int sk = (5 * nd <= 256) ? 4 : 3;
                if (c < nd) { ii = i + sk; if (ii >= ncol / 2) return false; }
                else if (i >= ncol / 2) { const int e = c - nd; if (i > ncol / 2 || e >= sk * nd) return false; ii = e / nd; cc = e % nd; }
            } else if ((long)i * G + c >= (long)np * ncol) return false;
            const int x = cc & 7, k = cc >> 3, ntg = ncol >> 2, hf = ii / ntg, tg = ii - hf * ntg; pl = 16 * x + 8 * hf + (k & 7); j = 4 * tg + (k >> 3);
        } else { const long L = (long)i * G + c; if (L >= (long)np * ncol) return false; pl = (int)(L % np); j = (int)(L / np); }
        const int pabs = __builtin_amdgcn_readfirstlane(list[pl]);
        u.pm = down ? (pabs & 127) : pabs; u.pn = __builtin_amdgcn_readfirstlane(panel_e[pabs]) * ncol + j; u.ko = 0; return true;
    }
    __device__ __forceinline__ void a_ready(const Unit&) const {}
    __device__ __forceinline__ void done(const Unit&) const {}
};

template <int KOB = 512>
struct OrderCtxSplitT {
    int ntile, nks, G, c;
    __device__ __forceinline__ bool next(int i, Unit& u) const {
        const int e = i * G + c; if (e >= 2 * ntile * nks) return false;
        u.pm = 128 + (e & 1); u.pn = (e >> 1) % ntile; u.ko = ((e >> 1) / ntile) * KOB; return true;
    }
    __device__ __forceinline__ void a_ready(const Unit&) const {}
    __device__ __forceinline__ void done(const Unit&) const {}
};
typedef OrderCtxSplitT<512> OrderCtxSplit;

struct EpiStoreBf16 {
    static constexpr bool PERM = true, AFTER_DRAIN = false;
    bf16_t* O; int ldc;
    __device__ __forceinline__ void operator()(const f32x4 (&acc)[2][2][4][2], const Unit& u, int wr, int wc, int fr, int fq) const {
        const int row0 = u.pm * BM + wr * 64 + fr, col0 = u.pn * BM + wc * 32 + 8 * fq;
#pragma unroll
        for (int ai = 0; ai < 2; ++ai)
#pragma unroll
            for (int m = 0; m < 4; ++m) { bf16_t* rowp = O + (size_t)(row0 + ai * HALF + m * 16) * ldc + col0;
#pragma unroll
                for (int bj = 0; bj < 2; ++bj) { const f32x4 v0 = acc[ai][bj][m][0], v1 = acc[ai][bj][m][1];
                    u32x4 w; w.x = cvt_pk_bf16(v0[0], v0[1]); w.y = cvt_pk_bf16(v0[2], v0[3]); w.z = cvt_pk_bf16(v1[0], v1[1]); w.w = cvt_pk_bf16(v1[2], v1[3]);
                    *(u32x4*)(rowp + bj * HALF) = w; } }
    }
};
__device__ __forceinline__ float silu_fast(float x) { return x * __builtin_amdgcn_rcpf(1.0f + __expf(-x)); }
typedef float f32x2 __attribute__((ext_vector_type(2)));
__device__ __forceinline__ f32x2 swiglu2(f32x2 g, f32x2 u, float gs, float us) {
    const f32x2 t = g * (-1.4426950408889634f * gs);
    f32x2 d; d.x = __builtin_amdgcn_exp2f(t.x); d.y = __builtin_amdgcn_exp2f(t.y);
    d = d + 1.0f;
    f32x2 rc; rc.x = __builtin_amdgcn_rcpf(d.x); rc.y = __builtin_amdgcn_rcpf(d.y);
    return (g * rc) * (u * (gs * us));
}
struct EpiSwiglu {
    static constexpr bool PERM = true, AFTER_DRAIN = false;
    bf16_t* O; int ldc; int pm_mask; int ncol;
    __device__ __forceinline__ void operator()(const f32x4 (&acc)[2][2][4][2], const Unit& u, int wr, int wc, int fr, int fq) const {
        const int row0 = (u.pm & pm_mask) * BM + wr * 64 + fr, col0 = (u.pn % ncol) * HALF + wc * 32 + 8 * fq;
#pragma unroll
        for (int ai = 0; ai < 2; ++ai)
#pragma unroll
            for (int m = 0; m < 4; ++m) { bf16_t* rowp = O + (size_t)(row0 + ai * HALF + m * 16) * ldc + col0;
                const f32x4 g0 = acc[ai][0][m][0], g1 = acc[ai][0][m][1], u0 = acc[ai][1][m][0], u1 = acc[ai][1][m][1];
                float r[8];
#pragma unroll
                for (int j = 0; j < 2; ++j) { const f32x2 a0 = swiglu2((f32x2){g0[2 * j], g0[2 * j + 1]}, (f32x2){u0[2 * j], u0[2 * j + 1]}, 1.0f, 1.0f), a1 = swiglu2((f32x2){g1[2 * j], g1[2 * j + 1]}, (f32x2){u1[2 * j], u1[2 * j + 1]}, 1.0f, 1.0f);
                    r[2 * j] = a0.x; r[2 * j + 1] = a0.y; r[4 + 2 * j] = a1.x; r[5 + 2 * j] = a1.y; }
                u32x4 w; w.x = cvt_pk_bf16(r[0], r[1]); w.y = cvt_pk_bf16(r[2], r[3]); w.z = cvt_pk_bf16(r[4], r[5]); w.w = cvt_pk_bf16(r[6], r[7]);
                *(u32x4*)rowp = w; }
    }
};
constexpr float F8_SX = 16.f, F8_SW = 256.f, F8_SA = 8.f;
__device__ __forceinline__ unsigned pk4_fp8(float a, float b, float c, float d) {
    a = __builtin_amdgcn_fmed3f(a, -448.f, 448.f); b = __builtin_amdgcn_fmed3f(b, -448.f, 448.f); c = __builtin_amdgcn_fmed3f(c, -448.f, 448.f); d = __builtin_amdgcn_fmed3f(d, -448.f, 448.f);
    int w = __builtin_amdgcn_cvt_pk_fp8_f32(a, b, 0, false); w = __builtin_amdgcn_cvt_pk_fp8_f32(c, d, w, true); return (unsigned)w; }
template <int INSC = 4096>
struct EpiSwigluF8T {
    static constexpr bool PERM = true, AFTER_DRAIN = false;
    unsigned char* O; int ldc; int pm_mask; int ncol;
    __device__ __forceinline__ void operator()(const f32x4 (&acc)[2][2][4][2], const Unit& u, int wr, int wc, int fr, int fq) const {
        const int row0 = (u.pm & pm_mask) * BM + wr * 64 + fr, col0 = (u.pn % ncol) * HALF + wc * 32 + 8 * fq;
        constexpr float gi = 1.0f / (float)INSC, ui = F8_SA / (float)INSC;
#pragma unroll
        for (int ai = 0; ai < 2; ++ai)
#pragma unroll
            for (int m = 0; m < 4; ++m) { unsigned char* rowp = O + (size_t)(row0 + ai * HALF + m * 16) * ldc + col0;
                const f32x4 g0 = acc[ai][0][m][0], g1 = acc[ai][0][m][1], u0 = acc[ai][1][m][0], u1 = acc[ai][1][m][1];
                float r[8];
#pragma unroll
                for (int j = 0; j < 2; ++j) { const f32x2 a0 = swiglu2((f32x2){g0[2 * j], g0[2 * j + 1]}, (f32x2){u0[2 * j], u0[2 * j + 1]}, gi, ui), a1 = swiglu2((f32x2){g1[2 * j], g1[2 * j + 1]}, (f32x2){u1[2 * j], u1[2 * j + 1]}, gi, ui);
                    r[2 * j] = a0.x; r[2 * j + 1] = a0.y; r[4 + 2 * j] = a1.x; r[5 + 2 * j] = a1.y; }
                typedef unsigned u32x2 __attribute__((ext_vector_type(2)));
                u32x2 w; w.x = pk4_fp8(r[0], r[1], r[2], r[3]); w.y = pk4_fp8(r[4], r[5], r[6], r[7]);
                *(u32x2*)rowp = w; }
    }
};
typedef EpiSwigluF8T<4096> EpiSwigluF8;
template <int SDIV = 1>
struct EpiResidT {
    static constexpr bool PERM = false, AFTER_DRAIN = false;
    const float* src_lat; const float* src_ctx; float* dst_lat; float* dst_ctx; const float* gate;
    __device__ __forceinline__ void operator()(const f32x4 (&acc)[2][2][4][2], const Unit& u, int wr, int wc, int fr, int fq) const {
        const bool isctx = u.pm >= 128; const int cond = isctx ? 2 : (u.pm >> 6);
        const int row0 = (isctx ? u.pm - 128 : u.pm) * BM + wr * 64 + fr, col0 = u.pn * BM + wc * 32 + 4 * fq;
        const float* sp = isctx ? src_ctx : src_lat; float* dp = isctx ? dst_ctx : dst_lat;
        f32x4 gv[2][2];
#pragma unroll
        for (int bj = 0; bj < 2; ++bj)
#pragma unroll
            for (int n = 0; n < 2; ++n) gv[bj][n] = *(const f32x4*)(gate + cond * 6144 + col0 + bj * HALF + n * 16) * (1.0f / (float)SDIV);
#pragma unroll
        for (int ai = 0; ai < 2; ++ai)
#pragma unroll
            for (int m = 0; m < 4; ++m) { const size_t off = (size_t)(row0 + ai * HALF + m * 16) * 1024 + col0;
#pragma unroll
                for (int bj = 0; bj < 2; ++bj)
#pragma unroll
                    for (int n = 0; n < 2; ++n) { const f32x4 s = *(const f32x4*)(sp + off + bj * HALF + n * 16); *(f32x4*)(dp + off + bj * HALF + n * 16) = s + gv[bj][n] * acc[ai][bj][m][n]; } }
    }
};
typedef EpiResidT<1> EpiResid;
template <int KOSH = 9, int SDIV = 1>
struct EpiPartialT {
    static constexpr bool PERM = false, AFTER_DRAIN = false;
    float* P;
    __device__ __forceinline__ void operator()(const f32x4 (&acc)[2][2][4][2], const Unit& u, int wr, int wc, int fr, int fq) const {
        const int row0 = (u.pm - 128) * BM + wr * 64 + fr, col0 = u.pn * BM + wc * 32 + 4 * fq;
        float* base = P + (size_t)(u.ko >> KOSH) * 512 * 1024;
#pragma unroll
        for (int ai = 0; ai < 2; ++ai)
#pragma unroll
            for (int m = 0; m < 4; ++m) { float* rp = base + (size_t)(row0 + ai * HALF + m * 16) * 1024 + col0;
#pragma unroll
                for (int bj = 0; bj < 2; ++bj)
#pragma unroll
                    for (int n = 0; n < 2; ++n) *(f32x4*)(rp + bj * HALF + n * 16) = acc[ai][bj][m][n] * (1.0f / (float)SDIV); }
    }
};
typedef EpiPartialT<9, 1> EpiPartial;
struct EpiMoeDown {
    static constexpr bool PERM = false, AFTER_DRAIN = false;
    float* out; const float* gate; const int* slot_tok; const float* slot_w; const int* res2abs;
    __device__ __forceinline__ void operator()(const f32x4 (&acc)[2][2][4][2], const Unit& u, int wr, int wc, int fr, int fq) const {
        const int slot0 = __builtin_amdgcn_readfirstlane(res2abs[u.pm]) * BM + wr * 64 + fr, col0 = (u.pn & 3) * BM + wc * 32 + 4 * fq;
#pragma unroll
        for (int ai = 0; ai < 2; ++ai)
#pragma unroll
            for (int m = 0; m < 4; ++m) { const int s = slot0 + ai * HALF + m * 16; const int tok = slot_tok[s];
                if (tok >= 0) { const float w = slot_w[s] * (1.0f / (F8_SA * F8_SW)); const float* gp = gate + (tok >> 14) * 6144 + col0; float* op = out + (size_t)tok * 1024 + col0;
#pragma unroll
                    for (int bj = 0; bj < 2; ++bj)
#pragma unroll
                        for (int n = 0; n < 2; ++n) { const f32x4 g = *(const f32x4*)(gp + bj * HALF + n * 16); const f32x4 o = *(const f32x4*)(op + bj * HALF + n * 16);
                            *(f32x4*)(op + bj * HALF + n * 16) = o + (g * w) * acc[ai][bj][m][n]; } } }
    }
};
}

#define DI __device__ __forceinline__
#define GW_DECL const int lane = lane_id(), wave = wave_of(a.wv), tid = (wave << 6) | lane, G = gridDim.x, gw = blockIdx.x * NWAVES + wave, NGW = G * NWAVES; (void)gw; (void)NGW; (void)lane; (void)wave; (void)G

DI void ada_item(const Ctx& a, int item, LAS float* red) {
    GW_DECL;
    const int lyr = item / 128, cc = item % 128;
    const float* W = a.in[lyr ? 21 : 4]; const float* B = a.in[lyr ? 22 : 5];
    float* ADA = (float*)(a.ws + WS_ADA);
    LAS float* sil = red + 2048;
    for (int i = tid; i < 3072; i += NTHR) { const int j = i >> 10, k = i & 1023; const float cv = (j == 0) ? a.in[1][k] : (j == 1) ? a.in[1][1024 + k] : a.in[3][k]; sil[i] = siluf(cv); }
    __syncthreads();
    const int col = cc * 48 + (lane < 48 ? lane : 47);
    float acc0 = 0.f, acc1 = 0.f, acc2 = 0.f;
    const int k0 = wave * 128;
#pragma unroll 16
    for (int k = k0; k < k0 + 128; ++k) {
        const float wv = W[(size_t)k * 6144 + col];
        acc0 += sil[k] * wv; acc1 += sil[1024 + k] * wv; acc2 += sil[2048 + k] * wv;
    }
    red[(wave * 3 + 0) * 64 + lane] = acc0; red[(wave * 3 + 1) * 64 + lane] = acc1; red[(wave * 3 + 2) * 64 + lane] = acc2;
    __syncthreads();
    if (tid < 192) { const int j = tid >> 6, l = tid & 63;
        if (l < 48) { float s = B[cc * 48 + l];
#pragma unroll
            for (int w = 0; w < 8; ++w) s += red[(w * 3 + j) * 64 + l];
            ADA[(lyr * 3 + j) * 6144 + cc * 48 + l] = s; } }
    __syncthreads();
}

DI void filt_hidden_item(const Ctx& a, int item, LAS float* sm) {
    GW_DECL;
    LAS float* w1s = sm;
    LAS float* b1s = sm + 2112;
    LAS float* frs = sm + 2176;
    LAS float* w2s = sm + 2240;
    LAS float* b2s = sm + 6336;
    const float* w1 = a.in[10]; const float* b1 = a.in[11]; const float* fr = a.in[12]; const float* w2 = a.in[13]; const float* b2 = a.in[14];
    for (int i = tid; i < 2112; i += NTHR) w1s[i] = w1[i];
    for (int i = tid; i < 4096; i += NTHR) w2s[i] = w2[i];
    if (tid < 64) { b1s[tid] = b1[tid]; frs[tid] = fr[tid]; b2s[tid] = b2[tid]; }
    __syncthreads();
    const bool isctx = item >= 32;
    const int Ln = isctx ? CTXL : SEQL;
    const int n = isctx ? tid : item * 512 + tid;
    float* H = isctx ? (float*)(a.ws + WS_H2C) : (float*)(a.ws + WS_H2);
    if (n < Ln) {
        float z[33];
        z[0] = (float)n / (float)(Ln - 1);
#pragma unroll
        for (int q = 0; q < 16; ++q) { const float fq = 1e-4f + (float)q * ((15.0f - 1e-4f) / 15.0f); const float x = (float)n * fq / (float)Ln;
            z[1 + q] = __builtin_amdgcn_cosf(x); z[17 + q] = -__builtin_amdgcn_sinf(x); }
        f32x4 acc2[16];
#pragma unroll
        for (int o4 = 0; o4 < 16; ++o4) acc2[o4] = *(LAS f32x4*)(b2s + o4 * 4);
#pragma unroll 2
        for (int i = 0; i < 64; ++i) {
            float acc = b1s[i];
#pragma unroll
            for (int q = 0; q < 33; ++q) acc += z[q] * w1s[q * 64 + i];
            const float h1 = __builtin_amdgcn_sinf(frs[i] * acc * 0.15915494309189535f);
#pragma unroll
            for (int o4 = 0; o4 < 16; ++o4) acc2[o4] += h1 * *(LAS f32x4*)(w2s + i * 64 + o4 * 4);
        }
#pragma unroll
        for (int o4 = 0; o4 < 16; ++o4) { const f32x4 f = *(LAS f32x4*)(frs + o4 * 4); f32x4 v;
#pragma unroll
            for (int j = 0; j < 4; ++j) v[j] = __builtin_amdgcn_sinf(f[j] * acc2[o4][j] * 0.15915494309189535f);
            *(f32x4*)(H + (size_t)n * 64 + o4 * 4) = v; }
    }
    __syncthreads();
}

DI void transpose_item(const float* W, int K, int N, bf16* WT, int dst_row0, LAS float* scr, int kb, int n0, int lane) {
    const int k0 = 64 * kb;
    float wv[32];
#pragma unroll
    for (int i = 0; i < 32; ++i) { const int kk = 2 * i + (lane >> 5); wv[i] = W[(size_t)(k0 + kk) * N + n0 + (lane & 31)]; }
#pragma unroll
    for (int i = 0; i < 32; ++i) { const int kk = 2 * i + (lane >> 5); scr[kk * 33 + (lane & 31)] = wv[i]; }
    asm volatile("s_waitcnt lgkmcnt(0)" ::: "memory");
    const int c = lane & 7;
#pragma unroll
    for (int j = 0; j < 4; ++j) { const int n = (lane >> 3) + 8 * j; const LAS float* s = scr + (8 * c) * 33 + n;
        v4u o; o.x = pk2(s[0 * 33], s[1 * 33]); o.y = pk2(s[2 * 33], s[3 * 33]); o.z = pk2(s[4 * 33], s[5 * 33]); o.w = pk2(s[6 * 33], s[7 * 33]);
        *(v4u*)(WT + (size_t)(dst_row0 + n) * K + k0 + 8 * c) = o; }
    asm volatile("s_waitcnt lgkmcnt(0)" ::: "memory");
}
DI void transpose_item_f8(const float* W, int K, int N, unsigned char* WT, int dst_row0, LAS float* scr, int kb, int n0, int lane) {
    const int k0 = 64 * kb;
    float wv[32];
#pragma unroll
    for (int i = 0; i < 32; ++i) { const int kk = 2 * i + (lane >> 5); wv[i] = __builtin_nontemporal_load(W + (size_t)(k0 + kk) * N + n0 + (lane & 31)); }
#pragma unroll
    for (int i = 0; i < 32; ++i) { const int kk = 2 * i + (lane >> 5); scr[kk * 33 + (lane & 31)] = wv[i] * pg8::F8_SW; }
    asm volatile("s_waitcnt lgkmcnt(0)" ::: "memory");
    const int c = lane & 7;
#pragma unroll
    for (int j = 0; j < 4; ++j) { const int n = (lane >> 3) + 8 * j; const LAS float* s = scr + (8 * c) * 33 + n;
        v2u o; o.x = pg8::pk4_fp8(s[0 * 33], s[1 * 33], s[2 * 33], s[3 * 33]); o.y = pg8::pk4_fp8(s[4 * 33], s[5 * 33], s[6 * 33], s[7 * 33]);
        *(v2u*)(WT + (size_t)(dst_row0 + n) * K + k0 + 8 * c) = o; }
    asm volatile("s_waitcnt lgkmcnt(0)" ::: "memory");
}
template <bool F8 = false>
DI void conv_matrix(const float* W, int K, int N, bf16* WT, int mode, int rowbase, LAS float* scr, int& goff, int gw, int NGW, int lane) {
    const int nblk = N / 32, items = (K / 64) * nblk;
    int first = (gw - (goff % NGW)); if (first < 0) first += NGW;
    for (int it = first; it < items; it += NGW) {
        const int kb = it / nblk, n0 = (it % nblk) * 32;
        const int drow = rowbase + (mode == 0 ? n0 : ((n0 >> 7) * 256 + (mode == 2 ? 128 : 0) + (n0 & 127)));
        if constexpr (F8) transpose_item_f8(W, K, N, (unsigned char*)WT, drow, scr, kb, n0, lane); else transpose_item(W, K, N, WT, drow, scr, kb, n0, lane);
    }
    goff += items;
}
DI void fold_item(const float* W  , bf16* WT  , LAS float* scr  , const LAS float* cosT, int kb, int g, int qtr, int lane) {
    const int k0 = kb * 64;
    float wv[64];
#pragma unroll
    for (int i = 0; i < 64; ++i) wv[i] = W[(size_t)(k0 + i) * 2560 + 2304 + g * 64 + lane];
#pragma unroll
    for (int i = 0; i < 64; ++i) scr[i * 65 + lane] = wv[i];
    asm volatile("s_waitcnt lgkmcnt(0)" ::: "memory");
    float row[64];
#pragma unroll
    for (int c = 0; c < 64; ++c) row[c] = scr[lane * 65 + c];
    for (int jp = qtr * 32; jp < qtr * 32 + 32; ++jp) {
        const int jj = jp & 63, off = (jp >= 64) ? 16 : 0;
        float acc = 0.f;
#pragma unroll
        for (int c = 0; c < 64; ++c) acc += row[c] * cosT[(jj * c + off) & 63];
        WT[(size_t)(2304 + g * 128 + jp) * 1024 + k0 + lane] = (bf16)f2bf(acc);
    }
    asm volatile("s_waitcnt lgkmcnt(0)" ::: "memory");
}

DI void phase0(const Ctx& a, LAS unsigned char* lds) {
    for (int it = blockIdx.x; it < 256; it += (int)gridDim.x) ada_item(a, it, (LAS float*)lds);
    for (int it = (int)gridDim.x - 1 - (int)blockIdx.x; it < 33; it += (int)gridDim.x) filt_hidden_item(a, it, (LAS float*)lds);
    GW_DECL;
    LAS float* cosT = (LAS float*)(lds + LDS_RED);
    if (tid < 64) { float s, c; sincospif((float)tid / 32.0f, &s, &c); cosT[tid] = c; }
    __syncthreads();
    LAS float* scr = (LAS float*)(lds + wave * WAVE_SCR);
    unsigned char* ws = a.ws;
    int goff = 0;
    for (int it = gw; it < 256; it += NGW) fold_item(a.in[8], (bf16*)(ws + WS_W_EIN), scr, cosT, it >> 4, (it >> 2) & 3, it & 3, lane);
    goff += 256;
    {   const int nblk = 2304 / 32, items = 16 * nblk; int first = gw - (goff % NGW); if (first < 0) first += NGW;
        for (int it = first; it < items; it += NGW) { const int kb = it / nblk, n0 = (it % nblk) * 32; transpose_item(a.in[8], 1024, 2560, (bf16*)(ws + WS_W_EIN), n0, scr, kb, n0, lane); }
        goff += items; }
    conv_matrix(a.in[17], 1024, 1024, (bf16*)(ws + WS_W_EOUT), 0, 0, scr, goff, gw, NGW, lane);
    conv_matrix<true>(a.in[18], 1024, DFF, (bf16*)(ws + WS_W_FGU), 1, 0, scr, goff, gw, NGW, lane);
    conv_matrix<true>(a.in[19], 1024, DFF, (bf16*)(ws + WS_W_FGU), 2, 0, scr, goff, gw, NGW, lane);
    conv_matrix<true>(a.in[20], DFF, 1024, (bf16*)(ws + WS_W_FD), 0, 0, scr, goff, gw, NGW, lane);
    conv_matrix(a.in[25], 1024, N2, (bf16*)(ws + WS_W_OIN), 0, 0, scr, goff, gw, NGW, lane);
    conv_matrix(a.in[30], 1024, 1024, (bf16*)(ws + WS_W_OOUT), 0, 0, scr, goff, gw, NGW, lane);
}
DI void conv_moe_weights(const Ctx& a, LAS unsigned char* lds) {
    GW_DECL;
    LAS float* scr = (LAS float*)(lds + wave * WAVE_SCR);
    unsigned char* ws = a.ws; int goff = 0;
    for (int e = 0; e < 4; ++e) {
        conv_matrix<true>(a.in[33] + (size_t)e * 1024 * DFE, 1024, DFE, (bf16*)(ws + WS_WMGU), 1, e * 2 * DFE, scr, goff, gw, NGW, lane);
        conv_matrix<true>(a.in[34] + (size_t)e * 1024 * DFE, 1024, DFE, (bf16*)(ws + WS_WMGU), 2, e * 2 * DFE, scr, goff, gw, NGW, lane);
    }
}

DI void conv_moe_S(const Ctx& a, LAS unsigned char* lds, int it_begin, int it_end, int rank, int nranks) {
    const int lane = lane_id(), wave = wave_of(a.wv);
    LAS float* scr = (LAS float*)(lds + wave * WAVE_SCR);
#pragma unroll 1
    for (int it = it_begin + rank * NWAVES + wave; it < it_end; it += nranks * NWAVES) {
        const int m = it / 1792, r = it % 1792;
        if (m < 8) { const int e = 4 + (m >> 1), t = m & 1, kb = r / 112, n0 = (r % 112) * 32;
            transpose_item_f8(a.in[33 + t] + (size_t)e * 1024 * DFE, 1024, DFE, a.ws + WS_WMGU, e * 2 * DFE + (n0 >> 7) * 256 + (t ? 128 : 0) + (n0 & 127), scr, kb, n0, lane); }
        else { const int e = m - 8, kb = r >> 5, n0 = (r & 31) * 32;
            transpose_item_f8(a.in[35] + (size_t)e * DFE * 1024, DFE, 1024, a.ws + WS_WMD, e * 1024 + n0, scr, kb, n0, lane); }
    }
}

DI void taps_mfma_item(const Ctx& a, int item, LAS unsigned char* lds) {
    GW_DECL;
    const bool isctx = item >= 256;
    const int q = isctx ? item - 256 : item >> 6, posblk = isctx ? 0 : item & 63, cbase = q * 384;
    const int Ln = isctx ? CTXL : SEQL;
    const float* w3 = a.in[15]; const float* H = isctx ? (const float*)(a.ws + WS_H2C) : (const float*)(a.ws + WS_H2);
    bf16* KT = (bf16*)(a.ws + WS_KT); float* KTCp = (float*)(a.ws + WS_KTC);
    for (int e = tid; e < 12 * 4 * 64; e += NTHR) { const int l = e & 63, sidx = (e >> 6) & 3, cgp = e >> 8; const int r = l & 31, h = l >> 5;
        const float* src = w3 + (size_t)(16 * sidx + 8 * h) * 1536 + cbase + 32 * cgp + r;
        v4u o; o.x = pk2(src[0], src[1536]); o.y = pk2(src[2 * 1536], src[3 * 1536]); o.z = pk2(src[4 * 1536], src[5 * 1536]); o.w = pk2(src[6 * 1536], src[7 * 1536]);
        *(LAS v4u*)(lds + (size_t)e * 16) = o; }
    const int r = lane & 31, h = lane >> 5, n = posblk * 256 + wave * 32 + r;
    bf16x8 bfr[4];
#pragma unroll
    for (int sidx = 0; sidx < 4; ++sidx) { const f32x4 v0 = *(const f32x4*)(H + (size_t)n * 64 + 16 * sidx + 8 * h), v1 = *(const f32x4*)(H + (size_t)n * 64 + 16 * sidx + 8 * h + 4);
        v4u o; o.x = pk2(v0[0], v0[1]); o.y = pk2(v0[2], v0[3]); o.z = pk2(v1[0], v1[1]); o.w = pk2(v1[2], v1[3]); bfr[sidx] = __builtin_bit_cast(bf16x8, o); }
    __syncthreads();
    const float tn = (float)n / (float)(Ln - 1);
    const float min_decay = -3.0701134573253945f, max_decay = -15.350567286626973f;
    const bool bwd = cbase >= HYW;
    const int idx = (!bwd || n == 0) ? n : SEQL - n;
#pragma unroll 1
    for (int cgp = 0; cgp < 12; ++cgp) {
        f32x16 acc;
#pragma unroll
        for (int i = 0; i < 16; ++i) acc[i] = 0.f;
#pragma unroll
        for (int sidx = 0; sidx < 4; ++sidx) { const bf16x8 af = *(LAS bf16x8*)(lds + ((cgp * 4 + sidx) * 64 + lane) * 16); acc = __builtin_amdgcn_mfma_f32_32x32x16_bf16(af, bfr[sidx], acc, 0, 0, 0); }
#pragma unroll
        for (int i = 0; i < 16; ++i) { const int c = cbase + 32 * cgp + (i & 3) + 8 * (i >> 2) + 4 * h, cc = c % HYW;
            const float delta = fabsf(min_decay + (float)cc * ((max_decay - min_decay) / 767.0f));
            const float val = acc[i] * __builtin_amdgcn_exp2f(-tn * delta * 1.4426950408889634f);
            if (isctx) KTCp[(size_t)c * CTXL + n] = val;
            else KT[(size_t)c * UTP + idx] = (bf16)((bwd && n == 0) ? 0u : f2bf(val)); }
    }
    __syncthreads();
}

template <bool F8 = false>
DI void norm_rows(const float* xlat, const float* xctx, const float* gain, const float* ADA  , int sh_off, int sc_off, bf16* H, int nrows, int gw, int NGW, int lane) {
    f32x4 nv[2][4];
#pragma unroll
    for (int q = 0; q < 2; ++q) { const int r = gw + q * NGW;
        if (r < nrows) { const float* xr = (r < T_LAT) ? xlat + (size_t)r * DM : xctx + (size_t)(r - T_LAT) * DM;
#pragma unroll
            for (int j = 0; j < 4; ++j) nv[q][j] = *(const f32x4*)(xr + 4 * lane + 256 * j); } }
    for (int r0 = gw; r0 < nrows; r0 += 2 * NGW) {
        f32x4 v[2][4];
#pragma unroll
        for (int q = 0; q < 2; ++q)
#pragma unroll
            for (int j = 0; j < 4; ++j) v[q][j] = nv[q][j];
#pragma unroll
        for (int q = 0; q < 2; ++q) { const int rn = r0 + (2 + q) * NGW;
            if (rn < nrows) { const float* xr = (rn < T_LAT) ? xlat + (size_t)rn * DM : xctx + (size_t)(rn - T_LAT) * DM;
#pragma unroll
                for (int j = 0; j < 4; ++j) nv[q][j] = *(const f32x4*)(xr + 4 * lane + 256 * j); } }
#pragma unroll
        for (int q = 0; q < 2; ++q) { const int r = r0 + q * NGW;
            if (r < nrows) {
                const int cond = r >> 14;
                float ss = 0.f;
#pragma unroll
                for (int j = 0; j < 4; ++j) ss += (v[q][j].x * v[q][j].x + v[q][j].y * v[q][j].y) + (v[q][j].z * v[q][j].z + v[q][j].w * v[q][j].w);
                const float rstd = 1.0f / sqrtf(wave_sum(ss) * (1.0f / DM) + 1e-6f);
#pragma unroll
                for (int j = 0; j < 4; ++j) {
                    const int c = 4 * lane + 256 * j;
                    const f32x4 g = *(const f32x4*)(gain + c), sc = *(const f32x4*)(ADA + cond * 6144 + sc_off + c), sh = *(const f32x4*)(ADA + cond * 6144 + sh_off + c);
                    const f32x4 y = (v[q][j] * rstd) * g * (sc + 1.0f) + sh;
                    if constexpr (F8) *(unsigned*)((unsigned char*)H + (size_t)r * DM + c) = pg8::pk4_fp8(y.x * pg8::F8_SX, y.y * pg8::F8_SX, y.z * pg8::F8_SX, y.w * pg8::F8_SX);
                    else { v2u o; o.x = pk2(y.x, y.y); o.y = pk2(y.z, y.w);
                    *(v2u*)(H + (size_t)r * DM + c) = o; }
                } } }
    }
}

template <int NKS, bool F8 = false>
DI void norm_ctx_partial(const float* xsrc, const float* gain, const float* ADA, int sh_off, int sc_off, bf16* Hout, const float* part, const float* pgate, float* wb, int gw, int NGW, int lane) {
    for (int rc = gw; rc < T_CTX; rc += NGW) {
        f32x4 v[4]; float ss = 0.f;
#pragma unroll
        for (int j = 0; j < 4; ++j) { const int c = 4 * lane + 256 * j;
            f32x4 pl[NKS];
#pragma unroll
            for (int sl = 0; sl < NKS; ++sl) pl[sl] = *(const f32x4*)(part + ((size_t)sl * 512 + rc) * 1024 + c);
            const f32x4 x0 = *(const f32x4*)(xsrc + (size_t)rc * DM + c), pg = *(const f32x4*)(pgate + c);
            f32x4 sum = pl[0];
#pragma unroll
            for (int sl = 1; sl < NKS; ++sl) sum += pl[sl];
            const f32x4 x = x0 + pg * sum;
            if (wb) *(f32x4*)(wb + (size_t)rc * DM + c) = x;
            v[j] = x;
            ss += (x.x * x.x + x.y * x.y) + (x.z * x.z + x.w * x.w); }
        const float rstd = 1.0f / sqrtf(wave_sum(ss) * (1.0f / DM) + 1e-6f);
#pragma unroll
        for (int j = 0; j < 4; ++j) { const int c = 4 * lane + 256 * j;
            const f32x4 g = *(const f32x4*)(gain + c), sc = *(const f32x4*)(ADA + 2 * 6144 + sc_off + c), sh = *(const f32x4*)(ADA + 2 * 6144 + sh_off + c);
            const f32x4 y = (v[j] * rstd) * g * (sc + 1.0f) + sh;
            if constexpr (F8) *(unsigned*)((unsigned char*)Hout + (size_t)(T_LAT + rc) * DM + c) = pg8::pk4_fp8(y.x * pg8::F8_SX, y.y * pg8::F8_SX, y.z * pg8::F8_SX, y.w * pg8::F8_SX);
            else { v2u o; o.x = pk2(y.x, y.y); o.y = pk2(y.z, y.w);
            *(v2u*)(Hout + (size_t)(T_LAT + rc) * DM + c) = o; } }
    }
}

DI void norm_router_phase(const Ctx& a, LAS unsigned char* lds) {
    GW_DECL;
    LAS float* rw = (LAS float*)lds;
    LAS int* cnt = (LAS int*)(lds + LDS_RED);
    const float* RW = a.in[31]; const float* RB = a.in[32];
    for (int i = tid; i < 8192; i += NTHR) rw[i] = RW[i];
    if (tid < 16) cnt[tid] = 0;
    __syncthreads();
    const float* ADA = (const float*)(a.ws + WS_ADA) + 3 * 6144;
    const float* gain = a.in[24];
    bf16* H = (bf16*)(a.ws + WS_H);
    int* toke = (int*)(a.ws + WS_TOKE); float* tokg = (float*)(a.ws + WS_TOKG);
    const int RPB = T_LAT / G;
    f32x4 nv[4];
    {   const float* xr = a.out + (size_t)(blockIdx.x * RPB + wave) * DM;
#pragma unroll
        for (int j = 0; j < 4; ++j) nv[j] = *(const f32x4*)(xr + 4 * lane + 256 * j); }
    for (int rr = wave; rr < RPB; rr += NWAVES) {
        const int r = blockIdx.x * RPB + rr, cond = r >> 14;
        f32x4 v[4]; float ss = 0.f;
#pragma unroll
        for (int j = 0; j < 4; ++j) { v[j] = nv[j]; ss += (v[j].x * v[j].x + v[j].y * v[j].y) + (v[j].z * v[j].z + v[j].w * v[j].w); }
        if (rr + NWAVES < RPB) { const float* xr = a.out + (size_t)(r + NWAVES) * DM;
#pragma unroll
            for (int j = 0; j < 4; ++j) nv[j] = *(const f32x4*)(xr + 4 * lane + 256 * j); }
        const float rstd = 1.0f / sqrtf(wave_sum(ss) * (1.0f / DM) + 1e-6f);
        float lg[8];
#pragma unroll
        for (int e = 0; e < 8; ++e) lg[e] = 0.f;
#pragma unroll
        for (int j = 0; j < 4; ++j) {
            const int c = 4 * lane + 256 * j;
            const f32x4 g = *(const f32x4*)(gain + c), sc = *(const f32x4*)(ADA + cond * 6144 + 4096 + c), sh = *(const f32x4*)(ADA + cond * 6144 + 3072 + c);
            const f32x4 y = (v[j] * rstd) * g * (sc + 1.0f) + sh;
            *(unsigned*)((unsigned char*)H + (size_t)r * DM + c) = pg8::pk4_fp8(y.x * pg8::F8_SX, y.y * pg8::F8_SX, y.z * pg8::F8_SX, y.w * pg8::F8_SX);
#pragma unroll
            for (int q = 0; q < 4; ++q) { const f32x4 w0 = *(LAS f32x4*)(rw + (c + q) * 8), w1 = *(LAS f32x4*)(rw + (c + q) * 8 + 4);
                lg[0] += y[q] * w0[0]; lg[1] += y[q] * w0[1]; lg[2] += y[q] * w0[2]; lg[3] += y[q] * w0[3];
                lg[4] += y[q] * w1[0]; lg[5] += y[q] * w1[1]; lg[6] += y[q] * w1[2]; lg[7] += y[q] * w1[3]; }
        }
#pragma unroll
        for (int e = 0; e < 8; ++e) lg[e] = wave_sum(lg[e]) + RB[e];
        int e1 = 0; float v1 = lg[0];
#pragma unroll
        for (int e = 1; e < 8; ++e) if (lg[e] > v1) { v1 = lg[e]; e1 = e; }
        int e2 = -1; float v2 = -3.0e38f;
#pragma unroll
        for (int e = 0; e < 8; ++e) if (e != e1 && lg[e] > v2) { v2 = lg[e]; e2 = e; }
        const float g1 = 1.0f / (1.0f + expf(v2 - v1)), g2 = 1.0f - g1;
        if (lane == 0) { toke[2 * r] = e1; toke[2 * r + 1] = e2; tokg[2 * r] = g1; tokg[2 * r + 1] = g2; __hip_atomic_fetch_add(&cnt[e1], 1, __ATOMIC_RELAXED, __HIP_MEMORY_SCOPE_WORKGROUP); __hip_atomic_fetch_add(&cnt[8 + e2], 1, __ATOMIC_RELAXED, __HIP_MEMORY_SCOPE_WORKGROUP); }
    }
    __syncthreads();
    if (tid < 16) ((int*)(a.ws + WS_BLKCNT))[blockIdx.x * 16 + tid] = cnt[tid];
    __syncthreads();
}

DI void slot_phase(const Ctx& a, LAS unsigned char* lds) {
    GW_DECL;
    LAS int* tot = (LAS int*)lds;
    LAS int* pre = tot + 16;
    LAS int* segstart = tot + 32;
    LAS int* cntL = tot + 64;
    LAS int* tokL = cntL + 4096;
    const int* blkcnt = (const int*)(a.ws + WS_BLKCNT);
    const int* toke = (const int*)(a.ws + WS_TOKE); const float* tokg = (const float*)(a.ws + WS_TOKG);
    const int RPB = T_LAT / G;
    for (int i = tid; i < G * 16; i += NTHR) cntL[i] = blkcnt[i];
    for (int i = tid; i < RPB * 2; i += NTHR) tokL[i] = toke[(size_t)blockIdx.x * RPB * 2 + i];
    __syncthreads();
    if (tid < 16) { int t = 0, p = 0; for (int b = 0; b < G; ++b) { const int c = cntL[b * 16 + tid]; if (b < (int)blockIdx.x) p += c; t += c; } tot[tid] = t; pre[tid] = p; }
    __syncthreads();
    if (tid == 0) { int s = 0; for (int g = 0; g < 16; ++g) { segstart[g] = s; s += ((tot[g] + 255) >> 8) << 8; } segstart[16] = s; }
    __syncthreads();
    int* slot_tok = (int*)(a.ws + WS_SLOTTOK); float* slot_w = (float*)(a.ws + WS_SLOTW);
    LAS int* posL = tokL + 2 * RPB;
    {
        LAS int* wcnt = posL + 2 * RPB;
        const bool act = tid < 2 * RPB;
        const int myseg = act ? (tid & 1) * 8 + tokL[tid] : -1;
        int rank = 0;
#pragma unroll
        for (int sg = 0; sg < 16; ++sg) { const unsigned long long m = __ballot(myseg == sg); if (myseg == sg) rank = __popcll(m & ((1ull << lane) - 1ull)); if (lane == 0 && wave < 4) wcnt[wave * 16 + sg] = __popcll(m); }
        __syncthreads();
        if (act) { int off = 0; for (int w = 0; w < wave; ++w) off += wcnt[w * 16 + myseg];
            const int pos = segstart[myseg] + pre[myseg] + off + rank, r = blockIdx.x * RPB + (tid >> 1);
            slot_tok[pos] = r; slot_w[pos] = tokg[2 * r + (tid & 1)]; posL[tid] = pos; }
    }
    __syncthreads();
    {
        const unsigned char* Hn = a.ws + WS_H; unsigned char* HP = a.ws + WS_BIG;
        for (int q0 = wave * 8; q0 < 2 * RPB; q0 += NWAVES * 8) {
            v4u v0[8]; int ps[8];
#pragma unroll
            for (int q = 0; q < 8; ++q) { const int r = blockIdx.x * RPB + ((q0 + q) >> 1); ps[q] = posL[q0 + q];
                v0[q] = *(const v4u*)(Hn + (size_t)r * DM + 16 * lane); }
#pragma unroll
            for (int q = 0; q < 8; ++q) *(v4u*)(HP + (size_t)ps[q] * DM + 16 * lane) = v0[q];
        }
        const v4u z = {0u, 0u, 0u, 0u};
        for (int g = 0; g < 16; ++g) { const int s0 = segstart[g] + tot[g], s1 = segstart[g + 1];
            for (int sl = s0 + gw; sl < s1; sl += NGW) { if (lane == 0) { slot_tok[sl] = -1; slot_w[sl] = 0.f; }
                *(v4u*)(HP + (size_t)sl * DM + 16 * lane) = z; } }
    }
    if (blockIdx.x == 0) {
        int* panel_e = (int*)(a.ws + WS_PANELE);
        for (int g = 0; g < 16; ++g) {
            for (int p = (segstart[g] >> 8) + tid; p < (segstart[g + 1] >> 8); p += NTHR) panel_e[p] = g & 7; }
    }
    if (blockIdx.x == (unsigned)(G - 1)) {
        int* panel_e = (int*)(a.ws + WS_PANELE);
        {
            const int P0 = segstart[8] >> 8, P = segstart[16] >> 8, P1 = P - P0, n0 = P0 >> 7, n1 = P1 >> 7;
            int* cnp = panel_e + PE_CNP; int* clist = panel_e + PE_LIST; int* cres = panel_e + PE_RES;
            for (int e = tid; e < (n0 + n1) * 128; e += NTHR) { const int i = e >> 7, q = e & 127, pa = (i < n0) ? 128 * i + q : P0 + 128 * (i - n0) + q;
                clist[i * 128 + q] = pa; cres[i * 128 + (pa & 127)] = pa; if (q == 0) cnp[i] = 128; }
        }
        if (tid == 0) {
            const int P0 = segstart[8] >> 8, P = segstart[16] >> 8, P1 = P - P0;
            const int n0 = P0 >> 7, r0 = P0 & 127, n1 = P1 >> 7, r1 = P1 & 127;
            int nc = n0 + n1, lastnp = 128;
            int* cnp = panel_e + PE_CNP; int* clist = panel_e + PE_LIST; int* cres = panel_e + PE_RES;
            int eA = -1, eB = -1; bool single = (r0 + r1 <= 128);
            for (int q = 0; q < r0 && single; ++q) { const int pa = 128 * n0 + q; int g = 0; while ((segstart[g + 1] >> 8) <= pa) ++g; const int e = g & 7; if (eA < 0) eA = e; else if (eA != e) single = false; }
            for (int q = 0; q < r1 && single; ++q) { const int pa = P0 + 128 * n1 + q; int g = 8; while ((segstart[g + 1] >> 8) <= pa) ++g; const int e = g & 7; if (eB < 0) eB = e; else if (eB != e) single = false; }
            if (single && r0 > 0 && r1 > 0 && eA != eB) single = false;
            if (single) { int k = 0;
                for (int q = 0; q < r0; ++q) { const int pa = 128 * n0 + q; clist[nc * 128 + k++] = pa; cres[nc * 128 + (pa & 127)] = pa; }
                for (int q = 0; q < r1; ++q) { const int pa = P0 + 128 * n1 + q; clist[nc * 128 + k++] = pa; cres[nc * 128 + (pa & 127)] = pa; }
                if (k > 0) { cnp[nc] = k; lastnp = k; ++nc; }
            } else {
                if (r0 > 0) { for (int q = 0; q < r0; ++q) { const int pa = 128 * n0 + q; clist[nc * 128 + q] = pa; cres[nc * 128 + (pa & 127)] = pa; } cnp[nc] = r0; lastnp = r0; ++nc; }
                if (r1 > 0) { for (int q = 0; q < r1; ++q) { const int pa = P0 + 128 * n1 + q; clist[nc * 128 + q] = pa; cres[nc * 128 + (pa & 127)] = pa; } cnp[nc] = r1; lastnp = r1; ++nc; }
            }
            panel_e[400] = P; panel_e[401] = P0; panel_e[402] = nc;
            int* sd = panel_e + PE_SD; int* sg = panel_e + PE_SG; int* sx = panel_e + PE_SX; int* snd = panel_e + PE_SND; int ns = 0;
            const int last = nc - 1;
            bool xok = (nc >= 2) && lastnp <= XPANELS;
            if (xok) for (int q = 0; q < lastnp; ++q) if ((clist[last * 128 + q] & 127) >= XPANELS) xok = false;
            if (xok && (n0 + n1) > 0 && G == 256) {
                sd[ns] = -1; sg[ns] = last; sx[ns] = 2; snd[ns] = 0; ++ns;
                sd[ns] = last; sg[ns] = 0; sx[ns] = 1; snd[ns] = lastnp * 4; ++ns;
                for (int chh = 1; chh < last; ++chh) { sd[ns] = chh - 1; sg[ns] = chh; sx[ns] = (((chh - 1) & 1) ? 4 : 0) | ((chh & 1) ? 8 : 0); snd[ns] = 0; ++ns; }
                sd[ns] = last - 1; sg[ns] = -1; sx[ns] = ((last - 1) & 1) ? 4 : 0; snd[ns] = 0; ++ns;
            } else {
                sd[ns] = -1; sg[ns] = 0; sx[ns] = 0; snd[ns] = 0; ++ns;
                for (int chh = 1; chh < nc; ++chh) { sd[ns] = chh - 1; sg[ns] = chh; sx[ns] = (((chh - 1) & 1) ? 4 : 0) | ((chh & 1) ? 8 : 0); snd[ns] = 0; ++ns; }
                sd[ns] = nc - 1; sg[ns] = -1; sx[ns] = ((nc - 1) & 1) ? 4 : 0; snd[ns] = 0; ++ns;
            }
            panel_e[PE_NSTEP] = ns;
        }
    }
    __syncthreads();
}

DI void gather_phase(const Ctx& a) {
    GW_DECL;
    const int P = ((const int*)(a.ws + WS_PANELE))[400];
    const int* slot_tok = (const int*)(a.ws + WS_SLOTTOK);
    const bf16* H = (const bf16*)(a.ws + WS_H); bf16* HP = (bf16*)(a.ws + WS_BIG);
    const int nslots = P * 256;
    for (int s0 = gw * 4; s0 < nslots; s0 += NGW * 4) {
        int tok[4]; v4u v0[4], v1[4];
#pragma unroll
        for (int q = 0; q < 4; ++q) tok[q] = slot_tok[s0 + q];
#pragma unroll
        for (int q = 0; q < 4; ++q) { v0[q] = (v4u){0u, 0u, 0u, 0u}; v1[q] = (v4u){0u, 0u, 0u, 0u};
            if (tok[q] >= 0) { v0[q] = *(const v4u*)(H + (size_t)tok[q] * DM + 8 * lane); v1[q] = *(const v4u*)(H + (size_t)tok[q] * DM + 512 + 8 * lane); } }
#pragma unroll
        for (int q = 0; q < 4; ++q) { *(v4u*)(HP + (size_t)(s0 + q) * DM + 8 * lane) = v0[q]; *(v4u*)(HP + (size_t)(s0 + q) * DM + 512 + 8 * lane) = v1[q]; }
    }
}

DI void prep0_phase(const Ctx& a, LAS unsigned char* lds) {
    GW_DECL;
    const bf16* P = (const bf16*)(a.ws + WS_BIG);
    bf16* A2 = (bf16*)(a.ws + WS_X0C); bf16* UT = (bf16*)(a.ws + WS_UT); unsigned* F1T = (unsigned*)(a.ws + WS_F1T);
    const float* SW = a.in[9];
    LAS bf16* raw = (LAS bf16*)lds;
    const int NH = 2 * 256 * 3, NF = 2 * 256;
    for (int it = blockIdx.x; it < NH + NF; it += G) {
        if (it < NH) {
            const int cq = it % 3, tch = (it / 3) % 256, b = it / 768, t0 = tch * 64, c0 = cq * 256;
            const size_t rowb = (size_t)b * SEQL;
            {   v4u sv[13];
#pragma unroll
                for (int i = 0; i < 13; ++i) { const int p = tid + NTHR * i; const int pc = p & 31, r = (p >> 5) % 66, sidx = p / (66 * 32); const int t = t0 - 1 + r;
                    sv[i] = (v4u){0u, 0u, 0u, 0u}; if (p < 3 * 66 * 32 && t >= 0 && t < SEQL) sv[i] = __builtin_nontemporal_load((const v4u*)(P + (rowb + t) * N1 + sidx * HYW + c0 + pc * 8)); }
#pragma unroll
                for (int i = 0; i < 13; ++i) { const int p = tid + NTHR * i; const int pc = p & 31, r = (p >> 5) % 66, sidx = p / (66 * 32);
                    if (p < 3 * 66 * 32) *(LAS v4u*)(raw + (sidx * 66 + r) * 256 + pc * 8) = sv[i]; } }
            __syncthreads();
            const int c = tid & 255, tg = tid >> 8;
            float w[3][3];
#pragma unroll
            for (int k = 0; k < 3; ++k)
#pragma unroll
                for (int sidx = 0; sidx < 3; ++sidx) w[k][sidx] = SW[k * 2304 + sidx * HYW + c0 + c];
            float pv[3], cu[3];
#pragma unroll
            for (int sidx = 0; sidx < 3; ++sidx) { pv[sidx] = bf2f(raw[(sidx * 66 + tg * 32) * 256 + c]); cu[sidx] = bf2f(raw[(sidx * 66 + tg * 32 + 1) * 256 + c]); }
            unsigned up[16];
#pragma unroll
            for (int tt = 0; tt < 32; ++tt) {
                float cv[3];
#pragma unroll
                for (int sidx = 0; sidx < 3; ++sidx) { const float nx = bf2f(raw[(sidx * 66 + tg * 32 + tt + 2) * 256 + c]);
                    cv[sidx] = w[0][sidx] * pv[sidx] + w[1][sidx] * cu[sidx] + w[2][sidx] * nx; pv[sidx] = cu[sidx]; cu[sidx] = nx; }
                A2[(rowb + t0 + tg * 32 + tt) * DM + c0 + c] = (bf16)f2bf(cv[0]);
                const unsigned ub = f2bf(cv[2] * cv[1]);
                if (tt & 1) up[tt >> 1] |= ub << 16; else up[tt >> 1] = ub;
            }
            v4u* dst = (v4u*)(UT + ((size_t)(c0 + c) * 2 + b) * UTP + t0 + tg * 32);
#pragma unroll
            for (int q = 0; q < 4; ++q) dst[q] = (v4u){up[4 * q], up[4 * q + 1], up[4 * q + 2], up[4 * q + 3]};
            __syncthreads();
        } else {
            const int f = it - NH, tch = f % 256, b = f / 256, t0 = tch * 64; const size_t rowb = (size_t)b * SEQL;
            {   v4u sv[8];
#pragma unroll
                for (int i = 0; i < 8; ++i) { const int p = tid + NTHR * i, pc = p & 63, r = p >> 6; sv[i] = __builtin_nontemporal_load((const v4u*)(P + (rowb + t0 + r) * N1 + 2304 + pc * 8)); }
#pragma unroll
                for (int i = 0; i < 8; ++i) { const int p = tid + NTHR * i, pc = p & 63, r = p >> 6; *(LAS v4u*)(raw + r * 512 + pc * 8) = sv[i]; } }
            __syncthreads();
            const int jb = tid & 255, g = jb >> 6, j = jb & 63, tg = tid >> 8;
            unsigned o[32];
#pragma unroll
            for (int tt = 0; tt < 32; ++tt) { const unsigned re = raw[(tg * 32 + tt) * 512 + g * 128 + j], im = raw[(tg * 32 + tt) * 512 + g * 128 + 64 + j]; o[tt] = re | (im << 16); }
            v4u* dst = (v4u*)(F1T + ((size_t)((b * 4 + g) * 64 + j)) * F1P + t0 + tg * 32);
#pragma unroll
            for (int q = 0; q < 8; ++q) dst[q] = (v4u){o[4 * q], o[4 * q + 1], o[4 * q + 2], o[4 * q + 3]};
            __syncthreads();
        }
    }
}

DI void untr0_phase(const Ctx& a, LAS unsigned char* lds) {
    GW_DECL;
    bf16* A2 = (bf16*)(a.ws + WS_A2); const bf16* X0C = (const bf16*)(a.ws + WS_X0C); const bf16* YT = (const bf16*)(a.ws + WS_YT); const bf16* YF = (const bf16*)(a.ws + WS_YF);
    LAS unsigned* tile32 = (LAS unsigned*)lds;
    LAS bf16* tile = (LAS bf16*)lds;
    const int NH = 2 * 256 * 3, NF = 2 * 256;
    for (int it = blockIdx.x; it < NH + NF; it += G) {
        const bool hy = it < NH;
        const int f = it - NH;
        const int cq = hy ? it % 3 : 0, tch = hy ? (it / 3) % 256 : f % 256, b = hy ? it / 768 : f / 256, t0 = tch * 64, c0 = cq * 256;
        const size_t rowb = (size_t)b * SEQL;
        {   v4u sv[4];
#pragma unroll
            for (int i = 0; i < 4; ++i) { const int p = tid + NTHR * i, pc = p & 7, c = p >> 3;
                const bf16* src = hy ? YT + ((size_t)(c0 + c) * 2 + b) * UTP + t0 + pc * 8 : YF + ((size_t)(b * 256 + c)) * UTP + t0 + pc * 8; sv[i] = __builtin_nontemporal_load((const v4u*)src); }
#pragma unroll
            for (int i = 0; i < 4; ++i) { const int p = tid + NTHR * i, pc = p & 7, c = p >> 3; LAS unsigned* d = tile32 + c * 33 + pc * 4; d[0] = sv[i].x; d[1] = sv[i].y; d[2] = sv[i].z; d[3] = sv[i].w; } }
        __syncthreads();
        const int c8 = tid & 31, tr = tid >> 5;
        v4u xq[4];
#pragma unroll
        for (int q = 0; q < 4; ++q) { xq[q] = (v4u){0u, 0u, 0u, 0u}; if (hy) xq[q] = *(const v4u*)(X0C + (rowb + t0 + tr + 16 * q) * DM + c0 + c8 * 8); }
#pragma unroll
        for (int q = 0; q < 4; ++q) { const int t = tr + 16 * q;
            float y[8];
#pragma unroll
            for (int j = 0; j < 8; ++j) y[j] = bf2f(tile[(c8 * 8 + j) * 66 + t]);
            bf16* ap = A2 + (rowb + t0 + t) * DM + (hy ? c0 : HYW) + c8 * 8;
            v4u o;
            if (hy) { const v4u x = xq[q];
                o.x = pk2(bflo(x.x) * y[0], bfhi(x.x) * y[1]); o.y = pk2(bflo(x.y) * y[2], bfhi(x.y) * y[3]); o.z = pk2(bflo(x.z) * y[4], bfhi(x.z) * y[5]); o.w = pk2(bflo(x.w) * y[6], bfhi(x.w) * y[7]); }
            else { o.x = pk2(y[0], y[1]); o.y = pk2(y[2], y[3]); o.z = pk2(y[4], y[5]); o.w = pk2(y[6], y[7]); }
            *(v4u*)ap = o; }
        __syncthreads();
    }
}

DI void prep1_phase(const Ctx& a, LAS unsigned char* lds) {
    GW_DECL;
    const bf16* P = (const bf16*)(a.ws + WS_BIG);
    bf16* A2 = (bf16*)(a.ws + WS_A2); bf16* QR = (bf16*)(a.ws + WS_QR); bf16* KR = (bf16*)(a.ws + WS_KR); bf16* VT = (bf16*)(a.ws + WS_VT);
    bf16* KC = (bf16*)(a.ws + WS_KC); bf16* VCT = (bf16*)(a.ws + WS_VCT);
    const float* qn = a.in[26]; const float* kn = a.in[27]; const float* CW = a.in[29];
    LAS bf16* raw = (LAS bf16*)lds;
    const int NC = 1024, NQ = 1024, NQC = 16;
    const float QSCALE = 0.125f * 1.4426950408889634f;
    for (int it = blockIdx.x; it < NC + NQ + NQC; it += G) {
        if (it < NC) {
            const int b = it / 512, t0 = (it % 512) * 32; const size_t rowb = (size_t)b * SEQL;
            {   v4u sv[13];
#pragma unroll
                for (int i = 0; i < 13; ++i) { const int p = tid + NTHR * i, pc = p % 192, r = p / 192, t = t0 - 1 + r; sv[i] = (v4u){0u, 0u, 0u, 0u};
                    if (p < 34 * 192 && t >= 0 && t < SEQL) sv[i] = __builtin_nontemporal_load((const v4u*)(P + (rowb + t) * N2 + 768 + pc * 8)); }
#pragma unroll
                for (int i = 0; i < 13; ++i) { const int p = tid + NTHR * i, pc = p % 192, r = p / 192; if (p < 34 * 192) *(LAS v4u*)(raw + r * 1536 + pc * 8) = sv[i]; } }
            __syncthreads();
            const int c8 = tid & 63, tr = tid >> 6, c = 8 * c8;
            float w[3][8];
#pragma unroll
            for (int k = 0; k < 3; ++k) { const f32x4 w0 = *(const f32x4*)(CW + k * 512 + c), w1 = *(const f32x4*)(CW + k * 512 + c + 4);
                w[k][0] = w0[0]; w[k][1] = w0[1]; w[k][2] = w0[2]; w[k][3] = w0[3]; w[k][4] = w1[0]; w[k][5] = w1[1]; w[k][6] = w1[2]; w[k][7] = w1[3]; }
            float pr[6][8];
#pragma unroll
            for (int q = 0; q < 6; ++q) { const v4u gc = *(LAS v4u*)(raw + (tr * 4 + q) * 1536 + 512 + c), hx = *(LAS v4u*)(raw + (tr * 4 + q) * 1536 + 1024 + c);
                pr[q][0] = bflo(gc.x) * bflo(hx.x); pr[q][1] = bfhi(gc.x) * bfhi(hx.x); pr[q][2] = bflo(gc.y) * bflo(hx.y); pr[q][3] = bfhi(gc.y) * bfhi(hx.y);
                pr[q][4] = bflo(gc.z) * bflo(hx.z); pr[q][5] = bfhi(gc.z) * bfhi(hx.z); pr[q][6] = bflo(gc.w) * bflo(hx.w); pr[q][7] = bfhi(gc.w) * bfhi(hx.w); }
#pragma unroll
            for (int k = 0; k < 4; ++k) { const int rr = tr * 4 + k;
                const v4u gb = *(LAS v4u*)(raw + (rr + 1) * 1536 + c);
                const float gbf[8] = {bflo(gb.x), bfhi(gb.x), bflo(gb.y), bfhi(gb.y), bflo(gb.z), bfhi(gb.z), bflo(gb.w), bfhi(gb.w)};
                float y[8];
#pragma unroll
                for (int j = 0; j < 8; ++j) y[j] = gbf[j] * (w[0][j] * pr[k][j] + w[1][j] * pr[k + 1][j] + w[2][j] * pr[k + 2][j]);
                v4u o; o.x = pk2(y[0], y[1]); o.y = pk2(y[2], y[3]); o.z = pk2(y[4], y[5]); o.w = pk2(y[6], y[7]);
                *(v4u*)(A2 + (rowb + t0 + rr) * DM + 512 + c) = o; }
            __syncthreads();
        } else {
            const int i2 = it - NC; const bool isctx = i2 >= NQ;
            const int row0 = isctx ? T_LAT + (i2 - NQ) * 32 : i2 * 32;
            if (!isctx) { v4u sv[6];
#pragma unroll
                for (int i = 0; i < 6; ++i) { const int p = tid + NTHR * i, pc = p % 96, r = p / 96; sv[i] = __builtin_nontemporal_load((const v4u*)(P + (size_t)(row0 + r) * N2 + pc * 8)); }
#pragma unroll
                for (int i = 0; i < 6; ++i) { const int p = tid + NTHR * i, pc = p % 96, r = p / 96; *(LAS v4u*)(raw + r * 768 + pc * 8) = sv[i]; } }
            else { for (int p = tid; p < 32 * 32; p += NTHR) { const int pc = p & 31, r = p >> 5; *(LAS v4u*)(raw + r * 768 + 512 + pc * 8) = *(const v4u*)(P + (size_t)(row0 + r) * N2 + 512 + pc * 8); } }
            __syncthreads();
            const int d = lane, fi = d & 15;
            const float inv_freq = exp2f(-(float)fi * (13.287712379549449f / 16.0f)) * 0.15915494309189535f;
            const float gq = qn[d], gk = kn[d];
#pragma unroll 1
            for (int k = 0; k < 4; ++k) { const int rr = wave * 4 + k, row = row0 + rr;
                if (!isctx) {
                    const int t = row & (SEQL - 1);
                    const float pos = (float)((d < 32) ? (t >> 6) : (t & 63));
                    const float sn = __builtin_amdgcn_sinf(pos * inv_freq), cs = __builtin_amdgcn_cosf(pos * inv_freq);
#pragma unroll
                    for (int hh = 0; hh < 10; ++hh) {
                        const float x = bf2f(raw[rr * 768 + hh * 64 + d]);
                        const float ss = wave_sum(x * x);
                        const float xn = x * (1.0f / sqrtf(ss * (1.0f / 64.0f) + 1e-6f)) * (hh < 8 ? gq : gk);
                        const float pr = __shfl_xor(xn, 16);
                        const float o = (d & 16) ? (xn * cs + pr * sn) : (xn * cs - pr * sn);
                        if (hh < 8) QR[(size_t)row * 512 + hh * 64 + d] = (bf16)f2bf(o * QSCALE);
                        else KR[(size_t)row * 128 + (hh - 8) * 64 + d] = (bf16)f2bf(o);
                    }
                } else {
                    const int cr = row - T_LAT, bb = cr >> 8, j = cr & 255;
#pragma unroll
                    for (int kh = 0; kh < 2; ++kh) {
                        const float x = bf2f(raw[rr * 768 + 512 + kh * 64 + d]);
                        const float ss = wave_sum(x * x);
                        KC[((size_t)(bb * 256 + j) * 2 + kh) * 64 + d] = (bf16)f2bf(x * (1.0f / sqrtf(ss * (1.0f / 64.0f) + 1e-6f)) * gk);
                    }
                }
            }
            {
                const int dd = tid & 127, tg = tid >> 7;
                unsigned o[4];
#pragma unroll
                for (int q = 0; q < 4; ++q) o[q] = (unsigned)raw[(tg * 8 + 2 * q) * 768 + 640 + dd] | ((unsigned)raw[(tg * 8 + 2 * q + 1) * 768 + 640 + dd] << 16);
                if (!isctx) { const int bb = row0 >> 14, t0 = row0 & (SEQL - 1);
                    *(v4u*)(VT + ((size_t)(bb * 128 + dd)) * UTP + t0 + tg * 8) = (v4u){o[0], o[1], o[2], o[3]}; }
                else { const int cr = row0 - T_LAT, bb = cr >> 8, j0 = cr & 255;
                    *(v4u*)(VCT + ((size_t)(bb * 128 + dd)) * CTXL + j0 + tg * 8) = (v4u){o[0], o[1], o[2], o[3]}; }
            }
            __syncthreads();
        }
    }
}

DI int pidx(int i) { return i + (i >> 4); }
DI void sincos_rev(float x, float& s, float& c) { s = __builtin_amdgcn_sinf(x); c = __builtin_amdgcn_cosf(x); }
DI f32x2 cmul(f32x2 a, f32x2 b) { return (f32x2){a.x * b.x - a.y * b.y, a.x * b.y + a.y * b.x}; }
DI float c32(int i) { const float t[16] = {1.0000000000000000f, 0.9807852804032304f, 0.9238795325112867f, 0.8314696123025452f, 0.7071067811865476f, 0.5555702330196023f, 0.3826834323650898f, 0.1950903220161283f, 0.0000000000000001f, -0.1950903220161282f, -0.3826834323650897f, -0.5555702330196020f, -0.7071067811865475f, -0.8314696123025453f, -0.9238795325112867f, -0.9807852804032304f}; return t[i]; }
DI float s32(int i) { const float t[16] = {0.0000000000000000f, 0.1950903220161282f, 0.3826834323650898f, 0.5555702330196022f, 0.7071067811865475f, 0.8314696123025452f, 0.9238795325112867f, 0.9807852804032304f, 1.0000000000000000f, 0.9807852804032304f, 0.9238795325112867f, 0.8314696123025455f, 0.7071067811865476f, 0.5555702330196022f, 0.3826834323650899f, 0.1950903220161286f}; return t[i]; }

DI f32x2 cmulr(f32x2 a, f32x2 t, f32x2 tr) { return a.xx * t + a.yy * tr; }
DI f32x2 rot90(f32x2 t) { return (f32x2){-t.y, t.x}; }
template <int HPL2, int RL2, bool INV, bool FUSE = false>
DI void fft_pass(LAS f32x2* X, int tid, const f32x2* kr = nullptr) {
    constexpr int R = 1 << RL2, hp = 1 << HPL2, NB = 16384 >> RL2;
    int b0 = tid; asm volatile("" : "+v"(b0));
#pragma unroll 1
    for (int b = b0; b < NB; b += NTHR) {
        const int lo = b & (hp - 1), hi = b >> HPL2;
        const int base = hi * (hp * R) + lo, pbase = base + (base >> 4);
        f32x2 r[R];
#pragma unroll
        for (int j = 0; j < R; ++j) r[j] = X[pbase + j * hp + ((j * hp) >> 4)];
        f32x2 wp[RL2], wr[RL2];
        if (HPL2 > 0) { float s, c; sincos_rev((INV ? 1.0f : -1.0f) * (float)lo / (float)(R * hp), s, c); wp[0] = (f32x2){c, s}; wr[0] = (f32x2){-s, c};
#pragma unroll
            for (int q = 1; q < RL2; ++q) { wp[q] = cmulr(wp[q - 1], wp[q - 1], wr[q - 1]); wr[q] = rot90(wp[q]); } }
        if (!INV) {
#pragma unroll
            for (int ms = RL2 - 1; ms >= 0; --ms) {
                const int m = 1 << ms;
#pragma unroll
                for (int j = 0; j < R; ++j) if ((j & m) == 0) {
                    const f32x2 x0 = r[j], x1 = r[j + m];
                    r[j] = x0 + x1;
                    f32x2 d = x0 - x1;
                    const int idx = (j & (m - 1)) * 16 / m;
                    if (idx == 8) d = (f32x2){d.y, -d.x};
                    else if (idx != 0) d = cmulr(d, (f32x2){c32(idx), -s32(idx)}, (f32x2){s32(idx), c32(idx)});
                    if (HPL2 > 0) d = cmulr(d, wp[RL2 - 1 - ms], wr[RL2 - 1 - ms]);
                    r[j + m] = d;
                }
            }
        }
        if constexpr (FUSE) {
#pragma unroll
            for (int j = 0; j < R; ++j) r[j] = cmul(r[j], kr[j]);
        }
        if (INV || FUSE) {
#pragma unroll
            for (int ms = 0; ms < RL2; ++ms) {
                const int m = 1 << ms;
#pragma unroll
                for (int j = 0; j < R; ++j) if ((j & m) == 0) {
                    f32x2 x1 = r[j + m];
                    const int idx = (j & (m - 1)) * 16 / m;
                    if (idx == 8) x1 = (f32x2){-x1.y, x1.x};
                    else if (idx != 0) x1 = cmulr(x1, (f32x2){c32(idx), s32(idx)}, (f32x2){-s32(idx), c32(idx)});
                    if (HPL2 > 0) x1 = cmulr(x1, wp[RL2 - 1 - ms], wr[RL2 - 1 - ms]);
                    const f32x2 x0 = r[j];
                    r[j] = x0 + x1; r[j + m] = x0 - x1;
                }
            }
        }
#pragma unroll
        for (int j = 0; j < R; ++j) X[pbase + j * hp + ((j * hp) >> 4)] = r[j];
    }
}
DI void fft_fwd(LAS f32x2* X, int tid) {
    fft_pass<10, 4, false>(X, tid); __syncthreads(); fft_pass<5, 5, false>(X, tid); __syncthreads(); fft_pass<0, 5, false>(X, tid); __syncthreads();
}
DI void fft_conv_a(LAS f32x2* X, int tid, const f32x2* kr) {
    fft_pass<10, 4, false>(X, tid); __syncthreads(); fft_pass<5, 5, false>(X, tid); __syncthreads(); fft_pass<0, 5, false, true>(X, tid, kr); __syncthreads();
}
DI void fft_conv_b(LAS f32x2* X, int tid) {
    fft_pass<5, 5, true>(X, tid); __syncthreads(); fft_pass<10, 4, true>(X, tid); __syncthreads();
}
DI void fft_inv(LAS f32x2* X, int tid) {
    fft_pass<0, 5, true>(X, tid); __syncthreads(); fft_pass<5, 5, true>(X, tid); __syncthreads(); fft_pass<10, 4, true>(X, tid); __syncthreads();
}

DI void hyena_job(const Ctx& a, int c, LAS unsigned char* lds) {
    int tid_ = tid_of(a.wv);
    const int tid = tid_, lane = tid & 63, wave = tid >> 6, pb = tid + (tid >> 4);
    LAS f32x2* X = (LAS f32x2*)lds; LAS float* red = (LAS float*)(lds + LDS_RED);
    const bf16* kf = (const bf16*)(a.ws + WS_KT) + (size_t)c * UTP; const bf16* kb = (const bf16*)(a.ws + WS_KT) + (size_t)(HYW + c) * UTP;
    const bf16* U0 = (const bf16*)(a.ws + WS_UT) + (size_t)(c * 2) * UTP; const bf16* U1 = U0 + UTP;
    bf16* Y0 = (bf16*)(a.ws + WS_YT) + (size_t)(c * 2) * UTP; bf16* Y1 = Y0 + UTP;
    const float skip = a.in[16][c];
    f32x2 kreg[32];
    unsigned* PART = (unsigned*)(a.ws + WS_PART) + (size_t)blockIdx.x * SEQL;
    const float sc = 0.5f / (float)SEQL;
    float l1 = 0.f;
    v4u fv[4], bv[4], u0v[4], u1v[4];
#pragma unroll
    for (int i = 0; i < 4; ++i) { const int n0 = 8 * tid + 4096 * i; fv[i] = *(const v4u*)(kf + n0); bv[i] = *(const v4u*)(kb + n0); }
    {
#pragma unroll
        for (int i = 0; i < 4; ++i) { const int n0 = 8 * tid + 4096 * i; const unsigned fw[4] = {fv[i].x, fv[i].y, fv[i].z, fv[i].w}, bw[4] = {bv[i].x, bv[i].y, bv[i].z, bv[i].w};
#pragma unroll
            for (int j = 0; j < 4; ++j) { const float f0 = bflo(fw[j]), f1 = bfhi(fw[j]), b0 = bflo(bw[j]), b1 = bfhi(bw[j]);
                l1 += (fabsf(f0) + fabsf(b0)) + (fabsf(f1) + fabsf(b1));
                X[pidx(n0 + 2 * j)] = (f32x2){f0 + b0, 0.f}; X[pidx(n0 + 2 * j + 1)] = (f32x2){f1 + b1, 0.f}; } }
    }
    l1 = wave_sum(l1); if (lane == 0) red[wave] = l1;
    __syncthreads();
    float tot = 0.f;
#pragma unroll
    for (int w = 0; w < 8; ++w) tot += red[w];
    const float inv = 1.0f / tot;
#pragma unroll
    for (int i = 0; i < 4; ++i) { const int n0 = 8 * tid + 4096 * i; u0v[i] = *(const v4u*)(U0 + n0); u1v[i] = *(const v4u*)(U1 + n0); }
    fft_fwd(X, tid);
#pragma unroll
    for (int i = 0; i < 32; ++i) { const f32x2 v = X[34 * tid + i + (i >> 4)]; kreg[i] = (f32x2){v.x * inv + skip, v.y * inv}; }
    __syncthreads();
    {
#pragma unroll
        for (int i = 0; i < 4; ++i) { const int n0 = 8 * tid + 4096 * i; const unsigned aw[4] = {u0v[i].x, u0v[i].y, u0v[i].z, u0v[i].w}, bw[4] = {u1v[i].x, u1v[i].y, u1v[i].z, u1v[i].w};
#pragma unroll
            for (int j = 0; j < 4; ++j) { X[pidx(n0 + 2 * j)] = (f32x2){bflo(aw[j]), bflo(bw[j])}; X[pidx(n0 + 2 * j + 1)] = (f32x2){bfhi(aw[j]), bfhi(bw[j])}; } }
    }
    __syncthreads();
    fft_conv_a(X, tid, kreg);
#pragma unroll
    for (int i = 0; i < 4; ++i) { const int n0 = 8 * tid + 4096 * i; fv[i] = *(const v4u*)(kf + n0); bv[i] = *(const v4u*)(kb + n0); }
    fft_conv_b(X, tid);
#pragma unroll
    for (int i = 0; i < 4; ++i) { const int n0 = 8 * tid + 4096 * i; unsigned pw[8];
#pragma unroll
        for (int j = 0; j < 8; ++j) { const f32x2 v0 = X[pidx(n0 + j)] * sc; pw[j] = pk2(v0.x, v0.y); }
        *(v4u*)(PART + n0) = (v4u){pw[0], pw[1], pw[2], pw[3]}; *(v4u*)(PART + n0 + 4) = (v4u){pw[4], pw[5], pw[6], pw[7]}; }
    __syncthreads();
    {
#pragma unroll
        for (int i = 0; i < 4; ++i) { const int n0 = 8 * tid + 4096 * i; const unsigned fw[4] = {fv[i].x, fv[i].y, fv[i].z, fv[i].w}, bw[4] = {bv[i].x, bv[i].y, bv[i].z, bv[i].w};
#pragma unroll
            for (int j = 0; j < 8; ++j) { const float d = (j & 1) ? (bfhi(fw[j >> 1]) - bfhi(bw[j >> 1])) : (bflo(fw[j >> 1]) - bflo(bw[j >> 1]));
                float s, cs; sincos_rev(-(float)(n0 + j) / (float)(2 * SEQL), s, cs); X[pidx(n0 + j)] = (f32x2){d * cs, d * s}; } }
    }
    __syncthreads();
    { int t2 = tid; asm volatile("" : "+v"(t2));
#pragma unroll
    for (int i = 0; i < 4; ++i) { const int n0 = 8 * t2 + 4096 * i; u0v[i] = *(const v4u*)(U0 + n0); u1v[i] = *(const v4u*)(U1 + n0); } }
    fft_fwd(X, tid);
#pragma unroll
    for (int i = 0; i < 32; ++i) { const f32x2 v = X[34 * tid + i + (i >> 4)]; kreg[i] = (f32x2){v.x * inv + skip, v.y * inv}; }
    __syncthreads();
    {
#pragma unroll
        for (int i = 0; i < 4; ++i) { const int n0 = 8 * tid + 4096 * i; const unsigned aw[4] = {u0v[i].x, u0v[i].y, u0v[i].z, u0v[i].w}, bw[4] = {u1v[i].x, u1v[i].y, u1v[i].z, u1v[i].w};
#pragma unroll
            for (int j = 0; j < 8; ++j) { const f32x2 z = (j & 1) ? (f32x2){bfhi(aw[j >> 1]), bfhi(bw[j >> 1])} : (f32x2){bflo(aw[j >> 1]), bflo(bw[j >> 1])};
                float s, cs; sincos_rev(-(float)(n0 + j) / (float)(2 * SEQL), s, cs); X[pidx(n0 + j)] = cmul(z, (f32x2){cs, s}); } }
    }
    __syncthreads();
    fft_conv_a(X, tid, kreg); fft_conv_b(X, tid);
#pragma unroll 1
    for (int ih = 0; ih < 2; ++ih) {
        v4u pv[2][2];
#pragma unroll
        for (int i = 0; i < 2; ++i)
#pragma unroll
            for (int j = 0; j < 2; ++j) pv[i][j] = *(const v4u*)(PART + 8 * tid + 4096 * (2 * ih + i) + 4 * j);
#pragma unroll
        for (int i = 0; i < 2; ++i) { const int n0 = 8 * tid + 4096 * (2 * ih + i); unsigned o0[4], o1[4];
#pragma unroll
            for (int j = 0; j < 4; ++j) { float s, cs; f32x2 y[2];
#pragma unroll
                for (int q = 0; q < 2; ++q) { const int n = n0 + 2 * j + q; sincos_rev((float)n / (float)(2 * SEQL), s, cs);
                    const unsigned pwd = pv[i][j >> 1][2 * (j & 1) + q]; const f32x2 pe = {bflo(pwd), bfhi(pwd)};
                    y[q] = pe + cmul(X[pidx(n)], (f32x2){cs, s}) * sc; }
                o0[j] = pk2(y[0].x, y[1].x); o1[j] = pk2(y[0].y, y[1].y); }
            *(v4u*)(Y0 + n0) = (v4u){o0[0], o0[1], o0[2], o0[3]}; *(v4u*)(Y1 + n0) = (v4u){o1[0], o1[1], o1[2], o1[3]}; }
    }
    __syncthreads();
}

DI void fnet_job(const Ctx& a, int job, LAS unsigned char* lds) {
    int tid_ = tid_of(a.wv);
    const int tid = tid_;
    LAS f32x2* X = (LAS f32x2*)lds;
    const unsigned* F = (const unsigned*)(a.ws + WS_F1T) + (size_t)job * F1P;
    {   v4u fv[8];
#pragma unroll
        for (int i = 0; i < 8; ++i) fv[i] = *(const v4u*)(F + 4 * tid + 2048 * i);
#pragma unroll
        for (int i = 0; i < 8; ++i) { const int n0 = 4 * tid + 2048 * i; const unsigned w[4] = {fv[i].x, fv[i].y, fv[i].z, fv[i].w};
#pragma unroll
            for (int j = 0; j < 4; ++j) X[pidx(n0 + j)] = (f32x2){bflo(w[j]), bfhi(w[j])}; }
    }
    __syncthreads();
    fft_fwd(X, tid);
    bf16* Y = (bf16*)(a.ws + WS_YF) + (size_t)job * UTP;
    const int pb = tid + (tid >> 4);
    float re[32];
#pragma unroll
    for (int i = 0; i < 32; ++i) re[i] = X[pb + 544 * i].x * (1.0f / 1024.0f);
    __syncthreads();
    LAS float* Yl = (LAS float*)lds;
#pragma unroll
    for (int i = 0; i < 32; ++i) { const int k = (int)(__brev((unsigned)(tid + 512 * i)) >> 18); Yl[k + (k >> 9)] = re[i]; }
    __syncthreads();
#pragma unroll
    for (int i = 0; i < 16; ++i) { const int k = 2 * tid + 1024 * i; const int ad = k + (k >> 9);
        *(unsigned*)(Y + k) = pk2(Yl[ad], Yl[ad + 1]); }
    __syncthreads();
}

DI void ctx_hyena_job(const Ctx& a, int b, int cg, LAS unsigned char* lds) {
    int tid_ = tid_of(a.wv);
    const int tid = tid_, c = tid & 15, tq = tid >> 4, ch = cg * 16 + c;
    LAS float* U = (LAS float*)lds; LAS float* TF = U + 256 * 16; LAS float* TB = TF + 256 * 16;
    const bf16* P = (const bf16*)(a.ws + WS_BIG) + (size_t)(T_LAT + b * CTXL) * N1;
    const float* SW = a.in[9];
    const float* kfw = (const float*)(a.ws + WS_KTC) + (size_t)ch * CTXL; const float* kbw = (const float*)(a.ws + WS_KTC) + (size_t)(HYW + ch) * CTXL;
    float w[3][3];
#pragma unroll
    for (int k = 0; k < 3; ++k)
#pragma unroll
        for (int s = 0; s < 3; ++s) w[k][s] = SW[k * 2304 + s * HYW + ch];
    float x0r[8], l1p = 0.f;
#pragma unroll
    for (int i = 0; i < 8; ++i) { const int t = tq + 32 * i; float cv[3];
#pragma unroll
        for (int s = 0; s < 3; ++s) { const float pm = (t > 0) ? bf2f(P[(size_t)(t - 1) * N1 + s * HYW + ch]) : 0.f, p0 = bf2f(P[(size_t)t * N1 + s * HYW + ch]),
            pp = (t < CTXL - 1) ? bf2f(P[(size_t)(t + 1) * N1 + s * HYW + ch]) : 0.f; cv[s] = w[0][s] * pm + w[1][s] * p0 + w[2][s] * pp; }
        U[t * 16 + c] = cv[2] * cv[1]; x0r[i] = cv[0];
        const float kf = kfw[t], kb = (t >= 1) ? kbw[t] : 0.f; TF[t * 16 + c] = kf; TB[t * 16 + c] = kb; l1p += fabsf(kf) + fabsf(kb); }
    LAS float* red = (LAS float*)(lds + LDS_RED);
    red[tid] = l1p;
    __syncthreads();
    float l1 = 0.f;
#pragma unroll 8
    for (int q = 0; q < 32; ++q) l1 += red[q * 16 + c];
    float acc[8];
#pragma unroll
    for (int i = 0; i < 8; ++i) acc[i] = 0.f;
    for (int d = 0; d < CTXL; ++d) { const float kd = TF[d * 16 + c], km = TB[d * 16 + c];
#pragma unroll
        for (int i = 0; i < 8; ++i) { const int t = tq + 32 * i; const int s0 = t - d, s1 = t + d;
            if (s0 >= 0) acc[i] += kd * U[s0 * 16 + c];
            if (s1 < CTXL) acc[i] += km * U[s1 * 16 + c]; } }
    const float inv = 1.0f / l1, skip = a.in[16][ch];
    bf16* A2 = (bf16*)(a.ws + WS_A2);
#pragma unroll
    for (int i = 0; i < 8; ++i) { const int t = tq + 32 * i; const float y = acc[i] * inv + skip * U[t * 16 + c];
        A2[(size_t)(T_LAT + b * CTXL + t) * DM + ch] = (bf16)f2bf(x0r[i] * y); }
    __syncthreads();
}
DI void ctx_fnet_job(const Ctx& a, int b, int g, LAS unsigned char* lds) {
    int tid_ = tid_of(a.wv);
    const int tid = tid_, j = tid & 63, kq = tid >> 6;
    LAS float* RE = (LAS float*)lds; LAS float* IM = RE + 256 * 64; LAS float* cosT = (LAS float*)(lds + LDS_RED);
    const bf16* P = (const bf16*)(a.ws + WS_BIG) + (size_t)(T_LAT + b * CTXL) * N1 + 2304 + g * 128;
    for (int i = 0; i < 32; ++i) { const int t = kq + 8 * i; RE[t * 64 + j] = bf2f(P[(size_t)t * N1 + j]); IM[t * 64 + j] = bf2f(P[(size_t)t * N1 + 64 + j]); }
    if (tid < 256) cosT[tid] = cospif((float)tid / 128.0f);
    __syncthreads();
    float acc[32];
#pragma unroll
    for (int i = 0; i < 32; ++i) acc[i] = 0.f;
    for (int t = 0; t < CTXL; ++t) { const float re = RE[t * 64 + j], im = IM[t * 64 + j];
#pragma unroll
        for (int i = 0; i < 32; ++i) { const int m = ((kq + 8 * i) * t) & 255; acc[i] += re * cosT[m] + im * cosT[(m - 64) & 255]; } }
    bf16* A2 = (bf16*)(a.ws + WS_A2);
#pragma unroll
    for (int i = 0; i < 32; ++i) A2[(size_t)(T_LAT + b * CTXL + kq + 8 * i) * DM + HYW + g * 64 + j] = (bf16)f2bf(acc[i] * (1.0f / 128.0f));
    __syncthreads();
}
DI void fft_phase(const Ctx& a, LAS unsigned char* lds, int mask = 7) {
    const int G = gridDim.x;
#pragma unroll 1
    for (int sl = 0; sl < 6; ++sl) {
        const int bx = blockIdx.x; int job = bx + G * sl;
        if (G == 256 && ((bx >> 3) & 1)) job = (sl == 0) ? 768 + bx : (sl <= 3) ? bx + 256 * (sl - 1) : (sl == 4) ? 1024 + bx : 1280 + bx;
        if (job >= 768 + 512 + 96 + 8) continue;
        if (job < 768) { if (mask & 1) hyena_job(a, job, lds); }
        else if (job < 1280) { if (mask & 2) fnet_job(a, job - 768, lds); }
        else if (!(mask & 4)) continue;
        else if (job < 1376) ctx_hyena_job(a, (job - 1280) / 48, (job - 1280) % 48, lds);
        else ctx_fnet_job(a, (job - 1376) / 4, (job - 1376) % 4, lds);
    }
}

#ifdef SELFCHECK
DI void hyena_selfcheck(const Ctx& a, LAS unsigned char* lds) {
    if (blockIdx.x != 0) return;
    const int lane = lane_id(), wave = wave_of(a.wv), tid = (wave << 6) | lane;
    LAS float* red = (LAS float*)lds;
    const int cs[4] = {0, 5, 300, 767}; const int ts[5] = {0, 1, 777, 8191, 16383};
    float sdiff = 0.f, sconv = 0.f;
    for (int ci = 0; ci < 4; ++ci) {
        const int c = cs[ci];
        const bf16* kf = (const bf16*)(a.ws + WS_KT) + (size_t)c * UTP; const bf16* kb = (const bf16*)(a.ws + WS_KT) + (size_t)(HYW + c) * UTP;
        float l1 = 0.f;
        for (int n = tid; n < SEQL; n += NTHR) l1 += fabsf(bf2f(kf[n])) + fabsf(bf2f(kb[n]));
        l1 = wave_sum(l1); __syncthreads(); if (lane == 0) red[wave] = l1; __syncthreads();
        float tot = 0.f; for (int w = 0; w < 8; ++w) tot += red[w];
        const float skip = a.in[16][c];
        for (int b = 0; b < 2; ++b) {
            const bf16* U = (const bf16*)(a.ws + WS_UT) + (size_t)(c * 2 + b) * UTP; const bf16* Y = (const bf16*)(a.ws + WS_YT) + (size_t)(c * 2 + b) * UTP;
            for (int ti = 0; ti < 5; ++ti) { const int t = ts[ti];
                float p = 0.f;
                for (int sidx = tid; sidx < SEQL; sidx += NTHR) { const int lag = t - sidx; const float kv = (lag >= 0) ? bf2f(kf[lag]) : bf2f(kb[SEQL + lag]); p += kv * bf2f(U[sidx]); }
                p = wave_sum(p); __syncthreads(); if (lane == 0) red[wave] = p; __syncthreads();
                float conv = 0.f; for (int w = 0; w < 8; ++w) conv += red[w];
                conv /= tot;
                const float yref = conv + skip * bf2f(U[t]); const float d = bf2f(Y[t]) - yref;
                sdiff += d * d; sconv += conv * conv; } } }
    if (tid == 0 && !(sdiff < 0.3f * sconv)) ((unsigned*)(a.ws + WS_CTL))[8] = 1u;
    if (tid < 64) {
        const int tcs[8] = {0, 5, 300, 767, 768, 1000, 1301, 1535}; const int tns[8] = {0, 1, 2, 33, 777, 8191, 12345, 16383};
        const int c = tcs[tid >> 3], n = tns[tid & 7];
        const float* w3 = a.in[15]; const float* H = (const float*)(a.ws + WS_H2);
        float acc = 0.f; for (int i = 0; i < 64; ++i) acc += H[(size_t)n * 64 + i] * w3[(size_t)i * 1536 + c];
        const int cc = c % HYW; const float delta = fabsf(-3.0701134573253945f + (float)cc * ((-15.350567286626973f + 3.0701134573253945f) / 767.0f));
        float ref = acc * expf(-((float)n / (float)(SEQL - 1)) * delta);
        const bool bwd = c >= HYW; if (bwd && n == 0) ref = 0.f;
        const int idx = (!bwd || n == 0) ? n : SEQL - n;
        const float got = bf2f(((const bf16*)(a.ws + WS_KT))[(size_t)c * UTP + idx]);
        if (!(fabsf(got - ref) <= 0.02f * fabsf(ref) + 2e-3f)) ((unsigned*)(a.ws + WS_CTL))[8] = 1u;
    }
}
#endif

#define MFMA32(a_, b_, c_) __builtin_amdgcn_mfma_f32_32x32x16_bf16((a_), (b_), (c_), 0, 0, 0)
template <int S>
DI bf16x8 pack_step(const f32x16& x) {
    v4u p;
    asm volatile("v_cvt_pk_bf16_f32 %0, %4, %5\n\tv_cvt_pk_bf16_f32 %1, %6, %7\n\tv_cvt_pk_bf16_f32 %2, %8, %9\n\tv_cvt_pk_bf16_f32 %3, %10, %11\n\ts_nop 1"
                 : "=&v"(p[0]), "=&v"(p[1]), "=&v"(p[2]), "=&v"(p[3])
                 : "v"(x[8 * S]), "v"(x[8 * S + 1]), "v"(x[8 * S + 2]), "v"(x[8 * S + 3]), "v"(x[8 * S + 4]), "v"(x[8 * S + 5]), "v"(x[8 * S + 6]), "v"(x[8 * S + 7]));
    return __builtin_bit_cast(bf16x8, p);
}
constexpr int AT_KPITCH = 144, AT_VOFF = 46080, AT_VPL = 648, AT_VPC = 520;
template <bool LOCAL>
DI void attn_chunk(LAS unsigned char* Ks, LAS unsigned char* Vs, int ch, const bf16x8 (&qf)[4], float& m, float& l, f32x16& o0, f32x16& o1, int r, int h, int tq, int kp_base) {
    constexpr int vpitch = LOCAL ? AT_VPL : AT_VPC;
    const int cr0 = ch * 32;
    f32x16 s;
#pragma unroll
    for (int i = 0; i < 16; ++i) s[i] = 0.f;
#pragma unroll
    for (int ks = 0; ks < 4; ++ks) { const bf16x8 kf = *(LAS bf16x8*)(Ks + (cr0 + r) * AT_KPITCH + (16 * ks + 8 * h) * 2); s = MFMA32(kf, qf[ks], s); }
    float cmax = -1e30f;
#pragma unroll
    for (int i = 0; i < 16; ++i) {
        if (LOCAL) { const int kp = kp_base + cr0 + (i & 3) + 8 * (i >> 2) + 4 * h; const int dl = kp - tq;
            const bool ok = (dl <= 128) && (dl >= -128) && (kp >= 0) && (kp < SEQL); s[i] = ok ? s[i] : -1e30f; }
        cmax = fmaxf(cmax, s[i]);
    }
    cmax = fmaxf(cmax, __shfl_xor(cmax, 32));
    const float mn = fmaxf(m, cmax), alpha = __builtin_amdgcn_exp2f(m - mn);
    m = mn;
    float ps = 0.f;
#pragma unroll
    for (int i = 0; i < 16; ++i) { s[i] = __builtin_amdgcn_exp2f(s[i] - mn); ps += s[i]; }
    l = l * alpha + ps;
#pragma unroll
    for (int i = 0; i < 16; ++i) { o0[i] *= alpha; o1[i] *= alpha; }
    const bf16x8 p0 = pack_step<0>(s), p1 = pack_step<1>(s);
#pragma unroll
    for (int mt = 0; mt < 2; ++mt) {
#pragma unroll
        for (int sp = 0; sp < 2; ++sp) {
            LAS unsigned char* vp = Vs + (32 * mt + r) * vpitch + (cr0 + 16 * sp + 4 * h) * 2;
            const s16x4 vlo = *(LAS s16x4*)vp, vhi = *(LAS s16x4*)(vp + 16);
            const bf16x8 vf = __builtin_shufflevector(vlo, vhi, 0, 1, 2, 3, 4, 5, 6, 7);
            if (mt == 0) o0 = MFMA32(vf, sp == 0 ? p0 : p1, o0); else o1 = MFMA32(vf, sp == 0 ? p0 : p1, o1);
        }
    }
}
DI void attn_load_local(const bf16* KR, const bf16* VT, int b, int kvh, int t0, int tid, v4u (&kv)[10]) {
#pragma unroll
    for (int i = 0; i < 5; ++i) { const int p = tid + NTHR * i, row = p >> 3, pc = p & 7, kp = t0 - 128 + row; kv[i] = (v4u){0u, 0u, 0u, 0u};
        if (kp >= 0 && kp < SEQL) kv[i] = *(const v4u*)(KR + ((size_t)(b * SEQL + kp)) * 128 + kvh * 64 + pc * 8); }
#pragma unroll
    for (int i = 0; i < 5; ++i) { const int p = tid + NTHR * i, d = p / 40, pc = p % 40, kp0 = t0 - 128 + pc * 8; kv[5 + i] = (v4u){0u, 0u, 0u, 0u};
        if (kp0 >= 0 && kp0 < SEQL) kv[5 + i] = *(const v4u*)(VT + ((size_t)((b * 2 + kvh) * 64 + d)) * UTP + kp0); }
}
DI void attn_store_local(LAS unsigned char* Ks, LAS unsigned char* Vs, int tid, const v4u (&kv)[10]) {
#pragma unroll
    for (int i = 0; i < 5; ++i) { const int p = tid + NTHR * i, row = p >> 3, pc = p & 7; *(LAS v4u*)(Ks + row * AT_KPITCH + pc * 16) = kv[i]; }
#pragma unroll
    for (int i = 0; i < 5; ++i) { const int p = tid + NTHR * i, d = p / 40, pc = p % 40; LAS v2u* dst = (LAS v2u*)(Vs + d * AT_VPL + pc * 16);
        dst[0] = (v2u){kv[5 + i].x, kv[5 + i].y}; dst[1] = (v2u){kv[5 + i].z, kv[5 + i].w}; }
}
DI void attn_load_ctx(const bf16* KC, const bf16* VCT, int b, int kvh, int tid, v4u (&cv)[8]) {
#pragma unroll
    for (int i = 0; i < 4; ++i) { const int p = tid + NTHR * i, row = p >> 3, pc = p & 7; cv[i] = *(const v4u*)(KC + ((size_t)(b * CTXL + row) * 2 + kvh) * 64 + pc * 8); }
#pragma unroll
    for (int i = 0; i < 4; ++i) { const int p = tid + NTHR * i, d = p >> 5, pc = p & 31; cv[4 + i] = *(const v4u*)(VCT + ((size_t)((b * 2 + kvh) * 64 + d)) * CTXL + pc * 8); }
}
DI void attn_store_ctx(LAS unsigned char* Ks, LAS unsigned char* Vs, int tid, const v4u (&cv)[8]) {
#pragma unroll
    for (int i = 0; i < 4; ++i) { const int p = tid + NTHR * i, row = p >> 3, pc = p & 7; *(LAS v4u*)(Ks + row * AT_KPITCH + pc * 16) = cv[i]; }
#pragma unroll
    for (int i = 0; i < 4; ++i) { const int p = tid + NTHR * i, d = p >> 5, pc = p & 31; LAS v2u* dst = (LAS v2u*)(Vs + d * AT_VPC + pc * 16);
        dst[0] = (v2u){cv[4 + i].x, cv[4 + i].y}; dst[1] = (v2u){cv[4 + i].z, cv[4 + i].w}; }
}
DI void attn_phase(const Ctx& a, LAS unsigned char* lds) {
    const int lane = lane_id(), wave = wave_of(a.wv), tid = (wave << 6) | lane, G = gridDim.x;
    const int r = lane & 31, h = lane >> 5;
    const bf16* QR = (const bf16*)(a.ws + WS_QR); const bf16* KR = (const bf16*)(a.ws + WS_KR); const bf16* VT = (const bf16*)(a.ws + WS_VT);
    const bf16* KC = (const bf16*)(a.ws + WS_KC); const bf16* VCT = (const bf16*)(a.ws + WS_VCT);
    bf16* A2 = (bf16*)(a.ws + WS_A2); const float* sink = a.in[28];
    LAS unsigned char* Ks = lds; LAS unsigned char* Vs = lds + AT_VOFF;
    v4u kv[10], cv[8];
    if ((int)blockIdx.x < 1024) { const int u = blockIdx.x; attn_load_local(KR, VT, u >> 9, (u >> 8) & 1, (u & 255) * 64, tid, kv); }
    for (int u = blockIdx.x; u < 1024; u += G) {
        const int qb = u & 255, kvh = (u >> 8) & 1, b = u >> 9;
        const int t0 = qb * 64, g = wave >> 1, qs = wave & 1, h8 = kvh * 4 + g, tq = t0 + qs * 32 + r;
        bf16x8 qf[4];
#pragma unroll
        for (int s = 0; s < 4; ++s) qf[s] = *(const bf16x8*)(QR + ((size_t)(b * SEQL + tq)) * 512 + h8 * 64 + 16 * s + 8 * h);
        float m = sink[h8] * 1.4426950408889634f, l = (h == 0) ? 1.0f : 0.0f;
        f32x16 o0, o1;
#pragma unroll
        for (int i = 0; i < 16; ++i) { o0[i] = 0.f; o1[i] = 0.f; }
        __syncthreads();
        attn_store_local(Ks, Vs, tid, kv);
        attn_load_ctx(KC, VCT, b, kvh, tid, cv);
        __syncthreads();
#pragma unroll 1
        for (int ch = 0; ch < 10; ++ch) attn_chunk<true>(Ks, Vs, ch, qf, m, l, o0, o1, r, h, tq, t0 - 128);
        __syncthreads();
        attn_store_ctx(Ks, Vs, tid, cv);
        { const int un = u + G; if (un < 1024) attn_load_local(KR, VT, un >> 9, (un >> 8) & 1, (un & 255) * 64, tid, kv); }
        __syncthreads();
#pragma unroll 1
        for (int ch = 0; ch < 8; ++ch) attn_chunk<false>(Ks, Vs, ch, qf, m, l, o0, o1, r, h, tq, 0);
        const float inv = 1.0f / (l + __shfl_xor(l, 32));
        bf16* op = A2 + ((size_t)(b * SEQL + tq)) * DM + h8 * 64 + 4 * h;
#pragma unroll
        for (int g4 = 0; g4 < 4; ++g4) {
            v2u w0; w0.x = pk2(o0[4 * g4] * inv, o0[4 * g4 + 1] * inv); w0.y = pk2(o0[4 * g4 + 2] * inv, o0[4 * g4 + 3] * inv);
            v2u w1; w1.x = pk2(o1[4 * g4] * inv, o1[4 * g4 + 1] * inv); w1.y = pk2(o1[4 * g4 + 2] * inv, o1[4 * g4 + 3] * inv);
            *(v2u*)(op + 8 * g4) = w0; *(v2u*)(op + 32 + 8 * g4) = w1;
        }
    }
    __syncthreads();
}

#ifndef SPLIT_G2
#define SPLIT_G2 1
#endif
#ifndef SPLIT_G4
#define SPLIT_G4 1
#endif
__global__ void __launch_bounds__(NTHR, 2) fwd_kernel(Args ka) {
    extern __shared__ __attribute__((aligned(16))) unsigned char lds_raw[];
    LAS unsigned char* lds = (LAS unsigned char*)lds_raw;
    const int wave = __builtin_amdgcn_readfirstlane((int)threadIdx.x >> 6), G = gridDim.x, gw = blockIdx.x * NWAVES + wave, NGW = G * NWAVES;
    const Ctx a{ka.in, ka.out, ka.ws, wave};
    { const int tid = tid_of(wave); if (tid < 4) ((LAS unsigned*)(lds + LDS_MISC))[tid] = 0u; }
    __syncthreads();
#if N_LAUNCH_MODE == 1
    XcdBarrier bar = xcd_barrier_post((unsigned*)(a.ws + WS_CTL) + CW_BAR, (volatile LAS unsigned*)(lds + LDS_MISC), wave);
#define GRID_BAR() xcd_barrier(bar)
#else
#define GRID_BAR() do { } while (0)
#endif
    const int lo = ka.ph_lo, hi = ka.ph_hi;
#ifdef ONLY_PHASE
#define IN(k) (((k) == ONLY_PHASE || (ONLY_PHASE >= 18 && (k) >= 18 && (((k) - ONLY_PHASE) % 2 == 0))) && lo <= (k) && (k) < hi)
#else
#define IN(k) (lo <= (k) && (k) < hi)
#endif
#define SEAM(k) do { if (IN(k) && IN((k) + 1)) GRID_BAR(); } while (0)
#ifndef DUP_MASK
#define DUP_MASK 0
#endif
#ifndef DUP_G345
#define DUP_G345 0
#endif
#define REPS(k) ((((DUP_MASK) >> (k)) & 1) + 1)
#define PH_BEGIN(k) if (IN(k)) { _Pragma("unroll 1") for (int rep_ = 0; rep_ < REPS(k); ++rep_) { if (rep_) GRID_BAR();
#define PH_END(k) } } SEAM(k);
    const int bid = (int)blockIdx.x;

    PH_BEGIN(0) phase0(a, lds); PH_END(0)
    PH_BEGIN(1) {
        for (int it = bid; it < 256; it += G) taps_mfma_item(a, it, lds);
        for (int it = 256 + (G - 1 - bid); it < 260; it += G) taps_mfma_item(a, it, lds);
        norm_rows(a.in[0], a.in[2], a.in[6], ((const float*)(a.ws + WS_ADA)), 0, 1024, ((bf16*)(a.ws + WS_H)), T_ALL, gw, NGW, lane_id());
    } PH_END(1)
    if (IN(2)) {
        pg8::Gemm g{((bf16*)(a.ws + WS_H)), (const bf16*)(a.ws + WS_W_EIN), T_ALL, N1, DM}; pg8::StaticOrder S; S.init(T_ALL, N1, G, bid);
        pg8::EpiStoreBf16 E{((bf16*)(a.ws + WS_BIG)), N1};
        pg8::gemm_phase<pg8::EpiStoreBf16, pg8::StaticOrder, true, true>(lds, g, S, E, wave);
        if (REPS(2) > 1) { GRID_BAR(); pg8::gemm_phase<pg8::EpiStoreBf16, pg8::StaticOrder, true, true>(lds, g, S, E, wave); }
    }
    SEAM(2);
#pragma unroll 1
    for (int grep_ = 0; grep_ < 1 + DUP_G345; ++grep_) {
    if (grep_) GRID_BAR();
    PH_BEGIN(3) prep0_phase(a, lds); PH_END(3)
#ifdef SELFCHECK
    if (IN(4)) { fft_phase(a, lds); GRID_BAR(); hyena_selfcheck(a, lds); } SEAM(4);
#else
#ifdef PROBE_FFT_MASK
    if (IN(4)) { fft_phase(a, lds); GRID_BAR(); fft_phase(a, lds, PROBE_FFT_MASK); } SEAM(4);
#else
    PH_BEGIN(4) fft_phase(a, lds); PH_END(4)
#endif
#endif
    PH_BEGIN(5) untr0_phase(a, lds); } }
    if (grep_ + 1 < 1 + DUP_G345) continue;
    SEAM(5);
    }
    if (IN(6)) {
        pg8::Gemm g{((bf16*)(a.ws + WS_A2)), (const bf16*)(a.ws + WS_W_EOUT), T_ALL, DM, DM}; pg8::StaticOrder S; S.init(T_LAT, DM, G, bid);
        pg8::EpiResid E{a.in[0], a.in[2], a.out, ((float*)(a.ws + WS_XC)), ((const float*)(a.ws + WS_ADA)) + 2048};
        pg8::gemm_phase<pg8::EpiResid, pg8::StaticOrder, true, true>(lds, g, S, E, wave);
        int bid2 = bid, ksl = 256; asm volatile("" : "+s"(bid2), "+s"(ksl) :: "memory");
        pg8::Gemm gc{((bf16*)(a.ws + WS_A2)), (const bf16*)(a.ws + WS_W_EOUT), T_ALL, DM, ksl, DM}; pg8::OrderCtxSplit Sc{4, 4, G, bid2};
        pg8::EpiPartial Ec{(float*)(a.ws + WS_PARTC)};
        if (SPLIT_G2) pg8::gemm_phase<pg8::EpiPartial, pg8::OrderCtxSplit, true, true, true>(lds, gc, Sc, Ec, wave);
        if (bid >= 32) conv_moe_S(a, lds, 0, 4608, bid - 32, 224);
    }
    SEAM(6);
    PH_BEGIN(7) {
        norm_ctx_partial<4, true>(a.in[2], a.in[7], (const float*)(a.ws + WS_ADA), 3072, 4096, (bf16*)(a.ws + WS_H), (const float*)(a.ws + WS_PARTC), (const float*)(a.ws + WS_ADA) + 2 * 6144 + 2048, (float*)(a.ws + WS_XC), NGW - 1 - gw, NGW, lane_id());
        norm_rows<true>(a.out, a.in[2], a.in[7], ((const float*)(a.ws + WS_ADA)), 3072, 4096, ((bf16*)(a.ws + WS_H)), T_LAT, gw, NGW, lane_id());
    } PH_END(7)
    if (IN(8)) {
        pg8::Gemm g{((bf16*)(a.ws + WS_H)), (const bf16*)(a.ws + WS_W_FGU), T_ALL, 2 * DFF, DM}; pg8::StaticOrder S; S.init(T_ALL, 2 * DFF, G, bid);
        pg8::EpiSwigluF8 E{a.ws + WS_BIG, DFF, 0x7fffffff, 22};
        pg8::gemm_phase<pg8::EpiSwigluF8, pg8::StaticOrder, true, true, false, true>(lds, g, S, E, wave);
        if (bid >= 44) conv_moe_S(a, lds, 4608, 17408, bid - 44, 212);
    }
    SEAM(8);
    if (IN(9)) {
        pg8::Gemm g{((bf16*)(a.ws + WS_BIG)), (const bf16*)(a.ws + WS_W_FD), T_ALL, DM, DFF}; pg8::StaticOrder S; S.init(T_LAT, DM, G, bid);
        pg8::EpiResidT<2048> E{a.out, ((float*)(a.ws + WS_XC)), a.out, ((float*)(a.ws + WS_XC)), ((const float*)(a.ws + WS_ADA)) + 5120};
        pg8::gemm_phase<pg8::EpiResidT<2048>, pg8::StaticOrder, true, true, false, true>(lds, g, S, E, wave);
        int bid2 = bid, ksl = 256; asm volatile("" : "+s"(bid2), "+s"(ksl) :: "memory");
        pg8::Gemm gc{((bf16*)(a.ws + WS_BIG)), (const bf16*)(a.ws + WS_W_FD), T_ALL, DM, ksl, DFF}; pg8::OrderCtxSplitT<256> Sc{4, 11, G, bid2};
        pg8::EpiPartialT<8, 2048> Ec{(float*)(a.ws + WS_PARTC)};
        if (SPLIT_G4) pg8::gemm_phase<pg8::EpiPartialT<8, 2048>, pg8::OrderCtxSplitT<256>, true, true, true, true>(lds, gc, Sc, Ec, wave);
        if (bid >= 88) conv_moe_S(a, lds, 17408, 20864, bid - 88, 168);
    }
    SEAM(9);
    if (IN(10)) {
        norm_ctx_partial<11>((const float*)(a.ws + WS_XC), a.in[23], (const float*)(a.ws + WS_ADA) + 3 * 6144, 0, 1024, (bf16*)(a.ws + WS_H), (const float*)(a.ws + WS_PARTC), (const float*)(a.ws + WS_ADA) + 2 * 6144 + 5120, nullptr, NGW - 1 - gw, NGW, lane_id());
        norm_rows(a.out, ((float*)(a.ws + WS_XC)), a.in[23], ((const float*)(a.ws + WS_ADA) + 3 * 6144), 0, 1024, ((bf16*)(a.ws + WS_H)), T_LAT, gw, NGW, lane_id());
    }
    SEAM(10);
    if (IN(11)) {
        pg8::Gemm g{((bf16*)(a.ws + WS_H)), (const bf16*)(a.ws + WS_W_OIN), T_ALL, N2, DM}; pg8::OrderL1In S; S.init(G, bid);
        pg8::EpiStoreBf16 E{((bf16*)(a.ws + WS_BIG)), N2};
        pg8::gemm_phase<pg8::EpiStoreBf16, pg8::OrderL1In, true, true>(lds, g, S, E, wave);
        if (bid >= 130) conv_moe_S(a, lds, 20864, 28672, bid - 130, 126);
    }
    SEAM(11);
    PH_BEGIN(12) prep1_phase(a, lds); PH_END(12)
    PH_BEGIN(13) attn_phase(a, lds); PH_END(13)
    if (IN(14)) {
        pg8::Gemm g{((bf16*)(a.ws + WS_A2)), (const bf16*)(a.ws + WS_W_OOUT), T_LAT, DM, DM}; pg8::StaticOrder S; S.init(T_LAT, DM, G, bid);
        pg8::EpiResid E{a.out, ((float*)(a.ws + WS_XC)), a.out, ((float*)(a.ws + WS_XC)), ((const float*)(a.ws + WS_ADA) + 3 * 6144) + 2048};
        pg8::gemm_phase<pg8::EpiResid, pg8::StaticOrder, true, true>(lds, g, S, E, wave);
    }
    SEAM(14);
    PH_BEGIN(15) { norm_router_phase(a, lds); conv_moe_weights(a, lds); } PH_END(15)
    PH_BEGIN(16) slot_phase(a, lds); PH_END(16)
#pragma unroll 1
    for (int st = 0; st < 2 * NCHUNK; ++st) {
        const int kk = 18 + st;
        if (!IN(kk)) continue;
        const int* panel_e = (const int*)(a.ws + WS_PANELE);
        if (st >= __builtin_amdgcn_readfirstlane(panel_e[PE_NSTEP])) break;
        const int sdn = __builtin_amdgcn_readfirstlane(panel_e[PE_SD + st]), sgu = __builtin_amdgcn_readfirstlane(panel_e[PE_SG + st]), sfl = __builtin_amdgcn_readfirstlane(panel_e[PE_SX + st]), snd = __builtin_amdgcn_readfirstlane(panel_e[PE_SND + st]);
        if (sdn >= 0) {
            pg8::Gemm g{(const bf16*)(a.ws + ((sfl & 1) ? WS_ACTX : ((sfl & 4) ? WS_ACTM2 : WS_ACTM))), (const bf16*)(a.ws + WS_WMD), 0, 0, DFE};
            pg8::OrderMoe S{panel_e, panel_e + PE_LIST + sdn * CHUNKP, __builtin_amdgcn_readfirstlane(panel_e[PE_CNP + sdn]), 4, G, bid, 1, 0};
            pg8::EpiMoeDown E{a.out, ((const float*)(a.ws + WS_ADA) + 3 * 6144) + 5120, (const int*)(a.ws + WS_SLOTTOK), (const float*)(a.ws + WS_SLOTW), panel_e + PE_RES + sdn * CHUNKP};
            pg8::gemm_phase<pg8::EpiMoeDown, pg8::OrderMoe, true, true, false, true>(lds, g, S, E, wave);
        }
        if (sgu >= 0) {
            pg8::Gemm g{((bf16*)(a.ws + WS_BIG)), (const bf16*)(a.ws + WS_WMGU), 0, 0, DM};
            pg8::OrderMoe S{panel_e, panel_e + PE_LIST + sgu * CHUNKP, __builtin_amdgcn_readfirstlane(panel_e[PE_CNP + sgu]), 28, G, bid, 0, snd};
            pg8::EpiSwigluF8 E{a.ws + ((sfl & 2) ? WS_ACTX : ((sfl & 8) ? WS_ACTM2 : WS_ACTM)), DFE, CHUNKP - 1, 28};
            pg8::gemm_phase<pg8::EpiSwigluF8, pg8::OrderMoe, true, true, false, true>(lds, g, S, E, wave);
        }
        SEAM(kk);
    }
#ifdef SELFCHECK
    GRID_BAR();
    if (__hip_atomic_load((unsigned*)(a.ws + WS_CTL) + 8, __ATOMIC_RELAXED, __HIP_MEMORY_SCOPE_AGENT) != 0u) { for (int i = gw * 64 + lane_id(); i < T_LAT * DM; i += NGW * 64) a.out[i] = __builtin_nanf(""); }
#endif
#undef IN
#undef SEAM
}

extern "C" void kernel_launch(void* const* d_in, const int* in_sizes, int n_in, void* d_out, int out_size, void* d_ws, size_t ws_size, hipStream_t stream) {
    static int grid = 0;
    if (grid == 0) {
        int dev = 0, cus = 0;
        if (n_in != 36 || out_size != T_LAT * DM || ws_size < WS_END) { fprintf(stderr, "kernel_launch: unexpected problem shape (n_in %d, out %d, ws %zu < %zu)\n", n_in, out_size, ws_size, (size_t)WS_END); grid = -1; return; }
        if (hipGetDevice(&dev) != hipSuccess || hipDeviceGetAttribute(&cus, hipDeviceAttributeMultiprocessorCount, dev) != hipSuccess) { grid = -1; return; }
        if (hipFuncSetAttribute((const void*)fwd_kernel, hipFuncAttributeMaxDynamicSharedMemorySize, LDS_BYTES) != hipSuccess) { grid = -1; return; }
        (void)hipGetLastError();
        if (cus < 256) { fprintf(stderr, "kernel_launch: needs 256 CUs, device has %d\n", cus); grid = -1; return; }
        grid = 256;
    }
    if (grid < 0) return;
    (void)hipMemsetAsync((char*)d_ws + WS_CTL, 0, 65536, stream);
    Args a{};
    for (int i = 0; i < 36; ++i) a.in[i] = (const float*)d_in[i];
    a.out = (float*)d_out; a.ws = (unsigned char*)d_ws;
#if LAST_PHASE <= 6
    (void)hipMemcpyAsync(d_out, d_in[0], (size_t)T_LAT * DM * 4, hipMemcpyDeviceToDevice, stream);
#endif
#if N_LAUNCH_MODE == 1
    a.ph_lo = 0; a.ph_hi = LAST_PHASE;
    hipLaunchKernelGGL(fwd_kernel, dim3(grid), dim3(NTHR), LDS_BYTES, stream, a);
#else
    for (int ph = 0; ph < LAST_PHASE; ++ph) { a.ph_lo = ph; a.ph_hi = ph + 1; hipLaunchKernelGGL(fwd_kernel, dim3(grid), dim3(NTHR), LDS_BYTES, stream, a); }
#endif
}
```
